# Optimizing an MI355X kernel written in HIP

```python
import jax, jax.numpy as jnp
from jax import lax
import numpy as np

D_MODEL = 1024
BATCH = 16
SEQ = 2048
DEPTH = 4

CHUNK = 64
N_MIXERS = 3
HEAD_DIM = 64
N_HEADS = D_MODEL // HEAD_DIM
Q_BLOCK = 128
SG_CHUNK = 128
SG_GROUPS = 8
SG_HALF = 3 * D_MODEL
CA_PREV = 8
CA_BAND = (CA_PREV + 1) * CHUNK
REL_CLIP = 128
D_FF = 2816
N_EXPERTS = 8
TOP_K = 2
D_FF_EXPERT = 3584
EPS = 1e-6

N_SB = (DEPTH + 2) // 3
N_SG = (DEPTH + 1) // 3
N_CA = DEPTH // 3
N_DENSE = (DEPTH + 1) // 2
N_MOE = DEPTH // 2

kernel_name = 'hybrid_chunk_causal_sb_sgu_relattn_moe'


def rms_norm(x, g):
    xf = x.astype(jnp.float32)
    y = xf * lax.rsqrt(jnp.mean(xf * xf, axis=-1, keepdims=True) + EPS)
    return (y * g.astype(jnp.float32)).astype(x.dtype)


def stick_breaking_mixer(h, w_qkv, q_g, k_g, w_o):
    b, s, _ = h.shape
    qkv = (h @ w_qkv).reshape(b, s, 3, N_HEADS, HEAD_DIM)
    q = rms_norm(qkv[:, :, 0], q_g)
    k = rms_norm(qkv[:, :, 1], k_g)
    v = qkv[:, :, 2]
    scale = HEAD_DIM ** -0.5
    outs = []
    for blk in range(s // Q_BLOCK):
        q0 = blk * Q_BLOCK
        kn = q0 + Q_BLOCK
        z = jnp.einsum('bqhd,bkhd->bhqk', q[:, q0:kn], k[:, :kn]).astype(jnp.float32) * scale
        qpos = q0 + jnp.arange(Q_BLOCK)[:, None]
        kpos = jnp.arange(kn)[None, :]
        strict = kpos < qpos
        log_fail = jnp.where(strict, jax.nn.log_sigmoid(-z), 0.0)
        after = lax.cumsum(log_fail, axis=3, reverse=True) - log_fail
        a = jnp.where(strict, jnp.exp(jax.nn.log_sigmoid(z) + after), 0.0)
        outs.append(jnp.einsum('bhqk,bkhd->bqhd', a.astype(v.dtype), v[:, :kn]))
    o = jnp.concatenate(outs, axis=1).reshape(b, s, D_MODEL)
    return o @ w_o


def spatial_gating_mixer(h, w_in, v_g, w_s, b_s, w_out):
    b, s, _ = h.shape
    z = jax.nn.gelu(h @ w_in)
    u = z[..., :SG_HALF]
    v = rms_norm(z[..., SG_HALF:], v_g)
    n = s // SG_CHUNK
    vc = v.reshape(b, n, SG_CHUNK, SG_GROUPS, SG_HALF // SG_GROUPS)
    pos = jnp.arange(SG_CHUNK)
    mask = (pos[None, :] // CHUNK) <= (pos[:, None] // CHUNK)
    ws = jnp.where(mask[None], w_s, 0.0)
    mixed = jnp.einsum('gij,bnjgc->bnigc', ws.astype(vc.dtype), vc) + b_s.T[None, None, :, :, None]
    y = u * mixed.reshape(b, s, SG_HALF)
    return y @ w_out


def chunk_attention_mixer(h, w_qkv, q_g, k_g, rel_bias, w_o):
    b, s, _ = h.shape
    qkv = (h @ w_qkv).reshape(b, s, 3, N_HEADS, HEAD_DIM)
    q = rms_norm(qkv[:, :, 0], q_g) * (HEAD_DIM ** -0.5)
    k = rms_norm(qkv[:, :, 1], k_g)
    v = qkv[:, :, 2]
    pad = CA_PREV * CHUNK
    kp = jnp.pad(k, ((0, 0), (pad, 0), (0, 0), (0, 0)))
    vp = jnp.pad(v, ((0, 0), (pad, 0), (0, 0), (0, 0)))
    qi = jnp.arange(CHUNK)[:, None]
    kj = jnp.arange(CA_BAND)[None, :]
    rel = qi + pad - kj
    idx = jnp.clip(rel, -REL_CLIP, REL_CLIP) + REL_CLIP
    bias = rel_bias[:, idx].astype(jnp.float32)

    def one_chunk(n):
        start = n * CHUNK
        qn = lax.dynamic_slice_in_dim(q, start, CHUNK, axis=1)
        kn = lax.dynamic_slice_in_dim(kp, start, CA_BAND, axis=1)
        vn = lax.dynamic_slice_in_dim(vp, start, CA_BAND, axis=1)
        logits = jnp.einsum('bqhd,bkhd->bhqk', qn, kn).astype(jnp.float32) + bias
        valid = (start - pad + kj) >= 0
        logits = jnp.where(valid, logits, -jnp.inf)
        p = jax.nn.softmax(logits, axis=-1)
        return jnp.einsum('bhqk,bkhd->bqhd', p.astype(vn.dtype), vn)

    o = lax.map(one_chunk, jnp.arange(s // CHUNK))
    o = jnp.moveaxis(o, 0, 1).reshape(b, s, D_MODEL)
    return o @ w_o


def swiglu(h, w13, w2):
    a, g = jnp.split(h @ w13, 2, axis=-1)
    return (jax.nn.silu(a) * g) @ w2


def moe_swiglu(h, w_r, b_r, w1, w3, w2):
    logits = (h @ w_r).astype(jnp.float32) + b_r.astype(jnp.float32)
    top_v, top_i = lax.top_k(logits, TOP_K)
    top_w = jax.nn.softmax(top_v, axis=-1)
    gates = jnp.sum(jax.nn.one_hot(top_i, N_EXPERTS, dtype=jnp.float32) * top_w[..., None], axis=-2)
    out = jnp.zeros_like(h)
    for e in range(N_EXPERTS):
        y = (jax.nn.silu(h @ w1[e]) * (h @ w3[e])) @ w2[e]
        out = out + gates[..., e:e + 1].astype(h.dtype) * y
    return out


def setup_inputs(seed: int = 0) -> dict:
    key = jax.random.key(seed)
    ks = jax.random.split(key, 26)
    nrm = jax.random.normal
    f32 = jnp.float32
    d = D_MODEL
    return {
        'x': nrm(ks[0], (BATCH, SEQ, d), f32),
        'c': nrm(ks[1], (BATCH, d), f32),
        'norm_g': 1.0 + 0.02 * nrm(ks[2], (DEPTH, 2, d), f32),
        'ada_w': nrm(ks[3], (DEPTH, d, 6 * d), f32) * (0.5 * d ** -0.5),
        'ada_b': 0.02 * nrm(ks[4], (DEPTH, 6 * d), f32),
        'sb_wqkv': nrm(ks[5], (N_SB, d, 3 * d), f32) * d ** -0.5,
        'sb_qg': 1.0 + 0.02 * nrm(ks[6], (N_SB, HEAD_DIM), f32),
        'sb_kg': 1.0 + 0.02 * nrm(ks[7], (N_SB, HEAD_DIM), f32),
        'sb_wo': nrm(ks[8], (N_SB, d, d), f32) * d ** -0.5,
        'sg_win': nrm(ks[9], (N_SG, d, 2 * SG_HALF), f32) * d ** -0.5,
        'sg_vg': 1.0 + 0.02 * nrm(ks[10], (N_SG, SG_HALF), f32),
        'sg_ws': nrm(ks[11], (N_SG, SG_GROUPS, SG_CHUNK, SG_CHUNK), f32) * SG_CHUNK ** -0.5,
        'sg_bs': 1.0 + 0.02 * nrm(ks[12], (N_SG, SG_GROUPS, SG_CHUNK), f32),
        'sg_wout': nrm(ks[13], (N_SG, SG_HALF, d), f32) * SG_HALF ** -0.5,
        'ca_wqkv': nrm(ks[14], (N_CA, d, 3 * d), f32) * d ** -0.5,
        'ca_qg': 1.0 + 0.02 * nrm(ks[15], (N_CA, HEAD_DIM), f32),
        'ca_kg': 1.0 + 0.02 * nrm(ks[16], (N_CA, HEAD_DIM), f32),
        'ca_relb': 0.2 * nrm(ks[17], (N_CA, N_HEADS, 2 * REL_CLIP + 1), f32),
        'ca_wo': nrm(ks[18], (N_CA, d, d), f32) * d ** -0.5,
        'ff_w13': nrm(ks[19], (N_DENSE, d, 2 * D_FF), f32) * d ** -0.5,
        'ff_w2': nrm(ks[20], (N_DENSE, D_FF, d), f32) * D_FF ** -0.5,
        'moe_wr': nrm(ks[21], (N_MOE, d, N_EXPERTS), f32) * d ** -0.5,
        'moe_br': 0.01 * nrm(ks[22], (N_MOE, N_EXPERTS), f32),
        'moe_w1': nrm(ks[23], (N_MOE, N_EXPERTS, d, D_FF_EXPERT), f32) * d ** -0.5,
        'moe_w3': nrm(ks[24], (N_MOE, N_EXPERTS, d, D_FF_EXPERT), f32) * d ** -0.5,
        'moe_w2': nrm(ks[25], (N_MOE, N_EXPERTS, D_FF_EXPERT, d), f32) * D_FF_EXPERT ** -0.5,
    }


def reference(x, c, norm_g, ada_w, ada_b, sb_wqkv, sb_qg, sb_kg, sb_wo, sg_win, sg_vg, sg_ws, sg_bs,
              sg_wout, ca_wqkv, ca_qg, ca_kg, ca_relb, ca_wo, ff_w13, ff_w2, moe_wr, moe_br,
              moe_w1, moe_w3, moe_w2):
    cond = jax.nn.silu(c)
    for i in range(DEPTH):
        mod = (cond @ ada_w[i] + ada_b[i])[:, None, :]
        sh1, sc1, g1, sh2, sc2, g2 = jnp.split(mod, 6, axis=-1)
        h = rms_norm(x, norm_g[i, 0]) * (1 + sc1) + sh1
        kind = i % N_MIXERS
        j = i // N_MIXERS
        if kind == 0:
            y = stick_breaking_mixer(h, sb_wqkv[j], sb_qg[j], sb_kg[j], sb_wo[j])
        elif kind == 1:
            y = spatial_gating_mixer(h, sg_win[j], sg_vg[j], sg_ws[j], sg_bs[j], sg_wout[j])
        else:
            y = chunk_attention_mixer(h, ca_wqkv[j], ca_qg[j], ca_kg[j], ca_relb[j], ca_wo[j])
        x = x + g1 * y
        h = rms_norm(x, norm_g[i, 1]) * (1 + sc2) + sh2
        m = i // 2
        if i % 2 == 0:
            y = swiglu(h, ff_w13[m], ff_w2[m])
        else:
            y = moe_swiglu(h, moe_wr[m], moe_br[m], moe_w1[m], moe_w3[m], moe_w2[m])
        x = x + g2 * y
    return x
```

```cpp
#include <hip/hip_runtime.h>
#include <cstdio>
#include <cstdint>
namespace pg8 {
#define PG8_LAS __attribute__((address_space(3)))
typedef unsigned short bf16_t;
typedef short bf16x8 __attribute__((ext_vector_type(8)));
typedef float f32x4 __attribute__((ext_vector_type(4)));
typedef unsigned u32x4 __attribute__((ext_vector_type(4)));
constexpr int BM = 256, BK = 64, HALF = 128, HTB = HALF * BK * 2  , STAGE_BYTES = 8 * HTB, NXCD = 8, WGM = 8;

__host__ __device__ __forceinline__ int lds_byte(int r, int c) { const int st = (r >> 4) * 2 + (c >> 5), rr = r & 15, cc = c & 31, ob = rr * 64 + cc * 2; return st * 1024 + (ob ^ (((ob >> 9) & 1) << 5)); }
__host__ __device__ __forceinline__ void stage_rc(int b, int& R, int& C) { const int st = b / 1024, sb = b % 1024, swz = sb ^ (((sb >> 9) & 1) << 5); R = (st >> 1) * 16 + swz / 64; C = (st & 1) * 32 + (swz % 64) / 2; }
__host__ __device__ __forceinline__ int perm32(int rho) { const int n = rho >> 4, i = rho & 15; return 8 * (i >> 2) + 4 * n + (i & 3); }

struct Unit { int pm, pn; };
struct Gemm { const bf16_t* A; const bf16_t* Bt; int M, N, K; };

struct StaticOrder {
    int nM, nN, nwg, G, c;
    __host__ __device__ void init(int M, int N, int G_, int c_) { nM = M / BM; nN = N / BM; nwg = nM * nN; G = G_; c = c_; }
    __host__ __device__ bool next(int i, Unit& u) const {
        const long L = (long)i * G + c; if (L >= nwg) return false;
        int wgid = (int)L; { const int q = nwg / NXCD, r = nwg % NXCD, xcd = wgid % NXCD, off = wgid / NXCD; wgid = (xcd < r ? xcd * (q + 1) : r * (q + 1) + (xcd - r) * q) + off; }
        const int nig = WGM * nN, gid = wgid / nig, fm = gid * WGM, gsz = (nM - fm) < WGM ? (nM - fm) : WGM;
        u.pm = fm + ((wgid % nig) % gsz); u.pn = (wgid % nig) / gsz; return true;
    }
    __device__ __forceinline__ void a_ready(const Unit&) const {}
    __device__ __forceinline__ void done(const Unit&) const {}
};

__device__ __forceinline__ unsigned cvt_pk_bf16(float lo, float hi) { unsigned r; asm volatile("v_cvt_pk_bf16_f32 %0, %1, %2" : "=v"(r) : "v"(lo), "v"(hi)); return r; }
typedef float f32x2 __attribute__((ext_vector_type(2)));
template <class Epi, class Sched, bool ALIGN_EPI = false, bool SP2 = false>
__device__ __forceinline__ void gemm_phase(PG8_LAS unsigned char* lds, const Gemm g, const Sched& S, const Epi& E) {
    int tid = threadIdx.x; asm volatile("" : "+v"(tid));
    const int wid = __builtin_amdgcn_readfirstlane(tid >> 6), lane = tid & 63, wr = wid >> 2, wc = wid & 3, fr = lane & 15, fq = lane >> 4;
    const int K = g.K, nt = K / BK;
    unsigned voffA[2], voffB[2];
#pragma unroll
    for (int i = 0; i < 2; ++i) { int R, C; stage_rc(tid * 16 + i * 8192, R, C); const int Rb = Epi::PERM ? ((R & ~31) + perm32(R & 31)) : R;
        voffA[i] = (unsigned)(R * K + C) * 2u; voffB[i] = (unsigned)(Rb * K + C) * 2u; }
    const size_t kstep = (size_t)(BK * 2);
    const size_t hstep = (size_t)HALF * K * 2;
    const size_t tstep = 2 * hstep;
    const unsigned ldsw = (unsigned)wid * 1024u;
    const int aoff = lds_byte(wr * 64 + fr, fq * 8), boff = lds_byte(wc * 32 + fr, fq * 8);
#define PG8_SA(b, h) (((b) * 2 + (h)) * HTB)
#define PG8_SB(b, h) ((4 + (b) * 2 + (h)) * HTB)
#define PG8_STAGE(bufoff, gbase, voff) do { _Pragma("unroll") for (int _i = 0; _i < 2; ++_i) \
        __builtin_amdgcn_global_load_lds((const unsigned*)((const char*)(gbase) + (voff)[_i]), (PG8_LAS unsigned*)(lds + (bufoff) + ldsw + _i * 8192), 16, 0, 0); } while (0)
#define PG8_LDA(dst, b, h) do { _Pragma("unroll") for (int m = 0; m < 4; ++m) _Pragma("unroll") for (int k = 0; k < 2; ++k) dst[m][k] = *(const PG8_LAS bf16x8*)(lds + PG8_SA(b, h) + aoff + m * 2048 + k * 1024); } while (0)
#define PG8_LDB(dst, b, h) do { _Pragma("unroll") for (int n = 0; n < 2; ++n) _Pragma("unroll") for (int k = 0; k < 2; ++k) dst[n][k] = *(const PG8_LAS bf16x8*)(lds + PG8_SB(b, h) + boff + n * 2048 + k * 1024); } while (0)
#define PG8_MMA(ai, bj, At, Bt) do { __builtin_amdgcn_s_setprio(1); _Pragma("unroll") for (int m = 0; m < 4; ++m) _Pragma("unroll") for (int n = 0; n < 2; ++n) _Pragma("unroll") for (int k = 0; k < 2; ++k) \
        acc[ai][bj][m][n] = __builtin_amdgcn_mfma_f32_16x16x32_bf16(Bt[n][k], At[m][k], acc[ai][bj][m][n], 0, 0, 0); __builtin_amdgcn_s_setprio(0); } while (0)
#define PG8_WAIT_V(n) asm volatile("s_waitcnt vmcnt(" #n ")" ::: "memory")
#define PG8_WAIT_L(n) asm volatile("s_waitcnt lgkmcnt(" #n ")" ::: "memory")
#define PG8_BAR __builtin_amdgcn_s_barrier()
#define PG8_SCHED __builtin_amdgcn_sched_barrier(0)
    Unit cur, nxt; int ui = 0;
    if (!S.next(0, cur)) return;
    f32x4 acc[2][2][4][2];
#pragma unroll
    for (int a = 0; a < 2; ++a)
#pragma unroll
        for (int b = 0; b < 2; ++b)
#pragma unroll
            for (int m = 0; m < 4; ++m)
#pragma unroll
                for (int n = 0; n < 2; ++n) acc[a][b][m][n] = (f32x4){0.f, 0.f, 0.f, 0.f};
    bf16x8 At[4][2], B0[2][2], B1[2][2];
    const char* cA = (const char*)g.A + (size_t)cur.pm * tstep; const char* cB = (const char*)g.Bt + (size_t)cur.pn * tstep;
    S.a_ready(cur);
    if constexpr (SP2) {
        PG8_STAGE(PG8_SB(0, 0), cB, voffB); PG8_STAGE(PG8_SB(0, 1), cB + hstep, voffB); PG8_STAGE(PG8_SA(0, 0), cA, voffA); PG8_STAGE(PG8_SA(0, 1), cA + hstep, voffA);
        if (wr == 1) PG8_BAR;
        PG8_WAIT_V(2); PG8_BAR;
        PG8_STAGE(PG8_SB(1, 0), cB + kstep, voffB); PG8_STAGE(PG8_SA(1, 0), cA + kstep, voffA); PG8_STAGE(PG8_SB(1, 1), cB + hstep + kstep, voffB);
        PG8_WAIT_V(6); PG8_BAR;
    } else {
        PG8_STAGE(PG8_SB(0, 0), cB, voffB); PG8_STAGE(PG8_SA(0, 0), cA, voffA); PG8_STAGE(PG8_SB(0, 1), cB + hstep, voffB); PG8_STAGE(PG8_SA(0, 1), cA + hstep, voffA);
        if (wr == 1) PG8_BAR;
        PG8_WAIT_V(4); PG8_BAR;
        PG8_STAGE(PG8_SB(1, 0), cB + kstep, voffB); PG8_STAGE(PG8_SA(1, 0), cA + kstep, voffA); PG8_STAGE(PG8_SB(1, 1), cB + hstep + kstep, voffB);
        PG8_WAIT_V(6); PG8_BAR;
    }
    for (;;) {
        const bool has_next = S.next(ui + 1, nxt);
        const char* nA = has_next ? (const char*)g.A + (size_t)nxt.pm * tstep : cA; const char* nB = has_next ? (const char*)g.Bt + (size_t)nxt.pn * tstep : cB;
        for (int t = 0; t < nt; t += 2) {
            const bool last = (t == nt - 2);
            const char* a1 = cA + (size_t)(t + 1) * kstep;
            const char* a2 = last ? nA : cA + (size_t)(t + 2) * kstep; const char* b2 = last ? nB : cB + (size_t)(t + 2) * kstep;
            const char* a3 = a2 + kstep; const char* b3 = b2 + kstep;
            if (last && has_next) S.a_ready(nxt);
            if constexpr (SP2) {
            PG8_LDB(B0, 0, 0); PG8_LDB(B1, 0, 1); PG8_SCHED; PG8_LDA(At, 0, 0); PG8_STAGE(PG8_SA(1, 1), a1 + hstep, voffA);
            PG8_WAIT_V(8); PG8_WAIT_L(0); PG8_BAR; PG8_MMA(0, 0, At, B0); PG8_MMA(0, 1, At, B1); PG8_BAR; PG8_SCHED;
            PG8_LDA(At, 0, 1); PG8_STAGE(PG8_SB(0, 0), b2, voffB); PG8_STAGE(PG8_SB(0, 1), b2 + hstep, voffB); PG8_STAGE(PG8_SA(0, 0), a2, voffA);
            PG8_WAIT_V(8); PG8_WAIT_L(0); PG8_BAR; PG8_MMA(1, 0, At, B0); PG8_MMA(1, 1, At, B1); PG8_BAR; PG8_SCHED;
            PG8_LDB(B0, 1, 0); PG8_LDB(B1, 1, 1); PG8_SCHED; PG8_LDA(At, 1, 0); PG8_STAGE(PG8_SA(0, 1), a2 + hstep, voffA);
            PG8_WAIT_V(8); PG8_WAIT_L(0); PG8_BAR; PG8_MMA(0, 0, At, B0); PG8_MMA(0, 1, At, B1); PG8_BAR; PG8_SCHED;
            PG8_LDA(At, 1, 1); PG8_STAGE(PG8_SB(1, 0), b3, voffB); PG8_STAGE(PG8_SB(1, 1), b3 + hstep, voffB); PG8_STAGE(PG8_SA(1, 0), a3, voffA);
            PG8_WAIT_V(8); PG8_WAIT_L(0); PG8_BAR; PG8_MMA(1, 0, At, B0); PG8_MMA(1, 1, At, B1); PG8_BAR; PG8_SCHED;
            } else {
            PG8_LDB(B0, 0, 0); PG8_SCHED; PG8_LDA(At, 0, 0); PG8_STAGE(PG8_SA(1, 1), a1 + hstep, voffA);
            PG8_WAIT_L(8); PG8_BAR; PG8_WAIT_L(0); PG8_MMA(0, 0, At, B0); PG8_BAR; PG8_SCHED;
            PG8_LDB(B1, 0, 1); PG8_STAGE(PG8_SB(0, 0), b2, voffB);
            PG8_BAR; PG8_WAIT_L(0); PG8_MMA(0, 1, At, B1); PG8_BAR;
            PG8_LDA(At, 0, 1); PG8_STAGE(PG8_SA(0, 0), a2, voffA);
            PG8_BAR; PG8_WAIT_L(0); PG8_MMA(1, 0, At, B0); PG8_BAR; PG8_SCHED;
            PG8_STAGE(PG8_SB(0, 1), b2 + hstep, voffB);
            PG8_WAIT_V(6); PG8_BAR; PG8_MMA(1, 1, At, B1); PG8_BAR;
            PG8_LDB(B0, 1, 0); PG8_SCHED; PG8_LDA(At, 1, 0); PG8_STAGE(PG8_SA(0, 1), a2 + hstep, voffA);
            PG8_WAIT_L(8); PG8_BAR; PG8_WAIT_L(0); PG8_MMA(0, 0, At, B0); PG8_BAR; PG8_SCHED;
            PG8_LDB(B1, 1, 1); PG8_STAGE(PG8_SB(1, 0), b3, voffB);
            PG8_BAR; PG8_WAIT_L(0); PG8_MMA(0, 1, At, B1); PG8_BAR;
            PG8_LDA(At, 1, 1); PG8_STAGE(PG8_SA(1, 0), a3, voffA);
            PG8_BAR; PG8_WAIT_L(0); PG8_MMA(1, 0, At, B0); PG8_BAR; PG8_SCHED;
            PG8_STAGE(PG8_SB(1, 1), b3 + hstep, voffB);
            PG8_WAIT_V(6); PG8_BAR; PG8_MMA(1, 1, At, B1); PG8_BAR;
            }
        }
        if constexpr (ALIGN_EPI) { if (wr == 0) PG8_BAR; }
        if constexpr (!Epi::AFTER_DRAIN) { E(acc, cur, wr, wc, fr, fq); S.done(cur); }
        if (!has_next) break;
#pragma unroll
        for (int a = 0; a < 2; ++a)
#pragma unroll
            for (int b = 0; b < 2; ++b)
#pragma unroll
                for (int m = 0; m < 4; ++m)
#pragma unroll
                    for (int n = 0; n < 2; ++n) acc[a][b][m][n] = (f32x4){0.f, 0.f, 0.f, 0.f};
        cur = nxt; cA = nA; cB = nB; ++ui;
        if constexpr (ALIGN_EPI) { if (wr == 1) PG8_BAR; }
    }
    PG8_WAIT_V(0);
    if constexpr (!ALIGN_EPI) { if (wr == 0) PG8_BAR; }
    PG8_BAR;
    if constexpr (Epi::AFTER_DRAIN) { E.fused(acc, cur, wr, wc, fr, fq, lds, wid, lane); S.done(cur); }
#undef PG8_SA
#undef PG8_SB
#undef PG8_STAGE
#undef PG8_LDA
#undef PG8_LDB
#undef PG8_MMA
#undef PG8_WAIT_V
#undef PG8_WAIT_L
#undef PG8_BAR
#undef PG8_SCHED
}
}
namespace pg8 {
__device__ __forceinline__ float ex2(float x) { return __builtin_amdgcn_exp2f(x); }
__device__ __forceinline__ float rcp(float x) { return __builtin_amdgcn_rcpf(x); }
__device__ __forceinline__ float silu_f(float a) { return a * rcp(1.0f + ex2(a * -1.4426950408889634f)); }
__device__ __forceinline__ float gelu_t(float x) { const float t = x * (1.0f + 0.044715f * x * x); return x * rcp(1.0f + ex2(t * -2.3022081981405e+00f)); }
__device__ __forceinline__ u32x4 pack8(const f32x4 a, const f32x4 b) { u32x4 w; w.x = cvt_pk_bf16(a[0], a[1]); w.y = cvt_pk_bf16(a[2], a[3]); w.z = cvt_pk_bf16(b[0], b[1]); w.w = cvt_pk_bf16(b[2], b[3]); return w; }

struct EpiQKV {
    static constexpr bool PERM = true, AFTER_DRAIN = false;
    bf16_t* QKV; const float* gains;
    __device__ __forceinline__ void operator()(const f32x4 (&acc)[2][2][4][2], const Unit& u, int wr, int wc, int fr, int fq) const {
        const int t = u.pn >> 2, head = (u.pn & 3) * 4 + wc;
        bf16_t* base = QKV + (size_t)t * ((size_t)32768 * 1024);
        const int row0 = u.pm * BM + wr * 64 + fr, col0 = head * 64 + 8 * fq;
        f32x4 gv[2][2];
        const float* g = gains + 64 * t;
#pragma unroll
        for (int bj = 0; bj < 2; ++bj)
#pragma unroll
            for (int n = 0; n < 2; ++n) gv[bj][n] = *(const f32x4*)(g + 32 * bj + 8 * fq + 4 * n);
#pragma unroll
        for (int ai = 0; ai < 2; ++ai)
#pragma unroll
            for (int m = 0; m < 4; ++m) {
                float ss = 0.f;
#pragma unroll
                for (int bj = 0; bj < 2; ++bj)
#pragma unroll
                    for (int n = 0; n < 2; ++n) { const f32x4 x = acc[ai][bj][m][n]; ss += (x[0] * x[0] + x[1] * x[1]) + (x[2] * x[2] + x[3] * x[3]); }
                ss += __shfl_xor(ss, 16); ss += __shfl_xor(ss, 32);
                const float r = t < 2 ? __builtin_amdgcn_rsqf(ss * (1.0f / 64.0f) + 1e-6f) : 1.0f;
                bf16_t* rowp = base + (size_t)(row0 + ai * HALF + m * 16) * 1024 + col0;
#pragma unroll
                for (int bj = 0; bj < 2; ++bj) { const f32x4 v0 = acc[ai][bj][m][0] * gv[bj][0] * r, v1 = acc[ai][bj][m][1] * gv[bj][1] * r;
                    *(u32x4*)(rowp + 32 * bj) = pack8(v0, v1); }
            }
    }
};
struct EpiSwiglu {
    static constexpr bool PERM = true, AFTER_DRAIN = false;
    bf16_t* O; int ldc; int ntl;
    __device__ __forceinline__ void operator()(const f32x4 (&acc)[2][2][4][2], const Unit& u, int wr, int wc, int fr, int fq) const {
        const int pnl = u.pn % ntl; const int row0 = u.pm * BM + wr * 64 + fr, col0 = pnl * 128 + wc * 32 + 8 * fq;
#pragma unroll
        for (int ai = 0; ai < 2; ++ai)
#pragma unroll
            for (int m = 0; m < 4; ++m) { bf16_t* rowp = O + (size_t)(row0 + ai * HALF + m * 16) * ldc + col0;
                f32x4 o0, o1;
#pragma unroll
                for (int j = 0; j < 4; ++j) { o0[j] = silu_f(acc[ai][0][m][0][j]) * acc[ai][1][m][0][j]; o1[j] = silu_f(acc[ai][0][m][1][j]) * acc[ai][1][m][1][j]; }
                *(u32x4*)rowp = pack8(o0, o1); }
    }
};
struct EpiGeluSG {
    static constexpr bool PERM = true, AFTER_DRAIN = false;
    bf16_t* U; bf16_t* V; float* vpart;
    __device__ __forceinline__ void operator()(const f32x4 (&acc)[2][2][4][2], const Unit& u, int wr, int wc, int fr, int fq) const {
        const bool isv = u.pn >= 12; const int pnl = isv ? u.pn - 12 : u.pn; bf16_t* base = isv ? V : U;
        const int row0 = u.pm * BM + wr * 64 + fr, col0 = pnl * BM + wc * 32 + 8 * fq;
#pragma unroll
        for (int ai = 0; ai < 2; ++ai)
#pragma unroll
            for (int m = 0; m < 4; ++m) { const int row = row0 + ai * HALF + m * 16; bf16_t* rowp = base + (size_t)row * 3072 + col0; float ss = 0.f;
#pragma unroll
                for (int bj = 0; bj < 2; ++bj) { f32x4 z0, z1;
#pragma unroll
                    for (int j = 0; j < 4; ++j) { z0[j] = gelu_t(acc[ai][bj][m][0][j]); z1[j] = gelu_t(acc[ai][bj][m][1][j]); ss += z0[j] * z0[j] + z1[j] * z1[j]; }
                    *(u32x4*)(rowp + bj * HALF) = pack8(z0, z1); }
                if (isv) { ss += __shfl_xor(ss, 16); ss += __shfl_xor(ss, 32); if (fq == 0) vpart[(size_t)row * 48 + pnl * 4 + wc] = ss; } }
    }
};
struct EpiResid {
    static constexpr bool PERM = false, AFTER_DRAIN = false;
    const float* xin; float* out; const float* gate;
    __device__ __forceinline__ void operator()(const f32x4 (&acc)[2][2][4][2], const Unit& u, int wr, int wc, int fr, int fq) const {
        const float* gp = gate + (size_t)(u.pm >> 3) * 6144;
        const int row0 = u.pm * BM + wr * 64 + fr, col0 = u.pn * BM + wc * 32 + 4 * fq;
        f32x4 gv[2][2];
#pragma unroll
        for (int bj = 0; bj < 2; ++bj)
#pragma unroll
            for (int n = 0; n < 2; ++n) gv[bj][n] = *(const f32x4*)(gp + col0 + bj * HALF + n * 16);
#pragma unroll
        for (int ai = 0; ai < 2; ++ai)
#pragma unroll
            for (int m = 0; m < 4; ++m) { const size_t off = (size_t)(row0 + ai * HALF + m * 16) * 1024 + col0;
#pragma unroll
                for (int bj = 0; bj < 2; ++bj)
#pragma unroll
                    for (int n = 0; n < 2; ++n) { const f32x4 xv = *(const f32x4*)(xin + off + bj * HALF + n * 16); *(f32x4*)(out + off + bj * HALF + n * 16) = xv + gv[bj][n] * acc[ai][bj][m][n]; } }
    }
};
struct EpiMoeOut {
    static constexpr bool PERM = true, AFTER_DRAIN = false;
    bf16_t* Y; const int* rowinfo; int mtok;
    __device__ __forceinline__ void operator()(const f32x4 (&acc)[2][2][4][2], const Unit& u, int wr, int wc, int fr, int fq) const {
        const int row0 = u.pm * BM + wr * 64 + fr, col0 = (u.pn & 3) * BM + wc * 32 + 8 * fq;
#pragma unroll
        for (int ai = 0; ai < 2; ++ai)
#pragma unroll
            for (int m = 0; m < 4; ++m) { const int ti = rowinfo[row0 + ai * HALF + m * 16];
                if (ti >= 0) { bf16_t* rowp = Y + ((size_t)(ti & 1) * mtok + (ti >> 1)) * 1024 + col0;
#pragma unroll
                    for (int bj = 0; bj < 2; ++bj) *(u32x4*)(rowp + bj * HALF) = pack8(acc[ai][bj][m][0], acc[ai][bj][m][1]); } }
    }
};
struct MoeOrder {
    const PG8_LAS int* pre; int ntl, G, c;
    __device__ __forceinline__ bool next(int i, Unit& u) const {
        StaticOrder so; so.init(__builtin_amdgcn_readfirstlane(pre[8]) * BM, ntl * BM, G, c);
        if (!so.next(i, u)) return false;
        int e = 0;
#pragma unroll
        for (int k = 1; k < 8; ++k) e += (u.pm >= pre[k]) ? 1 : 0;
        u.pn += e * ntl; return true;
    }
    __device__ __forceinline__ void a_ready(const Unit&) const {}
    __device__ __forceinline__ void done(const Unit&) const {}
};
__device__ __forceinline__ void moe_order_setup(PG8_LAS int* pre, const unsigned* cnt) {
    if (threadIdx.x == 0) { int p = 0; pre[0] = 0;
#pragma unroll
        for (int e = 0; e < 8; ++e) { p += (int)((cnt[64 * e] + 255u) >> 8); pre[e + 1] = p; } }
    __syncthreads();
}
}
#define GAS __attribute__((address_space(1)))
#define LAS __attribute__((address_space(3)))
typedef unsigned short bf16;
typedef unsigned v4u __attribute__((ext_vector_type(4)));
typedef float f32x4 __attribute__((ext_vector_type(4)));
typedef short bf16x8 __attribute__((ext_vector_type(8)));
typedef GAS unsigned gu32;
typedef GAS unsigned long long gu64;
#define RLX_AGENT __ATOMIC_RELAXED, __HIP_MEMORY_SCOPE_AGENT
#define LDS_WAIT() asm volatile("s_waitcnt lgkmcnt(0)" ::: "memory")
#define VM_WAIT() asm volatile("s_waitcnt vmcnt(0)" ::: "memory")
__device__ __forceinline__ unsigned long long rt() { return __builtin_amdgcn_s_memrealtime(); }
__device__ __forceinline__ unsigned f2bf(float f) { unsigned u = __builtin_bit_cast(unsigned, f); return (u + 0x7fffu + ((u >> 16) & 1u)) >> 16; }
__device__ __forceinline__ unsigned pk2(float lo, float hi) { return f2bf(lo) | (f2bf(hi) << 16); }
#define XB_TMO      128
#define XB_XCNT(j)  (256  + 64 * (j))
#define XB_XSUB(j)  (1280 + 64 * (j))
#define XB_XGEN(j)  (2304 + 64 * (j))
#define XB_TOP      3328
#define XB_TOPGEN   3392
#define XCD_BAR_WORDS 3456
#define XB_SPIN_CAP (1u << 22)

__device__ __forceinline__ unsigned xb_ld(unsigned* p)              { return __hip_atomic_load(p, __ATOMIC_RELAXED, __HIP_MEMORY_SCOPE_AGENT); }
__device__ __forceinline__ unsigned xb_add(unsigned* p, unsigned v) { return __hip_atomic_fetch_add(p, v, __ATOMIC_RELAXED, __HIP_MEMORY_SCOPE_AGENT); }
__device__ __forceinline__ unsigned xb_xcc_id() { return (unsigned)__builtin_amdgcn_s_getreg((3 << 11) | 20) & 0xFu; }
#define XB_SPIN(cond, bar) do { unsigned _sp = 0; while (cond) { __builtin_amdgcn_s_sleep(1); \
    if ((++_sp & 255u) == 0u) { if (xb_ld(&(bar)[XB_TMO])) break; if (_sp > XB_SPIN_CAP) { atomicAdd(&(bar)[XB_TMO], 1u); break; } } } } while (0)

struct XcdBarrier {
    unsigned* bar; unsigned x;
    volatile LAS unsigned* st;
};

__device__ __forceinline__ XcdBarrier xcd_barrier_post(unsigned* bar, volatile LAS unsigned* st) {
    XcdBarrier b; b.bar = bar; b.x = xb_xcc_id(); b.st = st;
    if (threadIdx.x == 0) (void)xb_add(&bar[XB_XCNT(b.x)], 1u);
    return b;
}
__device__ __forceinline__ void xcd_barrier_complete(unsigned* bar, unsigned x, unsigned& nloc, unsigned& nx) {
    const unsigned G = gridDim.x * gridDim.y * gridDim.z;
    unsigned sum, cnt, mine, sp = 0u;
    for (;;) {
        sum = 0u; cnt = 0u; mine = 0u;
#pragma unroll
        for (unsigned j = 0; j < 16; ++j) { const unsigned c = xb_ld(&bar[XB_XCNT(j)]); sum += c; cnt += (c > 0u) ? 1u : 0u; mine = (j == x) ? c : mine; }
        if (sum == G) break;
        __builtin_amdgcn_s_sleep(1);
        if ((++sp & 255u) == 0u) { if (xb_ld(&bar[XB_TMO])) break; if (sp > XB_SPIN_CAP) { atomicAdd(&bar[XB_TMO], 1u); break; } }
    }
    nloc = mine > 0u ? mine : 1u; nx = cnt > 0u ? cnt : 1u;
}

__device__ __forceinline__ void xcd_barrier(const XcdBarrier& b) {
    asm volatile("s_waitcnt vmcnt(0)" ::: "memory");
    __syncthreads();
    if (threadIdx.x == 0) {
        unsigned* bar = b.bar;
        __builtin_amdgcn_s_waitcnt(0);
        unsigned nloc = b.st[0], nx = b.st[1];
        if (nloc == 0u) { xcd_barrier_complete(bar, b.x, nloc, nx); b.st[0] = nloc; b.st[1] = nx; }
        const unsigned old = xb_add(&bar[XB_XSUB(b.x)], 1u);
        const unsigned gen = old / nloc;
        if (old + 1u == (gen + 1u) * nloc) {
            __builtin_amdgcn_fence(__ATOMIC_RELEASE, "agent");
            asm volatile("s_waitcnt vmcnt(0)" ::: "memory");
            const unsigned og = xb_add(&bar[XB_TOP], 1u);
            const unsigned tg = og / nx;
            if (og + 1u == (tg + 1u) * nx) xb_add(&bar[XB_TOPGEN], 1u);
            else XB_SPIN(xb_ld(&bar[XB_TOPGEN]) == tg, bar);
            __builtin_amdgcn_fence(__ATOMIC_ACQUIRE, "agent");
            xb_add(&bar[XB_XGEN(b.x)], 1u);
            asm volatile("s_waitcnt vmcnt(0)" ::: "memory");
        } else {
            XB_SPIN(xb_ld(&bar[XB_XGEN(b.x)]) == gen, bar);
            __builtin_amdgcn_fence(__ATOMIC_ACQUIRE, "agent");
            asm volatile("s_waitcnt vmcnt(0)" ::: "memory");
        }
    }
    __syncthreads();
}

constexpr int D = 1024, NB = 16, SEQ = 2048, MTOK = NB * SEQ, NHEAD = 16, HD = 64;
constexpr int SGH = 3072, DFF = 2816, NEXP = 8, DFE = 3584;
constexpr int MODL = NB * 6 * D;
constexpr float EPSN = 1e-6f, LOG2E = 1.4426950408889634f;
constexpr int NWAVES = 8;
constexpr int ASROWS = 2 * MTOK + NEXP * 256;

constexpr size_t MiB = 1u << 20;
constexpr size_t WS_CTL = 0, CTL_ZERO_BYTES = 2 * MiB;
constexpr size_t WS_MOD = 2 * MiB, WS_GAINS = 3 * MiB + 512 * 1024;
constexpr size_t WS_WQKV0 = 4 * MiB, WS_WQKV1 = 10 * MiB, WS_WQKVC = 16 * MiB, WS_WO0 = 22 * MiB, WS_WO1 = 24 * MiB, WS_WOC = 26 * MiB;
constexpr size_t WS_WIN = 28 * MiB, WS_WOUT = 40 * MiB, WS_W13_0 = 46 * MiB, WS_W13_1 = 57 * MiB, WS_W2_0 = 68 * MiB, WS_W2_1 = 68 * MiB + 5632 * 1024;
constexpr size_t WS_MOE13 = 80 * MiB, WS_MOE2 = 192 * MiB;
constexpr size_t WS_H = 248 * MiB;
constexpr size_t WS_AS = 312 * MiB;
constexpr size_t WS_ACT = 444 * MiB;
constexpr size_t WS_ROWINFO = 906 * MiB, WS_TROUTE = 907 * MiB, WS_TW = 908 * MiB, WS_VPART = 909 * MiB, WS_END = 916 * MiB;
static_assert(WS_W2_1 + (size_t)1024 * 2816 * 2 <= WS_MOE13 && WS_ACT + (size_t)ASROWS * DFE * 2 <= WS_ROWINFO && WS_AS + (size_t)ASROWS * 1024 * 2 <= WS_ACT, "ws map");
constexpr int CW_BAR = 4096, CW_CNT = 8192;

constexpr int LDS_BYTES = 147456, XTRA_OFF = 131072, MISC_OFF = LDS_BYTES - 256;

typedef float f32x16 __attribute__((ext_vector_type(16)));
typedef short s16x4 __attribute__((ext_vector_type(4)));
typedef unsigned u32x2 __attribute__((ext_vector_type(2)));

__device__ __forceinline__ float wave_sum(float v) {
#pragma unroll
    for (int o = 1; o < 64; o <<= 1) v += __shfl_xor(v, o);
    return v;
}
__device__ __forceinline__ float bf_lo(unsigned u) { return __uint_as_float(u << 16); }
__device__ __forceinline__ float bf_hi(unsigned u) { return __uint_as_float(u & 0xffff0000u); }
__device__ __forceinline__ int crow(int r, int hi) { return (r & 3) + 8 * (r >> 2) + 4 * hi; }

__device__ __forceinline__ void transpose_item(const float* __restrict__ W, int K, int N, int k0, int n0, bf16* dst, LAS float* scr, int lane) {
#pragma unroll 8
    for (int i = 0; i < 32; ++i) { const int kk = 2 * i + (lane >> 5); scr[kk * 33 + (lane & 31)] = W[(size_t)(k0 + kk) * N + n0 + (lane & 31)]; }
    LDS_WAIT(); asm volatile("" ::: "memory");
    const int c = lane & 7;
#pragma unroll
    for (int j = 0; j < 4; ++j) { const int n = (lane >> 3) + 8 * j; const LAS float* s = scr + (8 * c) * 33 + n;
        v4u o; o.x = pk2(s[0 * 33], s[1 * 33]); o.y = pk2(s[2 * 33], s[3 * 33]); o.z = pk2(s[4 * 33], s[5 * 33]); o.w = pk2(s[6 * 33], s[7 * 33]);
        *(GAS v4u*)(dst + (size_t)n * K + k0 + 8 * c) = o; }
    LDS_WAIT(); asm volatile("" ::: "memory");
}
__device__ __forceinline__ int map_nat(int n) { return n; }
__device__ __forceinline__ int map_qkv(int n) { const int L = n & 255; return (n & ~255) | (((L >> 5) & 1) << 7) | ((L >> 6) << 5) | (L & 31); }
__device__ __forceinline__ int map_glu(int n, int half) { const int a = n < half ? n : n - half; return ((a >> 7) << 8) + (n < half ? 0 : 128) + (a & 127); }
template <int MAP> __device__ __forceinline__ void conv_item(int r, const float* W, int K, int N, bf16* dst, LAS float* scr, int lane) {
    const int nblk = N / 32, kb = r / nblk, nb = r % nblk, k0 = 64 * kb, n0 = 32 * nb;
    int drow;
    if (MAP == 0) drow = map_nat(n0); else if (MAP == 1) drow = map_qkv(n0); else if (MAP == 2) drow = map_glu(n0, N / 2);
    else if (MAP == 3) drow = ((n0 >> 7) << 8) + (n0 & 127); else drow = ((n0 >> 7) << 8) + 128 + (n0 & 127);
    transpose_item(W, K, N, k0, n0, dst + (size_t)drow * K, scr, lane);
}
constexpr int IT_MOE1 = (D / 64) * (DFE / 32), IT_MOE2 = (DFE / 64) * (D / 32);
constexpr int IT_MOE = NEXP * (2 * IT_MOE1 + IT_MOE2);
__device__ __forceinline__ void moe_conv_item(int r, const float* w1, const float* w3, const float* w2, bf16* W13, bf16* W2, LAS float* scr, int lane) {
    if (r < NEXP * IT_MOE1) { const int e = r / IT_MOE1; conv_item<3>(r % IT_MOE1, w1 + (size_t)e * D * DFE, D, DFE, W13 + (size_t)e * 2 * DFE * D, scr, lane); return; }
    r -= NEXP * IT_MOE1;
    if (r < NEXP * IT_MOE1) { const int e = r / IT_MOE1; conv_item<4>(r % IT_MOE1, w3 + (size_t)e * D * DFE, D, DFE, W13 + (size_t)e * 2 * DFE * D, scr, lane); return; }
    r -= NEXP * IT_MOE1;
    { const int e = r / IT_MOE2; conv_item<0>(r % IT_MOE2, w2 + (size_t)e * DFE * D, DFE, D, W2 + (size_t)e * D * DFE, scr, lane); }
}
__device__ __forceinline__ void mod_item(int it, const float* __restrict__ ada_w, const float* __restrict__ ada_b, float* mod, const LAS float* cond, int lane) {
    const int i = it / 96, n0 = 64 * (it % 96), n4 = lane & 15, ksub = lane >> 4;
    f32x4 acc[16];
#pragma unroll
    for (int b = 0; b < 16; ++b) acc[b] = (f32x4){0.f, 0.f, 0.f, 0.f};
    const float* wp = ada_w + (size_t)i * D * 6 * D + n0 + 4 * n4;
#pragma unroll 4
    for (int kk = 0; kk < 256; ++kk) { const int k = 4 * kk + ksub;
        const f32x4 w = *(const f32x4*)(wp + (size_t)k * 6 * D);
        const LAS f32x4* cp = (const LAS f32x4*)(cond + k * 16);
#pragma unroll
        for (int q = 0; q < 4; ++q) { const f32x4 c = cp[q];
#pragma unroll
            for (int e = 0; e < 4; ++e) acc[4 * q + e] += w * c[e]; } }
#pragma unroll
    for (int b = 0; b < 16; ++b)
#pragma unroll
        for (int e = 0; e < 4; ++e) { float v = acc[b][e]; v += __shfl_xor(v, 16); v += __shfl_xor(v, 32); acc[b][e] = v; }
    if (ksub == 0) { const f32x4 bv = *(const f32x4*)(ada_b + (size_t)i * 6 * D + n0 + 4 * n4);
#pragma unroll
        for (int b = 0; b < 16; ++b) *(f32x4*)(mod + (size_t)i * MODL + (size_t)b * 6 * D + n0 + 4 * n4) = acc[b] + bv; }
}

template <bool COMBINE, bool NORM, bool ROUTE>
__device__ __forceinline__ void norm_phase(const float* xin, float* xout, bf16* H, const float* ng, const float* modl, int sh_off,
                                           const float* g2prev, const bf16* Y, const float* twin,
                                           const float* wr, const float* br, unsigned* cnt, int* troute, float* twout,
                                           LAS unsigned char* L, int vcu, int G, int wave, int lane, int tid) {
    LAS float* wrL = (LAS float*)L;
    if (ROUTE) { for (int u = tid; u < D * NEXP; u += NWAVES * 64) wrL[u] = wr[u]; __syncthreads(); }
    for (int gw = vcu * NWAVES + wave; gw < MTOK / 16; gw += G * NWAVES) {
        const int b = gw >> 7; const size_t row0 = (size_t)gw * 16;
        f32x4 A[4], Bv[4], G2[4];
#pragma unroll
        for (int j = 0; j < 4; ++j) { const int col = 4 * lane + 256 * j;
            if (NORM) { const f32x4 g = *(const f32x4*)(ng + col), sc = *(const f32x4*)(modl + (size_t)b * 6 * D + sh_off + D + col); A[j] = g * (sc + 1.0f); Bv[j] = *(const f32x4*)(modl + (size_t)b * 6 * D + sh_off + col); }
            if (COMBINE) G2[j] = *(const f32x4*)(g2prev + (size_t)b * 6 * D + col); }
        int my_e1 = 0, my_e2 = 0; float my_w1 = 0.f, my_w2 = 0.f;
        for (int r = 0; r < 16; ++r) { const size_t row = row0 + r;
            f32x4 x[4];
#pragma unroll
            for (int j = 0; j < 4; ++j) x[j] = *(const f32x4*)(xin + row * D + 4 * lane + 256 * j);
            if (COMBINE) { const float w0 = twin[2 * row], w1 = twin[2 * row + 1];
#pragma unroll
                for (int j = 0; j < 4; ++j) { const u32x2 y0 = *(const u32x2*)(Y + row * D + 4 * lane + 256 * j), y1 = *(const u32x2*)(Y + ((size_t)MTOK + row) * D + 4 * lane + 256 * j);
                    f32x4 t; t[0] = w0 * bf_lo(y0.x) + w1 * bf_lo(y1.x); t[1] = w0 * bf_hi(y0.x) + w1 * bf_hi(y1.x); t[2] = w0 * bf_lo(y0.y) + w1 * bf_lo(y1.y); t[3] = w0 * bf_hi(y0.y) + w1 * bf_hi(y1.y);
                    x[j] = x[j] + G2[j] * t; *(f32x4*)(xout + row * D + 4 * lane + 256 * j) = x[j]; } }
            if (NORM) { float ss = 0.f;
#pragma unroll
                for (int j = 0; j < 4; ++j) ss += (x[j][0] * x[j][0] + x[j][1] * x[j][1]) + (x[j][2] * x[j][2] + x[j][3] * x[j][3]);
                const float rstd = __builtin_amdgcn_rsqf(wave_sum(ss) * (1.0f / D) + EPSN);
                float lg[8];
#pragma unroll
                for (int e = 0; e < 8; ++e) lg[e] = 0.f;
#pragma unroll
                for (int j = 0; j < 4; ++j) { const f32x4 h = x[j] * rstd * A[j] + Bv[j];
                    u32x2 o; o.x = pk2(h[0], h[1]); o.y = pk2(h[2], h[3]); *(u32x2*)(H + row * D + 4 * lane + 256 * j) = o;
                    if (ROUTE) {
#pragma unroll
                        for (int jj = 0; jj < 4; ++jj) { const LAS f32x4* wp = (const LAS f32x4*)(wrL + (4 * lane + 256 * j + jj) * 8); const f32x4 wa = wp[0], wb = wp[1];
#pragma unroll
                            for (int e = 0; e < 4; ++e) { lg[e] += h[jj] * wa[e]; lg[4 + e] += h[jj] * wb[e]; } } } }
                if (ROUTE) {
#pragma unroll
                    for (int e = 0; e < 8; ++e) lg[e] = wave_sum(lg[e]) + br[e];
                    int e1 = 0; float v1 = lg[0];
#pragma unroll
                    for (int e = 1; e < 8; ++e) if (lg[e] > v1) { v1 = lg[e]; e1 = e; }
                    int e2 = -1; float v2 = -INFINITY;
#pragma unroll
                    for (int e = 0; e < 8; ++e) if (e != e1 && lg[e] > v2) { v2 = lg[e]; e2 = e; }
                    const float w1 = 1.0f / (1.0f + __expf(v2 - v1));
                    if (lane == r) { my_e1 = e1; my_e2 = e2; my_w1 = w1; my_w2 = 1.0f - w1; } } } }
        if (ROUTE) {
            const bool valid = lane < 16; int rank1 = 0, rank2 = 0; unsigned mine = 0;
            const unsigned long long lt = (1ull << lane) - 1ull;
#pragma unroll
            for (int e = 0; e < 8; ++e) { const unsigned long long m1 = __ballot(valid && my_e1 == e), m2 = __ballot(valid && my_e2 == e);
                if (my_e1 == e) rank1 = __popcll(m1 & lt);
                if (my_e2 == e) rank2 = __popcll(m1) + __popcll(m2 & lt);
                if (lane == e) mine = (unsigned)(__popcll(m1) + __popcll(m2)); }
            unsigned base = 0;
            if (lane < 8) base = __hip_atomic_fetch_add(cnt + 64 * lane, mine, __ATOMIC_RELAXED, __HIP_MEMORY_SCOPE_AGENT);
            const int b1 = (int)__shfl((int)base, my_e1), b2 = (int)__shfl((int)base, my_e2);
            if (valid) { int4 tr; tr.x = my_e1; tr.y = b1 + rank1; tr.z = my_e2; tr.w = b2 + rank2; *(int4*)(troute + 4 * (row0 + lane)) = tr;
                twout[2 * (row0 + lane)] = my_w1; twout[2 * (row0 + lane) + 1] = my_w2; } }
    }
}

__device__ __forceinline__ void gather_phase(const bf16* H, bf16* AS, int* rowinfo, const int* troute, const unsigned* cnt, int vcu, int G, int wave, int lane, int tid) {
    int mt[8];
#pragma unroll
    for (int e = 0; e < 8; ++e) mt[e] = (int)((cnt[64 * e] + 255u) >> 8);
    for (int gw = vcu * NWAVES + wave; gw < MTOK / 16; gw += G * NWAVES) {
        for (int r = 0; r < 16; ++r) { const size_t m = (size_t)gw * 16 + r;
            const int4 tr = *(const int4*)(troute + 4 * m);
            int rb1 = 0, rb2 = 0;
#pragma unroll
            for (int k = 0; k < 7; ++k) { rb1 += (tr.x > k) ? mt[k] * 256 : 0; rb2 += (tr.z > k) ? mt[k] * 256 : 0; }
            const size_t R1 = (size_t)(rb1 + tr.y), R2 = (size_t)(rb2 + tr.w);
            const v4u v0 = *(const v4u*)(H + m * D + lane * 8), v1 = *(const v4u*)(H + m * D + 512 + lane * 8);
            *(v4u*)(AS + R1 * D + lane * 8) = v0; *(v4u*)(AS + R1 * D + 512 + lane * 8) = v1;
            *(v4u*)(AS + R2 * D + lane * 8) = v0; *(v4u*)(AS + R2 * D + 512 + lane * 8) = v1;
            if (lane == 0) { rowinfo[R1] = (int)(2 * m); rowinfo[R2] = (int)(2 * m + 1); } }
    }
    if (vcu == 0) { int rb = 0;
#pragma unroll
        for (int e = 0; e < 8; ++e) { const int c = (int)cnt[64 * e]; for (int R = rb + c + tid; R < rb + mt[e] * 256; R += NWAVES * 64) rowinfo[R] = -1; rb += mt[e] * 256; } }
}

__device__ __forceinline__ void pv_tile(f32x16 (&o)[2], unsigned vb, pg8::bf16x8 pa0, pg8::bf16x8 pa1, pg8::bf16x8 pa2, pg8::bf16x8 pa3) {
#pragma unroll
    for (int d0 = 0; d0 < 2; ++d0) { s16x4 lo[4], hi[4];
#pragma unroll
        for (int ks = 0; ks < 4; ++ks) {
            asm volatile("ds_read_b64_tr_b16 %0,%1 offset:%c2" : "=&v"(lo[ks]) : "v"(vb), "i"(d0 * 4096 + ks * 1024) : "memory");
            asm volatile("ds_read_b64_tr_b16 %0,%1 offset:%c2" : "=&v"(hi[ks]) : "v"(vb), "i"(d0 * 4096 + ks * 1024 + 512) : "memory"); }
        asm volatile("s_waitcnt lgkmcnt(0)" ::: "memory"); __builtin_amdgcn_sched_barrier(0);
#define PK(k) (pg8::bf16x8){lo[k][0], lo[k][1], lo[k][2], lo[k][3], hi[k][0], hi[k][1], hi[k][2], hi[k][3]}
        o[d0] = __builtin_amdgcn_mfma_f32_32x32x16_bf16(pa0, PK(0), o[d0], 0, 0, 0);
        o[d0] = __builtin_amdgcn_mfma_f32_32x32x16_bf16(pa1, PK(1), o[d0], 0, 0, 0);
        o[d0] = __builtin_amdgcn_mfma_f32_32x32x16_bf16(pa2, PK(2), o[d0], 0, 0, 0);
        o[d0] = __builtin_amdgcn_mfma_f32_32x32x16_bf16(pa3, PK(3), o[d0], 0, 0, 0);
#undef PK
    }
}
__device__ __forceinline__ void v_dma(const bf16* vsrc, size_t pitch, LAS unsigned char* slot) {
#pragma unroll
    for (int p = 0; p < 8; ++p)
        __builtin_amdgcn_global_load_lds((const unsigned*)(vsrc + (size_t)(16 * (p & 3)) * pitch + (p >> 2) * 32), (LAS unsigned*)(slot + p * 1024), 16, 0, 0);
}
__device__ __forceinline__ unsigned short bf1(float x) { return (unsigned short)f2bf(x); }

template <int MODE>
__device__ __forceinline__ void attn_strip(const bf16* __restrict__ Q, const bf16* __restrict__ K, const bf16* __restrict__ V, bf16* __restrict__ O, int b, int h, int r0, int kt_hi, int kt_lo,
                                           LAS unsigned char* vbuf, LAS float* wsf, const LAS float* biasT, int lane) {
    const int r32 = lane & 31, hi = lane >> 5;
    const size_t rowbase = (size_t)b * SEQ;
    pg8::bf16x8 qr[4];
    { const bf16* qp = Q + (rowbase + r0 + r32) * D + h * HD + hi * 8;
#pragma unroll
      for (int d0 = 0; d0 < 4; ++d0) qr[d0] = *(const pg8::bf16x8*)(qp + d0 * 16); }
    const bf16* kbase = K + (rowbase + r32) * D + h * HD + hi * 8;
    const bf16* vsrc = V + (rowbase + (lane >> 2)) * D + h * HD + (lane & 3) * 8;
    const unsigned vb = (unsigned)(uintptr_t)vbuf + ((lane >> 4) & 1) * 32 + (lane & 3) * 8 + (4 * hi + ((lane & 15) >> 2)) * 64;
    f32x16 o[2];
#pragma unroll
    for (int r = 0; r < 16; ++r) { o[0][r] = 0.f; o[1][r] = 0.f; }
    pg8::bf16x8 kf[8], kn[8];
#pragma unroll
    for (int d0 = 0; d0 < 4; ++d0) { kf[2 * d0] = *(const pg8::bf16x8*)(kbase + (size_t)kt_hi * 64 * D + d0 * 16); kf[2 * d0 + 1] = *(const pg8::bf16x8*)(kbase + (size_t)kt_hi * 64 * D + 32 * D + d0 * 16); }
    const int t = r0 + r32;
    float prun = 1.0f, mrun = -INFINITY, lrun = 0.f;
    for (int kt = kt_hi; kt >= kt_lo; --kt) {
        LDS_WAIT();
        v_dma(vsrc + (size_t)kt * 64 * D, D, vbuf);
        if (kt > kt_lo) {
#pragma unroll
            for (int d0 = 0; d0 < 4; ++d0) { kn[2 * d0] = *(const pg8::bf16x8*)(kbase + (size_t)(kt - 1) * 64 * D + d0 * 16); kn[2 * d0 + 1] = *(const pg8::bf16x8*)(kbase + (size_t)(kt - 1) * 64 * D + 32 * D + d0 * 16); }
        }
        f32x16 p0, p1;
#pragma unroll
        for (int r = 0; r < 16; ++r) { p0[r] = 0.f; p1[r] = 0.f; }
#pragma unroll
        for (int d0 = 0; d0 < 4; ++d0) { p0 = __builtin_amdgcn_mfma_f32_32x32x16_bf16(kf[2 * d0], qr[d0], p0, 0, 0, 0); p1 = __builtin_amdgcn_mfma_f32_32x32x16_bf16(kf[2 * d0 + 1], qr[d0], p1, 0, 0, 0); }
        if (MODE == 0) {
            float F0[16], F1[16];
#pragma unroll
            for (int r = 0; r < 16; ++r) { F0[r] = pg8::rcp(1.0f + pg8::ex2(p0[r])); F1[r] = pg8::rcp(1.0f + pg8::ex2(p1[r])); }
            if (kt == kt_hi) { const int kb = 64 * kt + 4 * hi;
#pragma unroll
                for (int r = 0; r < 16; ++r) { const int kv = kb + (r & 3) + 8 * (r >> 2); if (kv >= t) F0[r] = 1.0f; if (kv + 32 >= t) F1[r] = 1.0f; } }
            float g[8], gp[8], E[8];
#pragma unroll
            for (int i = 0; i < 4; ++i) { g[i] = (F0[4 * i] * F0[4 * i + 1]) * (F0[4 * i + 2] * F0[4 * i + 3]); g[4 + i] = (F1[4 * i] * F1[4 * i + 1]) * (F1[4 * i + 2] * F1[4 * i + 3]); }
#pragma unroll
            for (int i = 0; i < 8; ++i) gp[i] = __shfl_xor(g[i], 32);
            float run = prun;
#pragma unroll
            for (int x = 1; x >= 0; --x)
#pragma unroll
                for (int i = 3; i >= 0; --i) { const float g1 = hi ? g[4 * x + i] : gp[4 * x + i], g0 = hi ? gp[4 * x + i] : g[4 * x + i];
                    const float E1 = run; run *= g1; const float E0 = run; run *= g0; E[4 * x + i] = hi ? E1 : E0; }
            prun = run;
#pragma unroll
            for (int i = 0; i < 4; ++i) { float w = E[i];
#pragma unroll
                for (int j = 3; j >= 0; --j) { const float wn = w * F0[4 * i + j]; p0[4 * i + j] = w - wn; w = wn; }
                w = E[4 + i];
#pragma unroll
                for (int j = 3; j >= 0; --j) { const float wn = w * F1[4 * i + j]; p1[4 * i + j] = w - wn; w = wn; } }
        } else {
            float mx = -INFINITY;
#pragma unroll
            for (int r = 0; r < 16; ++r) { const int kv = 64 * kt + crow(r, hi);
                int i0 = t - kv; i0 = i0 < -128 ? -128 : (i0 > 128 ? 128 : i0); int i1 = t - kv - 32; i1 = i1 < -128 ? -128 : (i1 > 128 ? 128 : i1);
                p0[r] += biasT[i0 + 128]; p1[r] += biasT[i1 + 128]; mx = fmaxf(mx, fmaxf(p0[r], p1[r])); }
            mx = fmaxf(mx, __shfl_xor(mx, 32));
            const float mnew = fmaxf(mrun, mx), alpha = pg8::ex2(mrun - mnew); mrun = mnew;
            float ls = 0.f;
#pragma unroll
            for (int r = 0; r < 16; ++r) { p0[r] = pg8::ex2(p0[r] - mnew); p1[r] = pg8::ex2(p1[r] - mnew); ls += p0[r] + p1[r]; }
            lrun = lrun * alpha + ls;
            if (kt != kt_hi) { if (hi == 0) wsf[r32] = alpha; asm volatile("s_waitcnt lgkmcnt(0)" ::: "memory");
#pragma unroll
                for (int r = 0; r < 16; ++r) { const float f = wsf[crow(r, hi)]; o[0][r] *= f; o[1][r] *= f; }
                asm volatile("s_waitcnt lgkmcnt(0)" ::: "memory"); }
        }
        pg8::u32x4 pw0, pw1, pw2, pw3;
        pw0 = (pg8::u32x4){pk2(p0[0], p0[1]), pk2(p0[2], p0[3]), pk2(p0[4], p0[5]), pk2(p0[6], p0[7])};
        pw1 = (pg8::u32x4){pk2(p0[8], p0[9]), pk2(p0[10], p0[11]), pk2(p0[12], p0[13]), pk2(p0[14], p0[15])};
        pw2 = (pg8::u32x4){pk2(p1[0], p1[1]), pk2(p1[2], p1[3]), pk2(p1[4], p1[5]), pk2(p1[6], p1[7])};
        pw3 = (pg8::u32x4){pk2(p1[8], p1[9]), pk2(p1[10], p1[11]), pk2(p1[12], p1[13]), pk2(p1[14], p1[15])};
        VM_WAIT();
        pv_tile(o, vb, __builtin_bit_cast(pg8::bf16x8, pw0), __builtin_bit_cast(pg8::bf16x8, pw1), __builtin_bit_cast(pg8::bf16x8, pw2), __builtin_bit_cast(pg8::bf16x8, pw3));
#pragma unroll
        for (int i = 0; i < 8; ++i) kf[i] = kn[i];
        if (MODE == 0) { if (!__any(prun > 1e-30f)) break; }
    }
    float sc[16];
    if (MODE == 1) { const float lt = lrun + __shfl_xor(lrun, 32); if (hi == 0) wsf[r32] = pg8::rcp(lt); asm volatile("s_waitcnt lgkmcnt(0)" ::: "memory");
#pragma unroll
        for (int r = 0; r < 16; ++r) sc[r] = wsf[crow(r, hi)];
        asm volatile("s_waitcnt lgkmcnt(0)" ::: "memory"); }
    bf16* op = O + (rowbase + r0) * D + h * HD + r32;
#pragma unroll
    for (int r = 0; r < 16; ++r) { const int q = crow(r, hi);
        const float a0 = MODE == 1 ? o[0][r] * sc[r] : o[0][r], a1 = MODE == 1 ? o[1][r] * sc[r] : o[1][r];
        op[(size_t)q * D] = bf1(a0); op[(size_t)q * D + 32] = bf1(a1); }
}
template <int MODE>
__device__ __forceinline__ void attn_phase(const bf16* Q, const bf16* K, const bf16* V, bf16* O, const float* relb, LAS unsigned char* L, int vcu, int G, int wave, int lane, int tid) {
    LAS float* biasL = (LAS float*)(L + 65536);
    LAS float* wsf = (LAS float*)(L + 65536 + 16448) + wave * 64;
    LAS unsigned char* vbuf = L + wave * 8192;
    if (MODE == 1) { for (int u = tid; u < NHEAD * 257; u += NWAVES * 64) biasL[u] = relb[u] * LOG2E; }
    __syncthreads();
    const int NGW = G * NWAVES;
    for (int idx = vcu * NWAVES + wave; idx < NB * NHEAD * 64; idx += NGW) {
        const int i = idx >> 11, gq = idx & 2047, bh = i * 32 + (gq >> 6), s = ((gq & 63) + 8 * i) & 63;
        const int b = bh >> 4, h = bh & 15, r0 = 32 * s, kt_hi = s >> 1;
        const int kt_lo = MODE == 1 ? (kt_hi > 8 ? kt_hi - 8 : 0) : 0;
        attn_strip<MODE>(Q, K, V, O, b, h, r0, kt_hi, kt_lo, vbuf, wsf, biasL + h * 257, lane);
    }
    LDS_WAIT(); VM_WAIT();
}

__device__ __forceinline__ void spatial_phase(bf16* U, const bf16* Vb, const float* vpart, const float* ws, const float* bs, const float* vg, LAS unsigned char* L, int vcu, int G, int wave, int lane, int tid) {
    LAS float* psum = (LAS float*)(L + XTRA_OFF);
    LAS float* rstdL = psum + 512;
    LAS unsigned char* vbuf = L + wave * 16384;
    const int r32 = lane & 31, hi = lane >> 5;
    const unsigned vb = (unsigned)(uintptr_t)vbuf + ((lane >> 4) & 1) * 32 + (lane & 3) * 8 + (4 * hi + ((lane & 15) >> 2)) * 64;
    for (int idx = vcu; idx < NB * 16 * 8; idx += G) {
        const int b = idx >> 7, n = (idx >> 3) & 15, g = idx & 7;
        const size_t tok0 = (size_t)b * SEQ + n * 128;
        { const int j = tid & 127, part = tid >> 7; const f32x4* p = (const f32x4*)(vpart + (tok0 + j) * 48 + part * 12); const f32x4 a = p[0], c = p[1], d = p[2];
          psum[part * 128 + j] = ((a[0] + a[1]) + (a[2] + a[3])) + ((c[0] + c[1]) + (c[2] + c[3])) + ((d[0] + d[1]) + (d[2] + d[3])); }
        __syncthreads();
        if (tid < 128) rstdL[tid] = __builtin_amdgcn_rsqf(((psum[tid] + psum[128 + tid]) + (psum[256 + tid] + psum[384 + tid])) * (1.0f / SGH) + EPSN);
        __syncthreads();
        if (wave < 6) {
            const int c0 = g * 384 + wave * 64;
            const bf16* vsrc = Vb + (tok0 + (lane >> 2)) * SGH + c0 + (lane & 3) * 8;
            v_dma(vsrc, SGH, vbuf); v_dma(vsrc + (size_t)64 * SGH, SGH, vbuf + 8192);
            VM_WAIT();
            const float vg0 = vg[c0 + r32], vg1 = vg[c0 + 32 + r32];
            for (int ib = 0; ib < 4; ++ib) {
                f32x16 o[2];
#pragma unroll
                for (int r = 0; r < 16; ++r) { o[0][r] = 0.f; o[1][r] = 0.f; }
                const int njt = ib < 2 ? 1 : 2;
                for (int jt = 0; jt < njt; ++jt) {
                    const float* wrow = ws + ((size_t)g * 128 + 32 * ib + r32) * 128 + 64 * jt + 4 * hi;
                    pg8::u32x4 pw[4];
#pragma unroll
                    for (int ks = 0; ks < 4; ++ks) { const f32x4 wa = *(const f32x4*)(wrow + 16 * ks), wb = *(const f32x4*)(wrow + 16 * ks + 8);
                        const f32x4 ra = *(const LAS f32x4*)(rstdL + 64 * jt + 16 * ks + 4 * hi), rb = *(const LAS f32x4*)(rstdL + 64 * jt + 16 * ks + 4 * hi + 8);
                        const f32x4 xa = wa * ra, xb = wb * rb;
                        pw[ks] = (pg8::u32x4){pk2(xa[0], xa[1]), pk2(xa[2], xa[3]), pk2(xb[0], xb[1]), pk2(xb[2], xb[3])}; }
                    pv_tile(o, vb + jt * 8192, __builtin_bit_cast(pg8::bf16x8, pw[0]), __builtin_bit_cast(pg8::bf16x8, pw[1]), __builtin_bit_cast(pg8::bf16x8, pw[2]), __builtin_bit_cast(pg8::bf16x8, pw[3]));
                }
#pragma unroll
                for (int r = 0; r < 16; ++r) { const int ii = 32 * ib + crow(r, hi); const float bsv = bs[g * 128 + ii];
                    bf16* up = U + (tok0 + ii) * SGH + c0 + r32;
                    const float u0 = __uint_as_float((unsigned)up[0] << 16), u1 = __uint_as_float((unsigned)up[32] << 16);
                    up[0] = bf1(u0 * (o[0][r] * vg0 + bsv)); up[32] = bf1(u1 * (o[1][r] * vg1 + bsv)); }
            }
        }
        LDS_WAIT(); __syncthreads();
    }
}

struct Args { const float* in[26]; float* out; unsigned char* ws; };
enum { I_X = 0, I_C, I_NORMG, I_ADAW, I_ADAB, I_SBWQKV, I_SBQG, I_SBKG, I_SBWO, I_SGWIN, I_SGVG, I_SGWS, I_SGBS, I_SGWOUT, I_CAWQKV, I_CAQG, I_CAKG, I_CARELB, I_CAWO, I_FFW13, I_FFW2, I_MOEWR, I_MOEBR, I_MOEW1, I_MOEW3, I_MOEW2 };

#ifndef PHMASK
#define PHMASK 0xFFFFFFFFu
#endif
#define PH(k) (((PHMASK) >> (k)) & 1u)
__device__ __forceinline__ const void* karg(int byte_off) { const void* p; asm volatile("s_load_dwordx2 %0, %1, %2\n\ts_waitcnt lgkmcnt(0)" : "=s"(p) : "s"(__builtin_amdgcn_kernarg_segment_ptr()), "i"(byte_off) : "memory"); return p; }
#define KIN(i) (a.in[i])
#define KOUT (a.out)
#define KWS (a.ws)
__global__ void __launch_bounds__(NWAVES * 64, 2) fwd_kernel(Args a) {
    extern __shared__ __attribute__((aligned(16))) unsigned char lds[];
    LAS unsigned char* L = (LAS unsigned char*)lds;
    const int G = gridDim.x, bx = blockIdx.x, vcu = (G % 8 == 0) ? (bx % 8) * (G / 8) + bx / 8 : bx;
#define PHASE_IDS int tid = threadIdx.x; asm volatile("" : "+v"(tid)); const int lane = tid & 63, wave = __builtin_amdgcn_readfirstlane(tid >> 6); const int gwi = wave * G + vcu, NGW = G * NWAVES; (void)gwi; (void)NGW; (void)lane
    volatile LAS unsigned* MISC = (volatile LAS unsigned*)(L + MISC_OFF);
    if (threadIdx.x < 64) MISC[threadIdx.x] = 0u;
    __syncthreads();
#define mod ((float*)(KWS + WS_MOD))
#define gains ((float*)(KWS + WS_GAINS))
#define WQKV0 ((bf16*)(KWS + WS_WQKV0))
#define WQKV1 ((bf16*)(KWS + WS_WQKV1))
#define WQKVC ((bf16*)(KWS + WS_WQKVC))
#define WO0 ((bf16*)(KWS + WS_WO0))
#define WO1 ((bf16*)(KWS + WS_WO1))
#define WOC ((bf16*)(KWS + WS_WOC))
#define WIN ((bf16*)(KWS + WS_WIN))
#define WOUT ((bf16*)(KWS + WS_WOUT))
#define W13_0 ((bf16*)(KWS + WS_W13_0))
#define W13_1 ((bf16*)(KWS + WS_W13_1))
#define W2_0 ((bf16*)(KWS + WS_W2_0))
#define W2_1 ((bf16*)(KWS + WS_W2_1))
#define MOE13 ((bf16*)(KWS + WS_MOE13))
#define MOE2 ((bf16*)(KWS + WS_MOE2))
#define H ((bf16*)(KWS + WS_H))
#define AS ((bf16*)(KWS + WS_AS))
#define YB ((bf16*)(KWS + WS_AS))
#define ACT ((bf16*)(KWS + WS_ACT))
#define Qb ACT
#define Kb (ACT + (size_t)MTOK * D)
#define Vb (ACT + (size_t)2 * MTOK * D)
#define Ub ACT
#define Vg (ACT + (size_t)MTOK * SGH)
#define rowinfo ((int*)(KWS + WS_ROWINFO))
#define troute ((int*)(KWS + WS_TROUTE))
#define tw ((float*)(KWS + WS_TW))
#define vpart ((float*)(KWS + WS_VPART))
#define X (KOUT)
#define x_in (KIN(I_X))
#define normg (KIN(I_NORMG))
#define ctl ((unsigned*)(KWS + WS_CTL))
    XcdBarrier bar = xcd_barrier_post(ctl + CW_BAR, MISC + 8);
#define GRID_BAR() xcd_barrier(bar)
    const float QS = 0.125f * LOG2E;

    if (PH(0)) { PHASE_IDS;
        LAS float* cond = (LAS float*)L;
        LAS float* scr = (LAS float*)(L + 65536 + wave * 8448);
        const float* c = KIN(I_C);
        for (int u = tid; u < NB * D; u += NWAVES * 64) { const int k = u >> 4, b = u & 15; const float v = c[b * D + k]; cond[u] = v / (1.0f + __expf(-v)); }
        if (bx == 0) for (int gi = tid; gi < 576; gi += NWAVES * 64) { const int set = gi / 192, w = (gi % 192) >> 6, d = gi & 63;
            float v = 1.0f;
            if (w < 2) { const float* src = set == 2 ? (w ? KIN(I_CAKG) : KIN(I_CAQG)) : (w ? KIN(I_SBKG) : KIN(I_SBQG)) + (set == 1 ? HD : 0); v = src[d] * (w ? 1.0f : QS); }
            gains[gi] = v; }
        __syncthreads();
        constexpr int C_MOD = 4 * 96, C_QKV = 16 * 96, C_WO = 16 * 32, C_WIN = 16 * 192, C_WOUT = 48 * 32, C_W13 = 16 * 176, C_W2 = 44 * 32;
        constexpr int TOTAL = C_MOD + 3 * C_QKV + 3 * C_WO + C_WIN + C_WOUT + 2 * C_W13 + 2 * C_W2 + IT_MOE;
        for (int it = gwi; it < TOTAL; it += NGW) {
            int r = it;
            if (r < C_MOD) { mod_item(r, KIN(I_ADAW), KIN(I_ADAB), mod, cond, lane); continue; } r -= C_MOD;
            if (r < C_QKV) { conv_item<1>(r, KIN(I_SBWQKV), D, 3 * D, WQKV0, scr, lane); continue; } r -= C_QKV;
            if (r < C_QKV) { conv_item<1>(r, KIN(I_SBWQKV) + (size_t)D * 3 * D, D, 3 * D, WQKV1, scr, lane); continue; } r -= C_QKV;
            if (r < C_QKV) { conv_item<1>(r, KIN(I_CAWQKV), D, 3 * D, WQKVC, scr, lane); continue; } r -= C_QKV;
            if (r < C_WO) { conv_item<0>(r, KIN(I_SBWO), D, D, WO0, scr, lane); continue; } r -= C_WO;
            if (r < C_WO) { conv_item<0>(r, KIN(I_SBWO) + (size_t)D * D, D, D, WO1, scr, lane); continue; } r -= C_WO;
            if (r < C_WO) { conv_item<0>(r, KIN(I_CAWO), D, D, WOC, scr, lane); continue; } r -= C_WO;
            if (r < C_WIN) { conv_item<0>(r, KIN(I_SGWIN), D, 2 * SGH, WIN, scr, lane); continue; } r -= C_WIN;
            if (r < C_WOUT) { conv_item<0>(r, KIN(I_SGWOUT), SGH, D, WOUT, scr, lane); continue; } r -= C_WOUT;
            if (r < C_W13) { conv_item<2>(r, KIN(I_FFW13), D, 2 * DFF, W13_0, scr, lane); continue; } r -= C_W13;
            if (r < C_W13) { conv_item<2>(r, KIN(I_FFW13) + (size_t)D * 2 * DFF, D, 2 * DFF, W13_1, scr, lane); continue; } r -= C_W13;
            if (r < C_W2) { conv_item<0>(r, KIN(I_FFW2), DFF, D, W2_0, scr, lane); continue; } r -= C_W2;
            if (r < C_W2) { conv_item<0>(r, KIN(I_FFW2) + (size_t)DFF * D, DFF, D, W2_1, scr, lane); continue; } r -= C_W2;
            moe_conv_item(r, KIN(I_MOEW1), KIN(I_MOEW3), KIN(I_MOEW2), MOE13, MOE2, scr, lane);
        }
    }
    GRID_BAR();

    if (PH(1)) { PHASE_IDS; norm_phase<false, true, false>(x_in, nullptr, H, normg + 0 * D, mod + 0 * MODL, 0, nullptr, nullptr, nullptr, nullptr, nullptr, nullptr, nullptr, nullptr, L, vcu, G, wave, lane, tid); }
    GRID_BAR();
    if (PH(2)) { pg8::Gemm g{H, WQKV0, MTOK, 3 * D, D}; pg8::StaticOrder S; S.init(MTOK, 3 * D, G, bx);
      pg8::EpiQKV E{Qb, gains + 0};
      pg8::gemm_phase<pg8::EpiQKV, pg8::StaticOrder, true, true>(L, g, S, E); }
    GRID_BAR();
    if (PH(3)) { PHASE_IDS; attn_phase<0>(Qb, Kb, Vb, H, nullptr, L, vcu, G, wave, lane, tid); }
    GRID_BAR();
    if (PH(4)) { pg8::Gemm g{H, WO0, MTOK, D, D}; pg8::StaticOrder S; S.init(MTOK, D, G, bx);
      pg8::EpiResid E{x_in, X, mod + 0 * MODL + 2 * D};
      pg8::gemm_phase<pg8::EpiResid, pg8::StaticOrder, true, true>(L, g, S, E); }
    GRID_BAR();
    if (PH(1)) { PHASE_IDS; norm_phase<false, true, false>(X, nullptr, H, normg + 1 * D, mod + 0 * MODL, 3 * D, nullptr, nullptr, nullptr, nullptr, nullptr, nullptr, nullptr, nullptr, L, vcu, G, wave, lane, tid); }
    GRID_BAR();
    if (PH(5)) { pg8::Gemm g{H, W13_0, MTOK, 2 * DFF, D}; pg8::StaticOrder S; S.init(MTOK, 2 * DFF, G, bx);
      pg8::EpiSwiglu E{ACT, DFF, 1 << 20};
      pg8::gemm_phase<pg8::EpiSwiglu, pg8::StaticOrder, true, true>(L, g, S, E); }
    GRID_BAR();
    if (PH(4)) { pg8::Gemm g{ACT, W2_0, MTOK, D, DFF}; pg8::StaticOrder S; S.init(MTOK, D, G, bx);
      pg8::EpiResid E{X, X, mod + 0 * MODL + 5 * D};
      pg8::gemm_phase<pg8::EpiResid, pg8::StaticOrder, true, true>(L, g, S, E); }
    GRID_BAR();

    if (PH(1)) { PHASE_IDS; norm_phase<false, true, false>(X, nullptr, H, normg + 2 * D, mod + 1 * MODL, 0, nullptr, nullptr, nullptr, nullptr, nullptr, nullptr, nullptr, nullptr, L, vcu, G, wave, lane, tid); }
    GRID_BAR();
    if (PH(6)) { pg8::Gemm g{H, WIN, MTOK, 2 * SGH, D}; pg8::StaticOrder S; S.init(MTOK, 2 * SGH, G, bx);
      pg8::EpiGeluSG E{Ub, Vg, vpart};
      pg8::gemm_phase<pg8::EpiGeluSG, pg8::StaticOrder, true, true>(L, g, S, E); }
    GRID_BAR();
    if (PH(7)) { PHASE_IDS; spatial_phase(Ub, Vg, vpart, KIN(I_SGWS), KIN(I_SGBS), KIN(I_SGVG), L, vcu, G, wave, lane, tid); }
    GRID_BAR();
    if (PH(4)) { pg8::Gemm g{Ub, WOUT, MTOK, D, SGH}; pg8::StaticOrder S; S.init(MTOK, D, G, bx);
      pg8::EpiResid E{X, X, mod + 1 * MODL + 2 * D};
      pg8::gemm_phase<pg8::EpiResid, pg8::StaticOrder, true, true>(L, g, S, E); }
    GRID_BAR();
    if (PH(8)) { PHASE_IDS; norm_phase<false, true, true>(X, nullptr, H, normg + 3 * D, mod + 1 * MODL, 3 * D, nullptr, nullptr, nullptr, KIN(I_MOEWR), KIN(I_MOEBR), ctl + CW_CNT, troute, tw, L, vcu, G, wave, lane, tid); }
    GRID_BAR();
    if (PH(9)) { PHASE_IDS; gather_phase(H, AS, rowinfo, troute, ctl + CW_CNT, vcu, G, wave, lane, tid); }
    GRID_BAR();
    if (PH(10)) { pg8::moe_order_setup((LAS int*)(L + MISC_OFF + 64), ctl + CW_CNT); pg8::MoeOrder S{(const LAS int*)(L + MISC_OFF + 64), 2 * DFE / 256, G, bx}; pg8::Gemm g{AS, MOE13, 0, 0, D};
      pg8::EpiSwiglu E{ACT, DFE, 2 * DFE / 256};
      pg8::gemm_phase<pg8::EpiSwiglu, pg8::MoeOrder, true, true>(L, g, S, E); }
    GRID_BAR();
    if (PH(11)) { pg8::moe_order_setup((LAS int*)(L + MISC_OFF + 64), ctl + CW_CNT); pg8::MoeOrder S{(const LAS int*)(L + MISC_OFF + 64), D / 256, G, bx}; pg8::Gemm g{ACT, MOE2, 0, 0, DFE};
      pg8::EpiMoeOut E{YB, rowinfo, MTOK};
      pg8::gemm_phase<pg8::EpiMoeOut, pg8::MoeOrder, true, true>(L, g, S, E); }
    GRID_BAR();

    if (PH(0)) { PHASE_IDS;
        LAS float* scr = (LAS float*)(L + 65536 + wave * 8448);
        for (int it = gwi; it < IT_MOE; it += NGW)
            moe_conv_item(it, KIN(I_MOEW1) + (size_t)NEXP * D * DFE, KIN(I_MOEW3) + (size_t)NEXP * D * DFE, KIN(I_MOEW2) + (size_t)NEXP * DFE * D, MOE13, MOE2, scr, lane);
    }
    if (PH(12)) { PHASE_IDS; norm_phase<true, true, false>(X, X, H, normg + 4 * D, mod + 2 * MODL, 0, mod + 1 * MODL + 5 * D, YB, tw, nullptr, nullptr, nullptr, nullptr, nullptr, L, vcu, G, wave, lane, tid); }
    GRID_BAR();
    if (PH(2)) { pg8::Gemm g{H, WQKVC, MTOK, 3 * D, D}; pg8::StaticOrder S; S.init(MTOK, 3 * D, G, bx);
      pg8::EpiQKV E{Qb, gains + 384};
      pg8::gemm_phase<pg8::EpiQKV, pg8::StaticOrder, true, true>(L, g, S, E); }
    GRID_BAR();
    if (PH(13)) { PHASE_IDS; attn_phase<1>(Qb, Kb, Vb, H, KIN(I_CARELB), L, vcu, G, wave, lane, tid); }
    GRID_BAR();
    if (PH(4)) { pg8::Gemm g{H, WOC, MTOK, D, D}; pg8::StaticOrder S; S.init(MTOK, D, G, bx);
      pg8::EpiResid E{X, X, mod + 2 * MODL + 2 * D};
      pg8::gemm_phase<pg8::EpiResid, pg8::StaticOrder, true, true>(L, g, S, E); }
    GRID_BAR();
    if (PH(1)) { PHASE_IDS; norm_phase<false, true, false>(X, nullptr, H, normg + 5 * D, mod + 2 * MODL, 3 * D, nullptr, nullptr, nullptr, nullptr, nullptr, nullptr, nullptr, nullptr, L, vcu, G, wave, lane, tid); }
    GRID_BAR();
    if (PH(5)) { pg8::Gemm g{H, W13_1, MTOK, 2 * DFF, D}; pg8::StaticOrder S; S.init(MTOK, 2 * DFF, G, bx);
      pg8::EpiSwiglu E{ACT, DFF, 1 << 20};
      pg8::gemm_phase<pg8::EpiSwiglu, pg8::StaticOrder, true, true>(L, g, S, E); }
    GRID_BAR();
    if (PH(4)) { pg8::Gemm g{ACT, W2_1, MTOK, D, DFF}; pg8::StaticOrder S; S.init(MTOK, D, G, bx);
      pg8::EpiResid E{X, X, mod + 2 * MODL + 5 * D};
      pg8::gemm_phase<pg8::EpiResid, pg8::StaticOrder, true, true>(L, g, S, E); }
    GRID_BAR();

    if (PH(1)) { PHASE_IDS; norm_phase<false, true, false>(X, nullptr, H, normg + 6 * D, mod + 3 * MODL, 0, nullptr, nullptr, nullptr, nullptr, nullptr, nullptr, nullptr, nullptr, L, vcu, G, wave, lane, tid); }
    GRID_BAR();
    if (PH(2)) { pg8::Gemm g{H, WQKV1, MTOK, 3 * D, D}; pg8::StaticOrder S; S.init(MTOK, 3 * D, G, bx);
      pg8::EpiQKV E{Qb, gains + 192};
      pg8::gemm_phase<pg8::EpiQKV, pg8::StaticOrder, true, true>(L, g, S, E); }
    GRID_BAR();
    if (PH(3)) { PHASE_IDS; attn_phase<0>(Qb, Kb, Vb, H, nullptr, L, vcu, G, wave, lane, tid); }
    GRID_BAR();
    if (PH(4)) { pg8::Gemm g{H, WO1, MTOK, D, D}; pg8::StaticOrder S; S.init(MTOK, D, G, bx);
      pg8::EpiResid E{X, X, mod + 3 * MODL + 2 * D};
      pg8::gemm_phase<pg8::EpiResid, pg8::StaticOrder, true, true>(L, g, S, E); }
    GRID_BAR();
    if (PH(8)) { PHASE_IDS; norm_phase<false, true, true>(X, nullptr, H, normg + 7 * D, mod + 3 * MODL, 3 * D, nullptr, nullptr, nullptr, KIN(I_MOEWR) + D * NEXP, KIN(I_MOEBR) + NEXP, ctl + CW_CNT + 8 * 64, troute, tw, L, vcu, G, wave, lane, tid); }
    GRID_BAR();
    if (PH(9)) { PHASE_IDS; gather_phase(H, AS, rowinfo, troute, ctl + CW_CNT + 8 * 64, vcu, G, wave, lane, tid); }
    GRID_BAR();
    if (PH(10)) { pg8::moe_order_setup((LAS int*)(L + MISC_OFF + 64), ctl + CW_CNT + 8 * 64); pg8::MoeOrder S{(const LAS int*)(L + MISC_OFF + 64), 2 * DFE / 256, G, bx}; pg8::Gemm g{AS, MOE13, 0, 0, D};
      pg8::EpiSwiglu E{ACT, DFE, 2 * DFE / 256};
      pg8::gemm_phase<pg8::EpiSwiglu, pg8::MoeOrder, true, true>(L, g, S, E); }
    GRID_BAR();
    if (PH(11)) { pg8::moe_order_setup((LAS int*)(L + MISC_OFF + 64), ctl + CW_CNT + 8 * 64); pg8::MoeOrder S{(const LAS int*)(L + MISC_OFF + 64), D / 256, G, bx}; pg8::Gemm g{ACT, MOE2, 0, 0, DFE};
      pg8::EpiMoeOut E{YB, rowinfo, MTOK};
      pg8::gemm_phase<pg8::EpiMoeOut, pg8::MoeOrder, true, true>(L, g, S, E); }
    GRID_BAR();
    if (PH(14)) { PHASE_IDS; norm_phase<true, false, false>(X, X, nullptr, nullptr, nullptr, 0, mod + 3 * MODL + 5 * D, YB, tw, nullptr, nullptr, nullptr, nullptr, nullptr, L, vcu, G, wave, lane, tid); }
#undef GRID_BAR
#undef PHASE_IDS
#undef mod
#undef gains
#undef WQKV0
#undef WQKV1
#undef WQKVC
#undef WO0
#undef WO1
#undef WOC
#undef WIN
#undef WOUT
#undef W13_0
#undef W13_1
#undef W2_0
#undef W2_1
#undef MOE13
#undef MOE2
#undef H
#undef AS
#undef YB
#undef ACT
#undef Qb
#undef Kb
#undef Vb
#undef Ub
#undef Vg
#undef rowinfo
#undef troute
#undef tw
#undef vpart
#undef X
#undef x_in
#undef normg
#undef ctl
}

extern "C" void kernel_launch(void* const* d_in, const int* in_sizes, int n_in, void* d_out, int out_size, void* d_ws, size_t ws_size, hipStream_t stream) {
    static int grid = 0;
    if (grid == 0) {
        if (n_in != 26 || in_sizes[0] != MTOK * D || out_size != MTOK * D || ws_size < WS_END) { fprintf(stderr, "kernel_launch: unexpected shapes (n_in %d, in0 %d, out %d, ws %zu < %zu)\n", n_in, n_in > 0 ? in_sizes[0] : -1, out_size, ws_size, (size_t)WS_END); grid = -1; return; }
        int dev = 0, cus = 0, per_cu = 0;
        if (hipGetDevice(&dev) != hipSuccess || hipDeviceGetAttribute(&cus, hipDeviceAttributeMultiprocessorCount, dev) != hipSuccess) { grid = -1; return; }
        if (hipFuncSetAttribute((const void*)fwd_kernel, hipFuncAttributeMaxDynamicSharedMemorySize, LDS_BYTES) != hipSuccess) { fprintf(stderr, "kernel_launch: hipFuncSetAttribute failed\n"); grid = -1; return; }
        if (hipOccupancyMaxActiveBlocksPerMultiprocessor(&per_cu, (const void*)fwd_kernel, NWAVES * 64, LDS_BYTES) != hipSuccess || per_cu < 1) { fprintf(stderr, "kernel_launch: occupancy query says %d\n", per_cu); }
        (void)hipGetLastError();
        grid = cus;
    }
    if (grid < 0) return;
    if (hipMemsetAsync((char*)d_ws + WS_CTL, 0, CTL_ZERO_BYTES, stream) != hipSuccess) return;
    Args a{};
    for (int i = 0; i < 26; ++i) a.in[i] = (const float*)d_in[i];
    a.out = (float*)d_out; a.ws = (unsigned char*)d_ws;
    hipLaunchKernelGGL(fwd_kernel, dim3(grid), dim3(NWAVES * 64), LDS_BYTES, stream, a);
}
```

```cpp
#include <hip/hip_runtime.h>
#include <cstdio>
#include <cstdint>
namespace pg8 {
#define PG8_LAS __attribute__((address_space(3)))
typedef unsigned short bf16_t;
typedef short bf16x8 __attribute__((ext_vector_type(8)));
typedef float f32x4 __attribute__((ext_vector_type(4)));
typedef unsigned u32x4 __attribute__((ext_vector_type(4)));
constexpr int BM = 256, BK = 64, HALF = 128, HTB = HALF * BK * 2  , STAGE_BYTES = 8 * HTB, NXCD = 8, WGM = 8;

__host__ __device__ __forceinline__ int lds_byte(int r, int c) { const int st = (r >> 4) * 2 + (c >> 5), rr = r & 15, cc = c & 31, ob = rr * 64 + cc * 2; return st * 1024 + (ob ^ (((ob >> 9) & 1) << 5)); }
__host__ __device__ __forceinline__ void stage_rc(int b, int& R, int& C) { const int st = b / 1024, sb = b % 1024, swz = sb ^ (((sb >> 9) & 1) << 5); R = (st >> 1) * 16 + swz / 64; C = (st & 1) * 32 + (swz % 64) / 2; }
__host__ __device__ __forceinline__ int perm32(int rho) { const int n = rho >> 4, i = rho & 15; return 8 * (i >> 2) + 4 * n + (i & 3); }

struct Unit { int pm, pn, ko, aux; };
struct Gemm { const bf16_t* A; const bf16_t* Bt; int M, N, K, Kp; };

struct StaticOrder {
    static constexpr bool SPLITK = false;
    int nM, nN, nwg, G, c;
    __host__ __device__ void init(int M, int N, int G_, int c_) { nM = M / BM; nN = N / BM; nwg = nM * nN; G = G_; c = c_; }
    __host__ __device__ bool next(int i, Unit& u) const {
        const long L = (long)i * G + c; if (L >= nwg) return false;
        int wgid = (int)L; { const int q = nwg / NXCD, r = nwg % NXCD, xcd = wgid % NXCD, off = wgid / NXCD; wgid = (xcd < r ? xcd * (q + 1) : r * (q + 1) + (xcd - r) * q) + off; }
        const int nig = WGM * nN, gid = wgid / nig, fm = gid * WGM, gsz = (nM - fm) < WGM ? (nM - fm) : WGM;
        u.pm = fm + ((wgid % nig) % gsz); u.pn = (wgid % nig) / gsz; return true;
    }
    __device__ __forceinline__ void a_ready(const Unit&) const {}
    __device__ __forceinline__ void done(const Unit&) const {}
};

__device__ __forceinline__ unsigned cvt_pk_bf16(float lo, float hi) { unsigned r; asm volatile("v_cvt_pk_bf16_f32 %0, %1, %2" : "=v"(r) : "v"(lo), "v"(hi)); return r; }
typedef float f32x2 __attribute__((ext_vector_type(2)));
typedef long long pg8_i64x2 __attribute__((ext_vector_type(2)));
__device__ __forceinline__ pg8_i64x2 zero128() { long long z0, z1; asm("v_mov_b64 %0, 0" : "=v"(z0)); asm("v_mov_b64 %0, 0" : "=v"(z1)); return (pg8_i64x2){z0, z1}; }
typedef int i32x4 __attribute__((ext_vector_type(4)));
typedef int i32x8 __attribute__((ext_vector_type(8)));
template <class Epi, class Sched, bool ALIGN_EPI = false, bool SP2 = false, bool F8 = false, bool I8 = false>
__device__ __forceinline__ void gemm_phase(PG8_LAS unsigned char* lds, const Gemm g, const Sched& S, const Epi& E) {
    int tid = threadIdx.x; asm volatile("" : "+v"(tid));
    const int wid = __builtin_amdgcn_readfirstlane(tid >> 6), lane = tid & 63, wr = wid >> 2, wc = wid & 3, fr = lane & 15, fq = lane >> 4;
    const int nt = g.K / BK, K = Sched::SPLITK ? g.Kp : g.K;
    unsigned voffA[2], voffB[2];
#pragma unroll
    for (int i = 0; i < 2; ++i) { int R, C; stage_rc(tid * 16 + i * 8192, R, C); const int Rb = Epi::PERM ? ((R & ~31) + perm32(R & 31)) : R;
        voffA[i] = (unsigned)(R * K + C) * 2u; voffB[i] = (unsigned)(Rb * K + C) * 2u; }
    const size_t kstep = (size_t)(BK * 2);
    const size_t hstep = (size_t)HALF * K * 2;
    const size_t tstep = 2 * hstep;
    const unsigned ldsw = (unsigned)wid * 1024u;
    const int aoff = lds_byte(wr * 64 + fr, fq * 8), boff = lds_byte(wc * 32 + fr, fq * 8);
#define PG8_SA(b, h) (((b) * 2 + (h)) * HTB)
#define PG8_SB(b, h) ((4 + (b) * 2 + (h)) * HTB)
#define PG8_STAGE(bufoff, gbase, voff) do { _Pragma("unroll") for (int _i = 0; _i < 2; ++_i) \
        __builtin_amdgcn_global_load_lds((const unsigned*)((const char*)(gbase) + (voff)[_i]), (PG8_LAS unsigned*)(lds + (bufoff) + ldsw + _i * 8192), 16, 0, 0); } while (0)
#define PG8_LDA(dst, b, h) do { if constexpr (F8) { _Pragma("unroll") for (int m = 0; m < 4; ++m) dst##8[m] = __builtin_shufflevector(*(const PG8_LAS i32x4*)(lds + PG8_SA(b, h) + aoff + m * 2048), *(const PG8_LAS i32x4*)(lds + PG8_SA(b, h) + aoff + m * 2048 + 1024), 0, 1, 2, 3, 4, 5, 6, 7); } \
        else { _Pragma("unroll") for (int m = 0; m < 4; ++m) _Pragma("unroll") for (int k = 0; k < 2; ++k) dst[m][k] = *(const PG8_LAS bf16x8*)(lds + PG8_SA(b, h) + aoff + m * 2048 + k * 1024); } } while (0)
#define PG8_LDB(dst, b, h) do { if constexpr (F8) { _Pragma("unroll") for (int n = 0; n < 2; ++n) dst##8[n] = __builtin_shufflevector(*(const PG8_LAS i32x4*)(lds + PG8_SB(b, h) + boff + n * 2048), *(const PG8_LAS i32x4*)(lds + PG8_SB(b, h) + boff + n * 2048 + 1024), 0, 1, 2, 3, 4, 5, 6, 7); } \
        else { _Pragma("unroll") for (int n = 0; n < 2; ++n) _Pragma("unroll") for (int k = 0; k < 2; ++k) dst[n][k] = *(const PG8_LAS bf16x8*)(lds + PG8_SB(b, h) + boff + n * 2048 + k * 1024); } } while (0)
#define PG8_MMA(ai, bj, At, Bt) do { __builtin_amdgcn_s_setprio(1); _Pragma("unroll") for (int m = 0; m < 4; ++m) _Pragma("unroll") for (int n = 0; n < 2; ++n) { \
        if constexpr (F8) { f32x4 c_; _Pragma("unroll") for (int j_ = 0; j_ < 4; ++j_) c_[j_] = accv[ai][bj][m >> 1][4 * ((m & 1) * 2 + n) + j_]; \
            c_ = __builtin_amdgcn_mfma_scale_f32_16x16x128_f8f6f4(Bt##8[n], At##8[m], c_, 0, 0, 0, 0x7F7F7F7F, 0, 0x7F7F7F7F); \
            _Pragma("unroll") for (int j_ = 0; j_ < 4; ++j_) accv[ai][bj][m >> 1][4 * ((m & 1) * 2 + n) + j_] = c_[j_]; } \
        else if constexpr (I8) { _Pragma("unroll") for (int k = 0; k < 2; ++k) acci[ai][bj][m][n] = __builtin_amdgcn_mfma_i32_16x16x64_i8(__builtin_bit_cast(i32x4, Bt[n][k]), __builtin_bit_cast(i32x4, At[m][k]), acci[ai][bj][m][n], 0, 0, 0); } \
        else { _Pragma("unroll") for (int k = 0; k < 2; ++k) acc[ai][bj][m][n] = __builtin_amdgcn_mfma_f32_16x16x32_bf16(Bt[n][k], At[m][k], acc[ai][bj][m][n], 0, 0, 0); } } \
        __builtin_amdgcn_s_setprio(0); } while (0)
#define PG8_WAIT_V(n) asm volatile("s_waitcnt vmcnt(" #n ")" ::: "memory")
#define PG8_WAIT_L(n) asm volatile("s_waitcnt lgkmcnt(" #n ")" ::: "memory")
#define PG8_BAR __builtin_amdgcn_s_barrier()
#define PG8_SCHED __builtin_amdgcn_sched_barrier(0)
    Unit cur, nxt; int ui = 0;
    if (!S.next(0, cur)) return;
    f32x4 acc[2][2][4][2];
    i32x4 acci[2][2][4][2];
#pragma unroll
    for (int a = 0; a < 2; ++a)
#pragma unroll
        for (int b = 0; b < 2; ++b)
#pragma unroll
            for (int m = 0; m < 4; ++m)
#pragma unroll
                for (int n = 0; n < 2; ++n) acci[a][b][m][n] = (i32x4){0, 0, 0, 0};
    typedef float f32x16v __attribute__((ext_vector_type(16)));
    f32x16v accv[2][2][2];
#pragma unroll
    for (int a = 0; a < 2; ++a)
#pragma unroll
        for (int b = 0; b < 2; ++b)
#pragma unroll
            for (int q = 0; q < 2; ++q)
#pragma unroll
                for (int j = 0; j < 16; ++j) accv[a][b][q][j] = 0.f;
#pragma unroll
    for (int a = 0; a < 2; ++a)
#pragma unroll
        for (int b = 0; b < 2; ++b)
#pragma unroll
            for (int m = 0; m < 4; ++m)
#pragma unroll
                for (int n = 0; n < 2; ++n) acc[a][b][m][n] = (f32x4){0.f, 0.f, 0.f, 0.f};
    bf16x8 At[4][2], B0[2][2], B1[2][2]; i32x8 At8[4], B08[2], B18[2]; (void)At; (void)B0; (void)B1; (void)At8; (void)B08; (void)B18;
    const char* cA = (const char*)g.A + (size_t)cur.pm * tstep; const char* cB = (const char*)g.Bt + (size_t)cur.pn * tstep;
    if constexpr (Sched::SPLITK) { cA += cur.ko; cB += cur.ko; }
    S.a_ready(cur);
    if constexpr (SP2) {
        PG8_STAGE(PG8_SB(0, 0), cB, voffB); PG8_STAGE(PG8_SB(0, 1), cB + hstep, voffB); PG8_STAGE(PG8_SA(0, 0), cA, voffA); PG8_STAGE(PG8_SA(0, 1), cA + hstep, voffA);
        if (wr == 1) PG8_BAR;
        PG8_WAIT_V(2); PG8_BAR;
        PG8_STAGE(PG8_SB(1, 0), cB + kstep, voffB); PG8_STAGE(PG8_SA(1, 0), cA + kstep, voffA); PG8_STAGE(PG8_SB(1, 1), cB + hstep + kstep, voffB);
        PG8_WAIT_V(6); PG8_BAR;
    } else {
        PG8_STAGE(PG8_SB(0, 0), cB, voffB); PG8_STAGE(PG8_SA(0, 0), cA, voffA); PG8_STAGE(PG8_SB(0, 1), cB + hstep, voffB); PG8_STAGE(PG8_SA(0, 1), cA + hstep, voffA);
        if (wr == 1) PG8_BAR;
        PG8_WAIT_V(4); PG8_BAR;
        PG8_STAGE(PG8_SB(1, 0), cB + kstep, voffB); PG8_STAGE(PG8_SA(1, 0), cA + kstep, voffA); PG8_STAGE(PG8_SB(1, 1), cB + hstep + kstep, voffB);
        PG8_WAIT_V(6); PG8_BAR;
    }
    for (;;) {
        const bool has_next = S.next(ui + 1, nxt);
        const char* nA = has_next ? (const char*)g.A + (size_t)nxt.pm * tstep + (Sched::SPLITK ? nxt.ko : 0) : cA; const char* nB = has_next ? (const char*)g.Bt + (size_t)nxt.pn * tstep + (Sched::SPLITK ? nxt.ko : 0) : cB;
#pragma nounroll
        for (int t = 0; t < nt; t += 2) {
            const bool last = (t == nt - 2);
            const char* a1 = cA + (size_t)(t + 1) * kstep;
            const char* a2 = last ? nA : cA + (size_t)(t + 2) * kstep; const char* b2 = last ? nB : cB + (size_t)(t + 2) * kstep;
            const char* a3 = a2 + kstep; const char* b3 = b2 + kstep;
            if (last && has_next) S.a_ready(nxt);
            if constexpr (SP2) {
            PG8_LDB(B0, 0, 0); PG8_LDB(B1, 0, 1); PG8_SCHED; PG8_LDA(At, 0, 0); PG8_STAGE(PG8_SA(1, 1), a1 + hstep, voffA);
            PG8_WAIT_V(8); PG8_WAIT_L(0); PG8_BAR; PG8_MMA(0, 0, At, B0); PG8_MMA(0, 1, At, B1); PG8_BAR; PG8_SCHED;
            PG8_LDA(At, 0, 1); PG8_STAGE(PG8_SB(0, 0), b2, voffB); PG8_STAGE(PG8_SB(0, 1), b2 + hstep, voffB); PG8_STAGE(PG8_SA(0, 0), a2, voffA);
            PG8_WAIT_V(8); PG8_WAIT_L(0); PG8_BAR; PG8_MMA(1, 0, At, B0); PG8_MMA(1, 1, At, B1); PG8_BAR; PG8_SCHED;
            PG8_LDB(B0, 1, 0); PG8_LDB(B1, 1, 1); PG8_SCHED; PG8_LDA(At, 1, 0); PG8_STAGE(PG8_SA(0, 1), a2 + hstep, voffA);
            PG8_WAIT_V(8); PG8_WAIT_L(0); PG8_BAR; PG8_MMA(0, 0, At, B0); PG8_MMA(0, 1, At, B1); PG8_BAR; PG8_SCHED;
            PG8_LDA(At, 1, 1); PG8_STAGE(PG8_SB(1, 0), b3, voffB); PG8_STAGE(PG8_SB(1, 1), b3 + hstep, voffB); PG8_STAGE(PG8_SA(1, 0), a3, voffA);
            PG8_WAIT_V(8); PG8_WAIT_L(0); PG8_BAR; PG8_MMA(1, 0, At, B0); PG8_MMA(1, 1, At, B1); PG8_BAR; PG8_SCHED;
            } else {
            PG8_LDB(B0, 0, 0); PG8_SCHED; PG8_LDA(At, 0, 0); PG8_STAGE(PG8_SA(1, 1), a1 + hstep, voffA);
            PG8_WAIT_L(8); PG8_BAR; PG8_WAIT_L(0); PG8_MMA(0, 0, At, B0); PG8_BAR; PG8_SCHED;
            PG8_LDB(B1, 0, 1); PG8_STAGE(PG8_SB(0, 0), b2, voffB);
            PG8_BAR; PG8_WAIT_L(0); PG8_MMA(0, 1, At, B1); PG8_BAR;
            PG8_LDA(At, 0, 1); PG8_STAGE(PG8_SA(0, 0), a2, voffA);
            PG8_BAR; PG8_WAIT_L(0); PG8_MMA(1, 0, At, B0); PG8_BAR; PG8_SCHED;
            PG8_STAGE(PG8_SB(0, 1), b2 + hstep, voffB);
            PG8_WAIT_V(6); PG8_BAR; PG8_MMA(1, 1, At, B1); PG8_BAR;
            PG8_LDB(B0, 1, 0); PG8_SCHED; PG8_LDA(At, 1, 0); PG8_STAGE(PG8_SA(0, 1), a2 + hstep, voffA);
            PG8_WAIT_L(8); PG8_BAR; PG8_WAIT_L(0); PG8_MMA(0, 0, At, B0); PG8_BAR; PG8_SCHED;
            PG8_LDB(B1, 1, 1); PG8_STAGE(PG8_SB(1, 0), b3, voffB);
            PG8_BAR; PG8_WAIT_L(0); PG8_MMA(0, 1, At, B1); PG8_BAR;
            PG8_LDA(At, 1, 1); PG8_STAGE(PG8_SA(1, 0), a3, voffA);
            PG8_BAR; PG8_WAIT_L(0); PG8_MMA(1, 0, At, B0); PG8_BAR; PG8_SCHED;
            PG8_STAGE(PG8_SB(1, 1), b3 + hstep, voffB);
            PG8_WAIT_V(6); PG8_BAR; PG8_MMA(1, 1, At, B1); PG8_BAR;
            }
        }
        if constexpr (ALIGN_EPI) { if (wr == 0) PG8_BAR; }
        if constexpr (F8) {
#pragma unroll
            for (int a = 0; a < 2; ++a)
#pragma unroll
                for (int b = 0; b < 2; ++b)
#pragma unroll
                    for (int m = 0; m < 4; ++m)
#pragma unroll
                        for (int n = 0; n < 2; ++n)
#pragma unroll
                            for (int j = 0; j < 4; ++j) { acc[a][b][m][n][j] = accv[a][b][m >> 1][4 * ((m & 1) * 2 + n) + j]; accv[a][b][m >> 1][4 * ((m & 1) * 2 + n) + j] = 0.f; } }
        if constexpr (I8) {
#pragma unroll
            for (int a = 0; a < 2; ++a)
#pragma unroll
                for (int b = 0; b < 2; ++b)
#pragma unroll
                    for (int m = 0; m < 4; ++m)
#pragma unroll
                        for (int n = 0; n < 2; ++n) { acc[a][b][m][n] = __builtin_convertvector(acci[a][b][m][n], f32x4); acci[a][b][m][n] = __builtin_bit_cast(i32x4, zero128()); } }
        if constexpr (!Epi::AFTER_DRAIN) { int tid2 = threadIdx.x; asm volatile("" : "+v"(tid2));
            E(acc, cur, wr, wc, tid2 & 15, (tid2 & 63) >> 4); S.done(cur); }
        if (!has_next) break;
#pragma unroll
        for (int a = 0; a < 2; ++a)
#pragma unroll
            for (int b = 0; b < 2; ++b)
#pragma unroll
                for (int m = 0; m < 4; ++m)
#pragma unroll
                    for (int n = 0; n < 2; ++n) acc[a][b][m][n] = __builtin_bit_cast(f32x4, zero128());
        cur = nxt; cA = nA; cB = nB; ++ui;
        if constexpr (ALIGN_EPI) { if (wr == 1) PG8_BAR; }
    }
    PG8_WAIT_V(0);
    if constexpr (!ALIGN_EPI) { if (wr == 0) PG8_BAR; }
    PG8_BAR;
    if constexpr (Epi::AFTER_DRAIN) { E.fused(acc, cur, wr, wc, fr, fq, lds, wid, lane); S.done(cur); }
#undef PG8_SA
#undef PG8_SB
#undef PG8_STAGE
#undef PG8_LDA
#undef PG8_LDB
#undef PG8_MMA
#undef PG8_WAIT_V
#undef PG8_WAIT_L
#undef PG8_BAR
#undef PG8_SCHED
}
}
namespace pg8 {
__device__ __forceinline__ float ex2(float x) { return __builtin_amdgcn_exp2f(x); }
__device__ __forceinline__ float rcp(float x) { return __builtin_amdgcn_rcpf(x); }
__device__ __forceinline__ float silu_f(float a) { return a * rcp(1.0f + ex2(a * -1.4426950408889634f)); }
__device__ __forceinline__ float gelu_t(float x) { const float w = __builtin_fmaf(x * x, 0.044715f * -2.3022081981405e+00f, -2.3022081981405e+00f); return x * rcp(1.0f + ex2(x * w)); }
__device__ __forceinline__ u32x4 pack8(const f32x4 a, const f32x4 b) { u32x4 w; w.x = cvt_pk_bf16(a[0], a[1]); w.y = cvt_pk_bf16(a[2], a[3]); w.z = cvt_pk_bf16(b[0], b[1]); w.w = cvt_pk_bf16(b[2], b[3]); return w; }

struct EpiQKV {
    static constexpr bool PERM = true, AFTER_DRAIN = false;
    bf16_t* QKV; const float* gains; const float* rs; const float* cs;
    __device__ __forceinline__ void operator()(const f32x4 (&acc)[2][2][4][2], const Unit& u, int wr, int wc, int fr, int fq) const {
        const int t = u.pn >> 2, head = (u.pn & 3) * 4 + wc;
        bf16_t* base = QKV + (size_t)t * ((size_t)32768 * 1024);
        const int row0 = u.pm * BM + wr * 64 + fr, col0 = head * 64 + 8 * fq;
        f32x4 gv[2][2], cv[2][2];
        const float* g = gains + 64 * t; const float* cp = cs + (size_t)u.pn * BM + wc * 32 + 8 * fq;
#pragma unroll
        for (int bj = 0; bj < 2; ++bj)
#pragma unroll
            for (int n = 0; n < 2; ++n) { gv[bj][n] = *(const f32x4*)(g + 32 * bj + 8 * fq + 4 * n); cv[bj][n] = *(const f32x4*)(cp + bj * HALF + 4 * n); }
#pragma unroll
        for (int ai = 0; ai < 2; ++ai)
#pragma unroll
            for (int m = 0; m < 4; ++m) { const int row = row0 + ai * HALF + m * 16; const float rsc = rs[row];
                f32x4 x[2][2]; float ss = 0.f;
#pragma unroll
                for (int bj = 0; bj < 2; ++bj)
#pragma unroll
                    for (int n = 0; n < 2; ++n) { x[bj][n] = acc[ai][bj][m][n] * cv[bj][n]; const f32x4 v = x[bj][n]; ss = __builtin_fmaf(v[0], v[0], __builtin_fmaf(v[1], v[1], __builtin_fmaf(v[2], v[2], __builtin_fmaf(v[3], v[3], ss)))); }
                ss += __shfl_xor(ss, 16); ss += __shfl_xor(ss, 32);
                const float r = rsc * (t < 2 ? __builtin_amdgcn_rsqf(ss * rsc * rsc * (1.0f / 64.0f) + 1e-6f) : 1.0f);
                bf16_t* rowp = base + (size_t)row * 1024 + col0;
#pragma unroll
                for (int bj = 0; bj < 2; ++bj) *(u32x4*)(rowp + 32 * bj) = pack8(x[bj][0] * (gv[bj][0] * r), x[bj][1] * (gv[bj][1] * r));
            }
    }
};
struct EpiSwiglu {
    static constexpr bool PERM = true, AFTER_DRAIN = false;
    bf16_t* O; int ldc; int ntl;
    __device__ __forceinline__ void operator()(const f32x4 (&acc)[2][2][4][2], const Unit& u, int wr, int wc, int fr, int fq) const {
        const int pnl = u.pn % ntl; const int row0 = u.pm * BM + wr * 64 + fr, col0 = pnl * 128 + wc * 32 + 8 * fq;
#pragma unroll
        for (int ai = 0; ai < 2; ++ai)
#pragma unroll
            for (int m = 0; m < 4; ++m) { bf16_t* rowp = O + (size_t)(row0 + ai * HALF + m * 16) * ldc + col0;
                f32x4 o0, o1;
#pragma unroll
                for (int j = 0; j < 4; ++j) { o0[j] = silu_f(acc[ai][0][m][0][j]) * acc[ai][1][m][0][j]; o1[j] = silu_f(acc[ai][0][m][1][j]) * acc[ai][1][m][1][j]; }
                *(u32x4*)rowp = pack8(o0, o1); }
    }
};
template <bool OUT8 = false> struct EpiSwigluQ {
    static constexpr bool PERM = true, AFTER_DRAIN = false;
    bf16_t* O; int ldc; int ntl; const float* rs; const float* cs;
    __device__ __forceinline__ void operator()(const f32x4 (&acc)[2][2][4][2], const Unit& u, int wr, int wc, int fr, int fq) const {
        const int pnl = u.pn % ntl; const int row0 = u.pm * BM + wr * 64 + fr, col0 = pnl * 128 + wc * 32 + 8 * fq;
        const float* cp = cs + (size_t)u.pn * BM + wc * 32 + 8 * fq;
        const float osc = OUT8 ? 8.0f : 1.0f;
        const f32x4 ca0 = *(const f32x4*)(cp), ca1 = *(const f32x4*)(cp + 4), cg0 = *(const f32x4*)(cp + HALF) * osc, cg1 = *(const f32x4*)(cp + HALF + 4) * osc;
#pragma unroll
        for (int ai = 0; ai < 2; ++ai)
#pragma unroll
            for (int m = 0; m < 4; ++m) { const int row = row0 + ai * HALF + m * 16; const float r = rs[row], rl = r * -1.4426950408889634f, r2 = r * r;
                f32x4 o0, o1;
#pragma unroll
                for (int n = 0; n < 2; ++n) { const f32x4 ca = n ? ca1 : ca0, cg = n ? cg1 : cg0;
#pragma unroll
                    for (int jp = 0; jp < 2; ++jp) { const f32x2 A = (f32x2){acc[ai][0][m][n][2 * jp], acc[ai][0][m][n][2 * jp + 1]} * (f32x2){ca[2 * jp], ca[2 * jp + 1]};
                        const f32x2 Gv = (f32x2){acc[ai][1][m][n][2 * jp], acc[ai][1][m][n][2 * jp + 1]} * (f32x2){cg[2 * jp], cg[2 * jp + 1]};
                        const f32x2 tt = A * rl; f32x2 ev; ev.x = ex2(tt.x); ev.y = ex2(tt.y);
                        const f32x2 dv = ev + 1.0f; f32x2 qv; qv.x = rcp(dv.x); qv.y = rcp(dv.y);
                        const f32x2 ov = (A * Gv) * (qv * r2);
                        if (n == 0) { o0[2 * jp] = ov.x; o0[2 * jp + 1] = ov.y; } else { o1[2 * jp] = ov.x; o1[2 * jp + 1] = ov.y; } } }
                if constexpr (OUT8) {
#pragma unroll
                    for (int j = 0; j < 4; ++j) { o0[j] = __builtin_amdgcn_fmed3f(o0[j], -440.0f, 440.0f); o1[j] = __builtin_amdgcn_fmed3f(o1[j], -440.0f, 440.0f); }
                    int w0 = 0, w1 = 0; w0 = __builtin_amdgcn_cvt_pk_fp8_f32(o0[0], o0[1], w0, false); w0 = __builtin_amdgcn_cvt_pk_fp8_f32(o0[2], o0[3], w0, true);
                    w1 = __builtin_amdgcn_cvt_pk_fp8_f32(o1[0], o1[1], w1, false); w1 = __builtin_amdgcn_cvt_pk_fp8_f32(o1[2], o1[3], w1, true);
                    typedef int i32x2v __attribute__((ext_vector_type(2)));
                    *(i32x2v*)((unsigned char*)O + (size_t)row * ldc + col0) = (i32x2v){w0, w1};
                } else { bf16_t* rowp = O + (size_t)row * ldc + col0; *(u32x4*)rowp = pack8(o0, o1); } }
    }
};
typedef EpiSwigluQ<false> EpiSwigluF8;
struct EpiGeluSG {
    static constexpr bool PERM = true, AFTER_DRAIN = false;
    bf16_t* U; bf16_t* V; float* vpart; const float* rs; const float* cs;
    __device__ __forceinline__ void operator()(const f32x4 (&acc)[2][2][4][2], const Unit& u, int wr, int wc, int fr, int fq) const {
        const bool isv = u.pn >= 12; const int pnl = isv ? u.pn - 12 : u.pn; bf16_t* base = isv ? V : U;
        const int row0 = u.pm * BM + wr * 64 + fr, col0 = pnl * BM + wc * 32 + 8 * fq;
        const float* cp = cs + (size_t)u.pn * BM + wc * 32 + 8 * fq;
        f32x4 cv[2][2];
#pragma unroll
        for (int bj = 0; bj < 2; ++bj)
#pragma unroll
            for (int n = 0; n < 2; ++n) cv[bj][n] = *(const f32x4*)(cp + bj * HALF + 4 * n);
#pragma unroll
        for (int ai = 0; ai < 2; ++ai)
#pragma unroll
            for (int m = 0; m < 4; ++m) { const int row = row0 + ai * HALF + m * 16; const float rsc = rs[row]; bf16_t* rowp = base + (size_t)row * 3072 + col0; float ss = 0.f; f32x2 ss2 = (f32x2){0.f, 0.f};
#pragma unroll
                for (int bj = 0; bj < 2; ++bj) { f32x4 z0, z1; const f32x4 s0 = cv[bj][0] * rsc, s1 = cv[bj][1] * rsc;
#pragma unroll
                    for (int n = 0; n < 2; ++n) { const f32x4 sv = n ? s1 : s0;
#pragma unroll
                        for (int jp = 0; jp < 2; ++jp) {
                            const f32x2 x = (f32x2){acc[ai][bj][m][n][2 * jp], acc[ai][bj][m][n][2 * jp + 1]} * (f32x2){sv[2 * jp], sv[2 * jp + 1]};
                            const f32x2 w = (x * x) * (0.044715f * -2.3022081981405e+00f) + (-2.3022081981405e+00f), tt = x * w;
                            f32x2 ev; ev.x = ex2(tt.x); ev.y = ex2(tt.y); const f32x2 dv = ev + 1.0f; f32x2 qv; qv.x = rcp(dv.x); qv.y = rcp(dv.y);
                            const f32x2 z = x * qv; ss2 = z * z + ss2;
                            if (n == 0) { z0[2 * jp] = z.x; z0[2 * jp + 1] = z.y; } else { z1[2 * jp] = z.x; z1[2 * jp + 1] = z.y; } } }
                    *(u32x4*)(rowp + bj * HALF) = pack8(z0, z1); }
                ss = ss2.x + ss2.y;
                if (isv) { ss += __shfl_xor(ss, 16); ss += __shfl_xor(ss, 32); if (fq == 0) vpart[(size_t)row * 48 + pnl * 4 + wc] = ss; } }
    }
};
struct EpiResid {
    static constexpr bool PERM = false, AFTER_DRAIN = false;
    const float* xin; float* out; const float* gate; const float* cs;
    __device__ __forceinline__ void operator()(const f32x4 (&acc)[2][2][4][2], const Unit& u, int wr, int wc, int fr, int fq) const {
        const float* gp = gate + (size_t)(u.pm >> 3) * 6144;
        const int row0 = u.pm * BM + wr * 64 + fr, col0 = u.pn * BM + wc * 32 + 4 * fq;
        f32x4 gv[2][2];
#pragma unroll
        for (int bj = 0; bj < 2; ++bj)
#pragma unroll
            for (int n = 0; n < 2; ++n) gv[bj][n] = *(const f32x4*)(gp + col0 + bj * HALF + n * 16) * *(const f32x4*)(cs + col0 + bj * HALF + n * 16);
#pragma unroll
        for (int ai = 0; ai < 2; ++ai)
#pragma unroll
            for (int m = 0; m < 4; ++m) { const size_t off = (size_t)(row0 + ai * HALF + m * 16) * 1024 + col0;
#pragma unroll
                for (int bj = 0; bj < 2; ++bj)
#pragma unroll
                    for (int n = 0; n < 2; ++n) { const f32x4 xv = *(const f32x4*)(xin + off + bj * HALF + n * 16); *(f32x4*)(out + off + bj * HALF + n * 16) = xv + gv[bj][n] * acc[ai][bj][m][n]; } }
    }
};
template <bool XIN32> struct EpiResid16 {
    static constexpr bool PERM = true, AFTER_DRAIN = false;
    const void* xin; bf16_t* out; const float* gate; const float* cs;
    __device__ __forceinline__ void operator()(const f32x4 (&acc)[2][2][4][2], const Unit& u, int wr, int wc, int fr, int fq) const {
        const float* gp = gate + (size_t)(u.pm >> 3) * 6144;
        const int row0 = u.pm * BM + wr * 64 + fr, col0 = u.pn * BM + wc * 32 + 8 * fq;
        f32x4 gv[2][2];
#pragma unroll
        for (int bj = 0; bj < 2; ++bj)
#pragma unroll
            for (int n = 0; n < 2; ++n) gv[bj][n] = *(const f32x4*)(gp + col0 + bj * HALF + 4 * n) * *(const f32x4*)(cs + col0 + bj * HALF + 4 * n);
#pragma unroll
        for (int ai = 0; ai < 2; ++ai)
#pragma unroll
            for (int m = 0; m < 4; ++m) { const size_t off = (size_t)(row0 + ai * HALF + m * 16) * 1024 + col0;
#pragma unroll
                for (int bj = 0; bj < 2; ++bj) { f32x4 x0, x1;
                    if constexpr (XIN32) { x0 = *(const f32x4*)((const float*)xin + off + bj * HALF); x1 = *(const f32x4*)((const float*)xin + off + bj * HALF + 4); }
                    else { const u32x4 w = *(const u32x4*)((const bf16_t*)xin + off + bj * HALF);
                        x0 = (f32x4){__uint_as_float(w.x << 16), __uint_as_float(w.x & 0xffff0000u), __uint_as_float(w.y << 16), __uint_as_float(w.y & 0xffff0000u)};
                        x1 = (f32x4){__uint_as_float(w.z << 16), __uint_as_float(w.z & 0xffff0000u), __uint_as_float(w.w << 16), __uint_as_float(w.w & 0xffff0000u)}; }
                    *(u32x4*)(out + off + bj * HALF) = pack8(x0 + gv[bj][0] * acc[ai][bj][m][0], x1 + gv[bj][1] * acc[ai][bj][m][1]); } }
    }
};
struct EpiMoeOut {
    static constexpr bool PERM = true, AFTER_DRAIN = false;
    bf16_t* Y; const int* rowinfo; int mtok; const float* cs;
    __device__ __forceinline__ void operator()(const f32x4 (&acc)[2][2][4][2], const Unit& u, int wr, int wc, int fr, int fq) const {
        const int row0 = u.pm * BM + wr * 64 + fr, col0 = (u.pn & 3) * BM + wc * 32 + 8 * fq;
        const float* cp = cs + (size_t)u.pn * BM + wc * 32 + 8 * fq;
#pragma unroll
        for (int ai = 0; ai < 2; ++ai)
#pragma unroll
            for (int m = 0; m < 4; ++m) { const int ti = rowinfo[row0 + ai * HALF + m * 16];
                if (ti >= 0) { bf16_t* rowp = Y + ((size_t)(ti & 1) * mtok + (ti >> 1)) * 1024 + col0;
#pragma unroll
                    for (int bj = 0; bj < 2; ++bj) { const f32x4 c0 = *(const f32x4*)(cp + bj * HALF), c1 = *(const f32x4*)(cp + bj * HALF + 4);
                        *(u32x4*)(rowp + bj * HALF) = pack8(acc[ai][bj][m][0] * c0, acc[ai][bj][m][1] * c1); } } }
    }
};
struct MoeOrder {
    static constexpr bool SPLITK = false;
    const PG8_LAS int* pre; int ntl, G, c;
    __device__ __forceinline__ bool next(int i, Unit& u) const {
        StaticOrder so; so.init(__builtin_amdgcn_readfirstlane(pre[8]) * BM, ntl * BM, G, c);
        if (!so.next(i, u)) return false;
        int e = 0;
#pragma unroll
        for (int k = 1; k < 8; ++k) e += (u.pm >= pre[k]) ? 1 : 0;
        u.pn += e * ntl; return true;
    }
    __device__ __forceinline__ void a_ready(const Unit&) const {}
    __device__ __forceinline__ void done(const Unit&) const {}
};
struct MoeOrderLim {
    static constexpr bool SPLITK = false;
    const PG8_LAS int* pre; int ntl, G, c, lim;
    __device__ __forceinline__ bool next(int i, Unit& u) const {
        if (i * G + c >= lim) return false;
        StaticOrder so; so.init(__builtin_amdgcn_readfirstlane(pre[8]) * BM, ntl * BM, G, c);
        if (!so.next(i, u)) return false;
        int e = 0;
#pragma unroll
        for (int k = 1; k < 8; ++k) e += (u.pm >= pre[k]) ? 1 : 0;
        u.pn += e * ntl; return true;
    }
    __device__ __forceinline__ void a_ready(const Unit&) const {}
    __device__ __forceinline__ void done(const Unit&) const {}
};
struct SplitOrder {
    static constexpr bool SPLITK = true;
    const PG8_LAS int* pre; int ntl, c, first, T, S, kbytes;
    __device__ __forceinline__ bool next(int i, Unit& u) const {
        if (i != 0 || c >= T * S) return false;
        const int j = c % T, s = c / T;
        StaticOrder so; so.init(__builtin_amdgcn_readfirstlane(pre[8]) * BM, ntl * BM, 1, first + j);
        if (!so.next(0, u)) return false;
        int e = 0;
#pragma unroll
        for (int k = 1; k < 8; ++k) e += (u.pm >= pre[k]) ? 1 : 0;
        u.pn += e * ntl; u.ko = s * kbytes; u.aux = j | (s << 16); return true;
    }
    __device__ __forceinline__ void a_ready(const Unit&) const {}
    __device__ __forceinline__ void done(const Unit&) const {}
};
struct EpiMoeSplit {
    static constexpr bool PERM = true, AFTER_DRAIN = false;
    EpiMoeOut inner; float* slab; unsigned* cnt; int S;
    __device__ __forceinline__ void operator()(const f32x4 (&acc)[2][2][4][2], const Unit& u, int wr, int wc, int fr, int fq) const {
        const int j = u.aux & 0xffff, s = u.aux >> 16, w = wr * 4 + wc, lane = fr + 16 * fq;
        const __amdgpu_buffer_rsrc_t rs = __builtin_amdgcn_make_buffer_rsrc((void*)slab, (short)0, 0x04000000, 0x00020000);
        const int mybase = (((j * S + s) * 8 + w) * 2048 + lane) * 16;
#pragma unroll
        for (int ai = 0; ai < 2; ++ai)
#pragma unroll
            for (int bj = 0; bj < 2; ++bj)
#pragma unroll
                for (int m = 0; m < 4; ++m)
#pragma unroll
                    for (int n = 0; n < 2; ++n) __builtin_amdgcn_raw_buffer_store_b128(__builtin_bit_cast(u32x4, acc[ai][bj][m][n]), rs, mybase + ((((ai * 2 + bj) * 4 + m) * 2 + n) * 1024), 0, 16);
        asm volatile("s_waitcnt vmcnt(0)" ::: "memory");
        unsigned old = 0;
        if (lane == 0) old = __hip_atomic_fetch_add(cnt + (j * 8 + w) * 4, 1u, __ATOMIC_RELAXED, __HIP_MEMORY_SCOPE_AGENT);
        old = (unsigned)__builtin_amdgcn_readfirstlane((int)old);
        if (old != (unsigned)(S - 1)) return;
        __builtin_amdgcn_fence(__ATOMIC_ACQUIRE, "agent"); asm volatile("s_waitcnt vmcnt(0)" ::: "memory");
        f32x4 tot[2][2][4][2];
#pragma unroll
        for (int ai = 0; ai < 2; ++ai)
#pragma unroll
            for (int bj = 0; bj < 2; ++bj)
#pragma unroll
                for (int m = 0; m < 4; ++m)
#pragma unroll
                    for (int n = 0; n < 2; ++n) tot[ai][bj][m][n] = (f32x4){0.f, 0.f, 0.f, 0.f};
        for (int s2 = 0; s2 < S; ++s2) { const float* p = slab + (size_t)(((j * S + s2) * 8 + w) * 2048 + lane) * 4;
#pragma unroll
            for (int ai = 0; ai < 2; ++ai)
#pragma unroll
                for (int bj = 0; bj < 2; ++bj)
#pragma unroll
                    for (int m = 0; m < 4; ++m)
#pragma unroll
                        for (int n = 0; n < 2; ++n) tot[ai][bj][m][n] += *(const f32x4*)(p + ((((ai * 2 + bj) * 4 + m) * 2 + n) * 256)); }
        inner(tot, u, wr, wc, fr, fq);
    }
};
__device__ __forceinline__ void moe_order_setup(PG8_LAS int* pre, const unsigned* cnt) {
    if (threadIdx.x == 0) { int p = 0; pre[0] = 0;
#pragma unroll
        for (int e = 0; e < 8; ++e) { p += (int)((cnt[64 * e] + 255u) >> 8); pre[e + 1] = p; } }
    __syncthreads();
}
}
#define GAS __attribute__((address_space(1)))
#define LAS __attribute__((address_space(3)))
typedef unsigned short bf16;
typedef unsigned v4u __attribute__((ext_vector_type(4)));
typedef float f32x4 __attribute__((ext_vector_type(4)));
typedef short bf16x8 __attribute__((ext_vector_type(8)));
typedef GAS unsigned gu32;
typedef GAS unsigned long long gu64;
#define RLX_AGENT __ATOMIC_RELAXED, __HIP_MEMORY_SCOPE_AGENT
#define LDS_WAIT() asm volatile("s_waitcnt lgkmcnt(0)" ::: "memory")
#define VM_WAIT() asm volatile("s_waitcnt vmcnt(0)" ::: "memory")
__device__ __forceinline__ unsigned long long rt() { return __builtin_amdgcn_s_memrealtime(); }
__device__ __forceinline__ unsigned f2bf(float f) { unsigned u = __builtin_bit_cast(unsigned, f); return (u + 0x7fffu + ((u >> 16) & 1u)) >> 16; }
__device__ __forceinline__ unsigned pk2(float lo, float hi) { return f2bf(lo) | (f2bf(hi) << 16); }
#define XB_TMO      128
#define XB_XCNT(j)  (256  + 64 * (j))
#define XB_XSUB(j)  (1280 + 64 * (j))
#define XB_XGEN(j)  (2304 + 64 * (j))
#define XB_TOP      3328
#define XB_TOPGEN   3392
#define XCD_BAR_WORDS 3456
#define XB_SPIN_CAP (1u << 22)

__device__ __forceinline__ unsigned xb_ld(unsigned* p)              { return __hip_atomic_load(p, __ATOMIC_RELAXED, __HIP_MEMORY_SCOPE_AGENT); }
__device__ __forceinline__ unsigned xb_add(unsigned* p, unsigned v) { return __hip_atomic_fetch_add(p, v, __ATOMIC_RELAXED, __HIP_MEMORY_SCOPE_AGENT); }
__device__ __forceinline__ unsigned xb_xcc_id() { return (unsigned)__builtin_amdgcn_s_getreg((3 << 11) | 20) & 0xFu; }
#define XB_SPIN(cond, bar) do { unsigned _sp = 0; while (cond) { __builtin_amdgcn_s_sleep(1); \
    if ((++_sp & 255u) == 0u) { if (xb_ld(&(bar)[XB_TMO])) break; if (_sp > XB_SPIN_CAP) { atomicAdd(&(bar)[XB_TMO], 1u); break; } } } } while (0)

struct XcdBarrier {
    unsigned* bar; unsigned x;
    volatile LAS unsigned* st;
};

__device__ __forceinline__ XcdBarrier xcd_barrier_post(unsigned* bar, volatile LAS unsigned* st) {
    XcdBarrier b; b.bar = bar; b.x = xb_xcc_id(); b.st = st;
    if (threadIdx.x == 0) (void)xb_add(&bar[XB_XCNT(b.x)], 1u);
    return b;
}
__device__ __forceinline__ void xcd_barrier_complete(unsigned* bar, unsigned x, unsigned& nloc, unsigned& nx) {
    const unsigned G = gridDim.x * gridDim.y * gridDim.z;
    unsigned sum, cnt, mine, sp = 0u;
    for (;;) {
        sum = 0u; cnt = 0u; mine = 0u;
#pragma unroll
        for (unsigned j = 0; j < 16; ++j) { const unsigned c = xb_ld(&bar[XB_XCNT(j)]); sum += c; cnt += (c > 0u) ? 1u : 0u; mine = (j == x) ? c : mine; }
        if (sum == G) break;
        __builtin_amdgcn_s_sleep(1);
        if ((++sp & 255u) == 0u) { if (xb_ld(&bar[XB_TMO])) break; if (sp > XB_SPIN_CAP) { atomicAdd(&bar[XB_TMO], 1u); break; } }
    }
    nloc = mine > 0u ? mine : 1u; nx = cnt > 0u ? cnt : 1u;
}

__device__ __forceinline__ void xcd_barrier(const XcdBarrier& b) {
    asm volatile("s_waitcnt vmcnt(0)" ::: "memory");
    __syncthreads();
    if (threadIdx.x == 0) {
        unsigned* bar = b.bar;
        __builtin_amdgcn_s_waitcnt(0);
        unsigned nloc = b.st[0], nx = b.st[1];
        if (nloc == 0u) { xcd_barrier_complete(bar, b.x, nloc, nx); b.st[0] = nloc; b.st[1] = nx; }
        const unsigned old = xb_add(&bar[XB_XSUB(b.x)], 1u);
        const unsigned gen = old / nloc;
        if (old + 1u == (gen + 1u) * nloc) {
            __builtin_amdgcn_fence(__ATOMIC_RELEASE, "agent");
            asm volatile("s_waitcnt vmcnt(0)" ::: "memory");
            const unsigned og = xb_add(&bar[XB_TOP], 1u);
            const unsigned tg = og / nx;
            if (og + 1u == (tg + 1u) * nx) xb_add(&bar[XB_TOPGEN], 1u);
            else XB_SPIN(xb_ld(&bar[XB_TOPGEN]) == tg, bar);
            __builtin_amdgcn_fence(__ATOMIC_ACQUIRE, "agent");
            xb_add(&bar[XB_XGEN(b.x)], 1u);
            asm volatile("s_waitcnt vmcnt(0)" ::: "memory");
        } else {
            XB_SPIN(xb_ld(&bar[XB_XGEN(b.x)]) == gen, bar);
            __builtin_amdgcn_fence(__ATOMIC_ACQUIRE, "agent");
            asm volatile("s_waitcnt vmcnt(0)" ::: "memory");
        }
    }
    __syncthreads();
}

constexpr int D = 1024, NB = 16, SEQ = 2048, MTOK = NB * SEQ, NHEAD = 16, HD = 64;
constexpr int SGH = 3072, DFF = 2816, NEXP = 8, DFE = 3584;
constexpr int MODL = NB * 6 * D;
constexpr float EPSN = 1e-6f, LOG2E = 1.4426950408889634f;
constexpr int NWAVES = 8;
constexpr int ASROWS = 2 * MTOK + NEXP * 256;

constexpr size_t MiB = 1u << 20;
constexpr size_t WS_CTL = 0, CTL_ZERO_BYTES = 96 * 1024;
constexpr size_t WS_MOD = 2 * MiB, WS_GAINS = 3 * MiB + 512 * 1024;
constexpr size_t WS_WQKV0 = 4 * MiB, WS_WQKV1 = 10 * MiB, WS_WQKVC = 16 * MiB, WS_WO0 = 22 * MiB, WS_WO1 = 24 * MiB, WS_WOC = 26 * MiB;
constexpr size_t WS_WIN = 28 * MiB, WS_WOUT = 40 * MiB, WS_W13_0 = 46 * MiB, WS_W13_1 = 57 * MiB, WS_W2_0 = 68 * MiB, WS_W2_1 = 68 * MiB + 5632 * 1024;
constexpr size_t WS_MOE13 = 80 * MiB, WS_MOE2 = 192 * MiB;
constexpr size_t WS_H = 248 * MiB;
constexpr size_t WS_AS = 312 * MiB;
constexpr size_t WS_ACT = 444 * MiB;
constexpr size_t WS_ROWINFO = 906 * MiB, WS_TROUTE = 907 * MiB, WS_TW = 908 * MiB, WS_VPART = 909 * MiB;
constexpr size_t WS_CS = 915 * MiB, WS_HSC = 915 * MiB + 512 * 1024, WS_RS = 916 * MiB, WS_XB = 917 * MiB, WS_MOE2B = 981 * MiB, WS_END = 1009 * MiB;
static_assert(WS_W2_1 + (size_t)1024 * 2816 * 2 <= WS_MOE13 && WS_ACT + (size_t)ASROWS * DFE * 2 <= WS_ROWINFO && WS_AS + (size_t)ASROWS * 1024 * 2 <= WS_ACT, "ws map");
constexpr int CW_BAR = 4096, CW_CNT = 8192, CW_CONV = 9280, CW_DONE = 9472, CW_SPLIT = 12288;

constexpr int LDS_BYTES = 147456, XTRA_OFF = 131072, MISC_OFF = LDS_BYTES - 256;

typedef float f32x16 __attribute__((ext_vector_type(16)));
typedef short s16x4 __attribute__((ext_vector_type(4)));
typedef unsigned u32x2 __attribute__((ext_vector_type(2)));

__device__ __forceinline__ float wave_sum(float v) {
#pragma unroll
    for (int o = 1; o < 64; o <<= 1) v += __shfl_xor(v, o);
    return v;
}
__device__ __forceinline__ float bf_lo(unsigned u) { return __uint_as_float(u << 16); }
__device__ __forceinline__ float bf_hi(unsigned u) { return __uint_as_float(u & 0xffff0000u); }
__device__ __forceinline__ int crow(int r, int hi) { return (r & 3) + 8 * (r >> 2) + 4 * hi; }

__device__ __forceinline__ int map_qkv(int n) { const int L = n & 255; return (n & ~255) | (((L >> 5) & 1) << 7) | ((L >> 6) << 5) | (L & 31); }
__device__ __forceinline__ int map_glu(int n, int half) { const int a = n < half ? n : n - half; return ((a >> 7) << 8) + (n < half ? 0 : 128) + (a & 127); }
template <int MAP> __device__ __forceinline__ void conv_item(int r, const float* __restrict__ W, int K, int N, bf16* dst, int lane) {
    const int nblk = N / 64, kb = r / nblk, nb = r - kb * nblk, n4 = lane & 15, kq = lane >> 4;
    const int ncol = 64 * nb + 4 * n4;
    int drow;
    if (MAP == 0) drow = ncol; else if (MAP == 1) drow = map_qkv(ncol); else if (MAP == 2) drow = map_glu(ncol, N / 2);
    else if (MAP == 3) drow = ((ncol >> 7) << 8) + (ncol & 127); else drow = ((ncol >> 7) << 8) + 128 + (ncol & 127);
    f32x4 f[2][8];
#pragma unroll
    for (int h = 0; h < 2; ++h)
#pragma unroll
        for (int i = 0; i < 8; ++i) f[h][i] = *(const f32x4*)(W + (size_t)(64 * kb + 32 * h + 8 * kq + i) * N + ncol);
#pragma unroll
    for (int h = 0; h < 2; ++h)
#pragma unroll
        for (int j = 0; j < 4; ++j) { v4u o; o.x = pg8::cvt_pk_bf16(f[h][0][j], f[h][1][j]); o.y = pg8::cvt_pk_bf16(f[h][2][j], f[h][3][j]); o.z = pg8::cvt_pk_bf16(f[h][4][j], f[h][5][j]); o.w = pg8::cvt_pk_bf16(f[h][6][j], f[h][7][j]);
            *(GAS v4u*)(dst + (size_t)(drow + j) * K + 64 * kb + 32 * h + 8 * kq) = o; }
}
__device__ __forceinline__ unsigned q4i8(float a, float b, float c, float d) {
    const int ia = (int)__builtin_rintf(a), ib = (int)__builtin_rintf(b), ic = (int)__builtin_rintf(c), id = (int)__builtin_rintf(d);
    return (unsigned)(ia & 255) | ((unsigned)(ib & 255) << 8) | ((unsigned)(ic & 255) << 16) | ((unsigned)id << 24);
}
template <int MAP> __device__ __forceinline__ void conv8_item(int nb, const float* __restrict__ W, int N, unsigned char* dst, float* cscale, int lane) {
    const int n4 = lane & 7, kq = lane >> 3, ncol = 32 * nb + 4 * n4;
    const int drow = MAP == 0 ? ncol : MAP == 1 ? map_qkv(ncol) : MAP == 2 ? map_glu(ncol, N / 2) : ((ncol >> 7) << 8) + (MAP == 4 ? 128 : 0) + (ncol & 127);
    f32x4 mx = (f32x4){0.f, 0.f, 0.f, 0.f};
#pragma unroll 8
    for (int i = 0; i < 128; ++i) { const f32x4 v = *(const f32x4*)(W + (size_t)(8 * i + kq) * N + ncol);
#pragma unroll
        for (int j = 0; j < 4; ++j) mx[j] = fmaxf(mx[j], fabsf(v[j])); }
    float qs[4];
#pragma unroll
    for (int j = 0; j < 4; ++j) { float a = mx[j]; a = fmaxf(a, __shfl_xor(a, 8)); a = fmaxf(a, __shfl_xor(a, 16)); a = fmaxf(a, __shfl_xor(a, 32));
        qs[j] = a > 0.f ? 127.0f / a : 1.0f; if (kq == 0) cscale[drow + j] = a > 0.f ? a * (1.0f / 127.0f) : 1.0f; }
    for (int kb = 0; kb < 8; ++kb) {
        f32x4 f[16];
#pragma unroll
        for (int i = 0; i < 16; ++i) f[i] = *(const f32x4*)(W + (size_t)(128 * kb + 16 * kq + i) * N + ncol);
#pragma unroll
        for (int j = 0; j < 4; ++j) { v4u o;
#pragma unroll
            for (int q = 0; q < 4; ++q) o[q] = q4i8(f[4 * q][j] * qs[j], f[4 * q + 1][j] * qs[j], f[4 * q + 2][j] * qs[j], f[4 * q + 3][j] * qs[j]);
            *(GAS v4u*)(dst + (size_t)(drow + j) * D + 128 * kb + 16 * kq) = o; }
    }
}
template <int KD> __device__ __forceinline__ void convf8_item(int nb, const float* __restrict__ W, int N, unsigned char* dst, float* cscale, int lane) {
    const int n4 = lane & 7, kq = lane >> 3, ncol = 32 * nb + 4 * n4;
    f32x4 mx = (f32x4){0.f, 0.f, 0.f, 0.f};
#pragma unroll 8
    for (int i = 0; i < KD / 8; ++i) { const f32x4 v = *(const f32x4*)(W + (size_t)(8 * i + kq) * N + ncol);
#pragma unroll
        for (int j = 0; j < 4; ++j) mx[j] = fmaxf(mx[j], fabsf(v[j])); }
    float qs[4];
#pragma unroll
    for (int j = 0; j < 4; ++j) { float a = mx[j]; a = fmaxf(a, __shfl_xor(a, 8)); a = fmaxf(a, __shfl_xor(a, 16)); a = fmaxf(a, __shfl_xor(a, 32));
        qs[j] = a > 0.f ? 440.0f / a : 1.0f; if (kq == 0) cscale[ncol + j] = (a > 0.f ? a * (1.0f / 440.0f) : 1.0f) * 0.125f; }
    for (int kb = 0; kb < KD / 128; ++kb) {
        f32x4 f[16];
#pragma unroll
        for (int i = 0; i < 16; ++i) f[i] = *(const f32x4*)(W + (size_t)(128 * kb + 16 * kq + i) * N + ncol);
#pragma unroll
        for (int j = 0; j < 4; ++j) { v4u o;
#pragma unroll
            for (int q = 0; q < 4; ++q) { int w = 0; w = __builtin_amdgcn_cvt_pk_fp8_f32(f[4 * q][j] * qs[j], f[4 * q + 1][j] * qs[j], w, false); w = __builtin_amdgcn_cvt_pk_fp8_f32(f[4 * q + 2][j] * qs[j], f[4 * q + 3][j] * qs[j], w, true); o[q] = (unsigned)w; }
            *(GAS v4u*)(dst + (size_t)(ncol + j) * KD + 128 * kb + 16 * kq) = o; }
    }
}
__device__ __forceinline__ void conv8_wg_item(int MAP, int nb, const float* __restrict__ W, int N, unsigned char* dst, float* cscale, LAS float* amx, int par, int wave, int lane) {
    const int n4 = lane & 7, kq = lane >> 3, ncol = 32 * nb + 4 * n4;
    const int drow = MAP == 0 ? ncol : MAP == 1 ? map_qkv(ncol) : MAP == 2 ? map_glu(ncol, N / 2) : ((ncol >> 7) << 8) + (MAP == 4 ? 128 : 0) + (ncol & 127);
    f32x4 f[16]; f32x4 mx = (f32x4){0.f, 0.f, 0.f, 0.f};
#pragma unroll
    for (int i = 0; i < 16; ++i) { f[i] = *(const f32x4*)(W + (size_t)(128 * wave + 16 * kq + i) * N + ncol);
#pragma unroll
        for (int j = 0; j < 4; ++j) mx[j] = fmaxf(mx[j], fabsf(f[i][j])); }
#pragma unroll
    for (int j = 0; j < 4; ++j) { float a = mx[j]; a = fmaxf(a, __shfl_xor(a, 8)); a = fmaxf(a, __shfl_xor(a, 16)); a = fmaxf(a, __shfl_xor(a, 32)); mx[j] = a; }
    LAS float* ap = amx + par * 256;
    if (kq == 0) *(LAS f32x4*)(ap + wave * 32 + 4 * n4) = mx;
    LDS_WAIT(); __syncthreads();
    f32x4 am = *(const LAS f32x4*)(ap + 4 * n4);
#pragma unroll
    for (int w = 1; w < 8; ++w) { const f32x4 o = *(const LAS f32x4*)(ap + w * 32 + 4 * n4);
#pragma unroll
        for (int j = 0; j < 4; ++j) am[j] = fmaxf(am[j], o[j]); }
    float qs[4];
#pragma unroll
    for (int j = 0; j < 4; ++j) { qs[j] = am[j] > 0.f ? 127.0f / am[j] : 1.0f; if (wave == 0 && kq == 0) cscale[drow + j] = am[j] > 0.f ? am[j] * (1.0f / 127.0f) : 1.0f; }
#pragma unroll
    for (int j = 0; j < 4; ++j) { v4u o;
#pragma unroll
        for (int q = 0; q < 4; ++q) o[q] = q4i8(f[4 * q][j] * qs[j], f[4 * q + 1][j] * qs[j], f[4 * q + 2][j] * qs[j], f[4 * q + 3][j] * qs[j]);
        *(GAS v4u*)(dst + (size_t)(drow + j) * D + 128 * wave + 16 * kq) = o; }
}
template <int KD> __device__ __forceinline__ void convf8_wg_item(int nb, const float* __restrict__ W, int N, unsigned char* dst, float* cscale, LAS float* amx, int par, int wave, int lane) {
    constexpr int RW = KD / 8, NG = RW / 16;
    static_assert(RW % 16 == 0, "rows per wave");
    const int n4 = lane & 7, kq = lane >> 3, ncol = 32 * nb + 4 * n4;
    const float* wp = W + (size_t)(RW * wave) * N + ncol;
    f32x4 mx = (f32x4){0.f, 0.f, 0.f, 0.f};
    constexpr int PB = RW / 32;
    static_assert(RW % 32 == 0, "pass-1 batches");
    for (int b0 = 0; b0 < 4; ++b0) { f32x4 v[PB];
#pragma unroll
        for (int i = 0; i < PB; ++i) v[i] = *(const f32x4*)(wp + (size_t)(8 * (PB * b0 + i) + kq) * N);
#pragma unroll
        for (int i = 0; i < PB; ++i)
#pragma unroll
            for (int j = 0; j < 4; ++j) mx[j] = fmaxf(mx[j], fabsf(v[i][j])); }
#pragma unroll
    for (int j = 0; j < 4; ++j) { float a = mx[j]; a = fmaxf(a, __shfl_xor(a, 8)); a = fmaxf(a, __shfl_xor(a, 16)); a = fmaxf(a, __shfl_xor(a, 32)); mx[j] = a; }
    LAS float* ap = amx + par * 256;
    if (kq == 0) *(LAS f32x4*)(ap + wave * 32 + 4 * n4) = mx;
    LDS_WAIT(); __syncthreads();
    f32x4 am = *(const LAS f32x4*)(ap + 4 * n4);
#pragma unroll
    for (int w = 1; w < 8; ++w) { const f32x4 o = *(const LAS f32x4*)(ap + w * 32 + 4 * n4);
#pragma unroll
        for (int j = 0; j < 4; ++j) am[j] = fmaxf(am[j], o[j]); }
    float qs[4];
#pragma unroll
    for (int j = 0; j < 4; ++j) { qs[j] = am[j] > 0.f ? 440.0f / am[j] : 1.0f; if (wave == 0 && kq == 0) cscale[ncol + j] = (am[j] > 0.f ? am[j] * (1.0f / 440.0f) : 1.0f) * 0.125f; }
    for (int t = 0; t < (NG + 7) / 8; ++t) { const int g = 8 * t + kq;
        if (g < NG) { f32x4 f[16];
#pragma unroll
            for (int i = 0; i < 16; ++i) f[i] = *(const f32x4*)(wp + (size_t)(16 * g + i) * N);
#pragma unroll
            for (int j = 0; j < 4; ++j) { v4u o;
#pragma unroll
                for (int q = 0; q < 4; ++q) { int w = 0; w = __builtin_amdgcn_cvt_pk_fp8_f32(f[4 * q][j] * qs[j], f[4 * q + 1][j] * qs[j], w, false); w = __builtin_amdgcn_cvt_pk_fp8_f32(f[4 * q + 2][j] * qs[j], f[4 * q + 3][j] * qs[j], w, true); o[q] = (unsigned)w; }
                *(GAS v4u*)(dst + (size_t)(ncol + j) * KD + RW * wave + 16 * g) = o; } } }
}
constexpr int IT_MOE8 = DFE / 32, IT_MOE2 = D / 32;
constexpr int IT_MOE = NEXP * (2 * IT_MOE8 + IT_MOE2);
__device__ __forceinline__ void moe_conv_item(int r, const float* w1, const float* w3, const float* w2, unsigned char* W13, float* cscale, bf16* W2, float* cs2, int lane) {
    if (r < NEXP * IT_MOE8) { const int e = r / IT_MOE8; conv8_item<3>(r % IT_MOE8, w1 + (size_t)e * D * DFE, DFE, W13 + (size_t)e * 2 * DFE * D, cscale + e * 2 * DFE, lane); return; }
    r -= NEXP * IT_MOE8;
    if (r < NEXP * IT_MOE8) { const int e = r / IT_MOE8; conv8_item<4>(r % IT_MOE8, w3 + (size_t)e * D * DFE, DFE, W13 + (size_t)e * 2 * DFE * D, cscale + e * 2 * DFE, lane); return; }
    r -= NEXP * IT_MOE8;
    { const int e = r / IT_MOE2; convf8_item<DFE>(r % IT_MOE2, w2 + (size_t)e * DFE * D, D, (unsigned char*)W2 + (size_t)e * D * DFE, cs2 + e * D, lane); }
}
__device__ __forceinline__ void moe3_conv_opp(const int site, const bool drain, const float* w1, const float* w3, const float* w2, unsigned char* W13, float* cs13, unsigned char* W2b, float* cs2b,
                                              unsigned* ctlp, const XcdBarrier& bar, LAS unsigned char* L, int tid, int wave, int lane) {
    LAS float* amx = (LAS float*)(L + XTRA_OFF); volatile LAS int* dealw = (volatile LAS int*)(L + XTRA_OFF + 4096);
    unsigned* done = ctlp + CW_DONE + 64 * bar.x; unsigned* cnt = ctlp + CW_CONV;
    if (tid == 0 && !drain) __hip_atomic_fetch_add(done, 1u, __ATOMIC_RELAXED, __HIP_MEMORY_SCOPE_AGENT);
    int par = 0;
    __syncthreads();
    for (;;) {
        if (tid == 0) { int r = -1; bool take = true;
            if (!drain) { const unsigned nloc = bar.st[0]; const unsigned d = xb_ld(done) - (unsigned)site * nloc; take = d * 2u < nloc; }
            if (take) { r = (int)__hip_atomic_fetch_add(cnt, 1u, __ATOMIC_RELAXED, __HIP_MEMORY_SCOPE_AGENT); if (r >= IT_MOE) r = -1; }
            dealw[par] = r; }
        __syncthreads();
        int r = dealw[par];
        if (r < 0) break;
        if (r < 2 * NEXP * IT_MOE8) { const int hi = r >= NEXP * IT_MOE8; r -= hi ? NEXP * IT_MOE8 : 0; const int e = r / IT_MOE8;
            conv8_wg_item(hi ? 4 : 3, r % IT_MOE8, (hi ? w3 : w1) + (size_t)e * D * DFE, DFE, W13 + (size_t)e * 2 * DFE * D, cs13 + e * 2 * DFE, amx, par, wave, lane); }
        else { r -= 2 * NEXP * IT_MOE8; const int e = r / IT_MOE2; convf8_wg_item<DFE>(r % IT_MOE2, w2 + (size_t)e * DFE * D, D, W2b + (size_t)e * D * DFE, cs2b + e * D, amx, par, wave, lane); }
        par ^= 1;
    }
    __syncthreads();
}
__device__ __forceinline__ void mod_item(int it, const float* __restrict__ ada_w, const float* __restrict__ ada_b, float* mod, const LAS float* cond, int lane) {
    const int i = it / 384, n0 = 16 * (it % 384), n4 = lane & 3, ksub = lane >> 2;
    f32x4 acc[16];
#pragma unroll
    for (int b = 0; b < 16; ++b) acc[b] = (f32x4){0.f, 0.f, 0.f, 0.f};
    const float* wp = ada_w + (size_t)i * D * 6 * D + n0 + 4 * n4;
#pragma unroll 8
    for (int kk = 0; kk < 64; ++kk) { const int k = 16 * kk + ksub;
        const f32x4 w = *(const f32x4*)(wp + (size_t)k * 6 * D);
        const LAS f32x4* cp = (const LAS f32x4*)(cond + k * 16);
#pragma unroll
        for (int q = 0; q < 4; ++q) { const f32x4 c = cp[q];
#pragma unroll
            for (int e = 0; e < 4; ++e) acc[4 * q + e] += w * c[e]; } }
#pragma unroll
    for (int b = 0; b < 16; ++b)
#pragma unroll
        for (int e = 0; e < 4; ++e) { float v = acc[b][e]; v += __shfl_xor(v, 4); v += __shfl_xor(v, 8); v += __shfl_xor(v, 16); v += __shfl_xor(v, 32); acc[b][e] = v; }
    if (ksub == 0) { const f32x4 bv = *(const f32x4*)(ada_b + (size_t)i * 6 * D + n0 + 4 * n4);
#pragma unroll
        for (int b = 0; b < 16; ++b) *(f32x4*)(mod + (size_t)i * MODL + (size_t)b * 6 * D + n0 + 4 * n4) = acc[b] + bv; }
}

template <bool COMBINE, bool NORM, bool ROUTE, bool F8OUT = ROUTE, bool XIN16 = true, bool XOUT16 = true>
__device__ __forceinline__ void norm_phase(const void* xin, void* xout, bf16* H, const float* ng, const float* modl, int sh_off,
                                           const float* g2prev, const bf16* Y, const float* twin,
                                           const float* wr, const float* br, unsigned* cnt, int* troute, float* twout, float* hsc,
                                           LAS unsigned char* L, int vcu, int G, int wave, int lane, int tid) {
    LAS float* wrL = (LAS float*)L;
    if (ROUTE) { float wv[D * NEXP / (NWAVES * 64)];
#pragma unroll
        for (int i = 0; i < D * NEXP / (NWAVES * 64); ++i) wv[i] = wr[tid + NWAVES * 64 * i];
#pragma unroll
        for (int i = 0; i < D * NEXP / (NWAVES * 64); ++i) wrL[tid + NWAVES * 64 * i] = wv[i];
        __syncthreads(); }
    for (int gw = vcu * NWAVES + wave; gw < MTOK / 16; gw += G * NWAVES) {
        const int b = gw >> 7; const size_t row0 = (size_t)gw * 16;
        f32x4 A[4], Bv[4], G2[4];
#pragma unroll
        for (int j = 0; j < 4; ++j) { const int col = 4 * lane + 256 * j;
            if (NORM) { const f32x4 g = *(const f32x4*)(ng + col), sc = *(const f32x4*)(modl + (size_t)b * 6 * D + sh_off + D + col); A[j] = g * (sc + 1.0f); Bv[j] = *(const f32x4*)(modl + (size_t)b * 6 * D + sh_off + col); }
            if (COMBINE) G2[j] = *(const f32x4*)(g2prev + (size_t)b * 6 * D + col); }
        int my_e1 = 0, my_e2 = 0; float my_w1 = 0.f, my_w2 = 0.f;
        u32x2 cw[4], cy0[4], cy1[4]; f32x4 cf[4]; float cw0 = 0.f, cw1 = 0.f;
#pragma unroll
        for (int j = 0; j < 4; ++j) {
            if (XIN16) cw[j] = *(const u32x2*)((const bf16*)xin + row0 * D + 4 * lane + 256 * j); else cf[j] = *(const f32x4*)((const float*)xin + row0 * D + 4 * lane + 256 * j);
            if (COMBINE) { cy0[j] = *(const u32x2*)(Y + row0 * D + 4 * lane + 256 * j); cy1[j] = *(const u32x2*)(Y + ((size_t)MTOK + row0) * D + 4 * lane + 256 * j); } }
        if (COMBINE) { cw0 = twin[2 * row0]; cw1 = twin[2 * row0 + 1]; }
        for (int r = 0; r < 16; ++r) { const size_t row = row0 + r;
            f32x4 x[4]; u32x2 ny0[4], ny1[4]; float nw0 = 0.f, nw1 = 0.f;
            { const size_t nrow = row + (r < 15 ? 1 : 0);
              u32x2 nwd[4]; f32x4 nf[4];
#pragma unroll
              for (int j = 0; j < 4; ++j) {
                if (XIN16) nwd[j] = *(const u32x2*)((const bf16*)xin + nrow * D + 4 * lane + 256 * j); else nf[j] = *(const f32x4*)((const float*)xin + nrow * D + 4 * lane + 256 * j);
                if (COMBINE) { ny0[j] = *(const u32x2*)(Y + nrow * D + 4 * lane + 256 * j); ny1[j] = *(const u32x2*)(Y + ((size_t)MTOK + nrow) * D + 4 * lane + 256 * j); } }
              if (COMBINE) { nw0 = twin[2 * nrow]; nw1 = twin[2 * nrow + 1]; }
#pragma unroll
              for (int j = 0; j < 4; ++j) {
                if (XIN16) { const u32x2 w = cw[j]; x[j] = (f32x4){bf_lo(w.x), bf_hi(w.x), bf_lo(w.y), bf_hi(w.y)}; cw[j] = nwd[j]; }
                else { x[j] = cf[j]; cf[j] = nf[j]; } } }
            if (COMBINE) { const float w0 = cw0, w1 = cw1; cw0 = nw0; cw1 = nw1;
#pragma unroll
                for (int j = 0; j < 4; ++j) { const u32x2 y0 = cy0[j], y1 = cy1[j]; cy0[j] = ny0[j]; cy1[j] = ny1[j];
                    f32x4 t; t[0] = w0 * bf_lo(y0.x) + w1 * bf_lo(y1.x); t[1] = w0 * bf_hi(y0.x) + w1 * bf_hi(y1.x); t[2] = w0 * bf_lo(y0.y) + w1 * bf_lo(y1.y); t[3] = w0 * bf_hi(y0.y) + w1 * bf_hi(y1.y);
                    x[j] = x[j] + G2[j] * t;
                    if (XOUT16) { u32x2 o; o.x = pk2(x[j][0], x[j][1]); o.y = pk2(x[j][2], x[j][3]); *(u32x2*)((bf16*)xout + row * D + 4 * lane + 256 * j) = o; }
                    else *(f32x4*)((float*)xout + row * D + 4 * lane + 256 * j) = x[j]; } }
            if (NORM) { float ss = 0.f;
#pragma unroll
                for (int j = 0; j < 4; ++j) ss += (x[j][0] * x[j][0] + x[j][1] * x[j][1]) + (x[j][2] * x[j][2] + x[j][3] * x[j][3]);
                const float rstd = __builtin_amdgcn_rsqf(wave_sum(ss) * (1.0f / D) + EPSN);
                float lg[8];
#pragma unroll
                for (int e = 0; e < 8; ++e) lg[e] = 0.f;
                f32x4 hv[4]; float amax = 0.f;
#pragma unroll
                for (int j = 0; j < 4; ++j) { hv[j] = x[j] * rstd * A[j] + Bv[j]; amax = fmaxf(amax, fmaxf(fmaxf(fabsf(hv[j][0]), fabsf(hv[j][1])), fmaxf(fabsf(hv[j][2]), fabsf(hv[j][3])))); }
                float qs = 1.0f;
                if (F8OUT) {
#pragma unroll
                    for (int o = 1; o < 64; o <<= 1) amax = fmaxf(amax, __shfl_xor(amax, o));
                    qs = amax > 0.f ? 127.0f / amax : 1.0f;
                    if (lane == 0) hsc[row] = amax > 0.f ? amax * (1.0f / 127.0f) : 1.0f; }
#pragma unroll
                for (int j = 0; j < 4; ++j) { const f32x4 h = hv[j];
                    if (F8OUT) *(unsigned*)((unsigned char*)H + row * D + 4 * lane + 256 * j) = q4i8(h[0] * qs, h[1] * qs, h[2] * qs, h[3] * qs);
                    else { u32x2 o; o.x = pk2(h[0], h[1]); o.y = pk2(h[2], h[3]); *(u32x2*)(H + row * D + 4 * lane + 256 * j) = o; }
                    if (ROUTE) {
#pragma unroll
                        for (int jj = 0; jj < 4; ++jj) { const LAS f32x4* wp = (const LAS f32x4*)(wrL + (4 * lane + 256 * j + jj) * 8); const f32x4 wa = wp[0], wb = wp[1];
#pragma unroll
                            for (int e = 0; e < 4; ++e) { lg[e] += h[jj] * wa[e]; lg[4 + e] += h[jj] * wb[e]; } } } }
                if (ROUTE) {
#pragma unroll
                    for (int e = 0; e < 8; ++e) lg[e] = wave_sum(lg[e]) + br[e];
                    int e1 = 0; float v1 = lg[0];
#pragma unroll
                    for (int e = 1; e < 8; ++e) if (lg[e] > v1) { v1 = lg[e]; e1 = e; }
                    int e2 = -1; float v2 = -INFINITY;
#pragma unroll
                    for (int e = 0; e < 8; ++e) if (e != e1 && lg[e] > v2) { v2 = lg[e]; e2 = e; }
                    const float w1 = 1.0f / (1.0f + __expf(v2 - v1));
                    if (lane == r) { my_e1 = e1; my_e2 = e2; my_w1 = w1; my_w2 = 1.0f - w1; } } } }
        if (ROUTE) {
            const bool valid = lane < 16; int rank1 = 0, rank2 = 0; unsigned mine = 0;
            const unsigned long long lt = (1ull << lane) - 1ull;
#pragma unroll
            for (int e = 0; e < 8; ++e) { const unsigned long long m1 = __ballot(valid && my_e1 == e), m2 = __ballot(valid && my_e2 == e);
                if (my_e1 == e) rank1 = __popcll(m1 & lt);
                if (my_e2 == e) rank2 = __popcll(m1) + __popcll(m2 & lt);
                if (lane == e) mine = (unsigned)(__popcll(m1) + __popcll(m2)); }
            unsigned base = 0;
            if (lane < 8) base = __hip_atomic_fetch_add(cnt + 64 * lane, mine, __ATOMIC_RELAXED, __HIP_MEMORY_SCOPE_AGENT);
            const int b1 = (int)__shfl((int)base, my_e1), b2 = (int)__shfl((int)base, my_e2);
            if (valid) { int4 tr; tr.x = my_e1; tr.y = b1 + rank1; tr.z = my_e2; tr.w = b2 + rank2; *(int4*)(troute + 4 * (row0 + lane)) = tr;
                twout[2 * (row0 + lane)] = my_w1; twout[2 * (row0 + lane) + 1] = my_w2; } }
    }
}

__device__ __forceinline__ void gather_phase(const unsigned char* H8, unsigned char* AS8, int* rowinfo, const int* troute, const unsigned* cnt, const float* hsc, float* rs, int vcu, int G, int wave, int lane, int tid) {
    int mt[8];
#pragma unroll
    for (int e = 0; e < 8; ++e) mt[e] = (int)((cnt[64 * e] + 255u) >> 8);
    for (int gw = vcu * NWAVES + wave; gw < MTOK / 16; gw += G * NWAVES) {
        const size_t m0 = (size_t)gw * 16;
        int R1v = 0, R2v = 0;
        if (lane < 16) { const int4 tr = *(const int4*)(troute + 4 * (m0 + lane));
            int rb1 = 0, rb2 = 0;
#pragma unroll
            for (int k = 0; k < 7; ++k) { rb1 += (tr.x > k) ? mt[k] * 256 : 0; rb2 += (tr.z > k) ? mt[k] * 256 : 0; }
            R1v = rb1 + tr.y; R2v = rb2 + tr.w;
            rowinfo[R1v] = (int)(2 * (m0 + lane)); rowinfo[R2v] = (int)(2 * (m0 + lane) + 1); const float sc = hsc[m0 + lane]; rs[R1v] = sc; rs[R2v] = sc; }
#pragma unroll
        for (int rb = 0; rb < 16; rb += 4) {
            v4u v[4];
#pragma unroll
            for (int q = 0; q < 4; ++q) v[q] = *(const v4u*)(H8 + (m0 + rb + q) * D + lane * 16);
#pragma unroll
            for (int q = 0; q < 4; ++q) { const size_t R1 = (size_t)__builtin_amdgcn_readlane(R1v, rb + q), R2 = (size_t)__builtin_amdgcn_readlane(R2v, rb + q);
                *(v4u*)(AS8 + R1 * D + lane * 16) = v[q]; *(v4u*)(AS8 + R2 * D + lane * 16) = v[q]; } }
    }
    if (vcu == 0) { int rb = 0;
#pragma unroll
        for (int e = 0; e < 8; ++e) { const int c = (int)cnt[64 * e]; for (int R = rb + c + tid; R < rb + mt[e] * 256; R += NWAVES * 64) { rowinfo[R] = -1; rs[R] = 0.f; } rb += mt[e] * 256; } }
}

typedef short v4i16_t __attribute__((ext_vector_type(4)));
__device__ __forceinline__ s16x4 vtr(unsigned a) { return __builtin_bit_cast(s16x4, __builtin_amdgcn_ds_read_tr16_b64_v4i16((LAS v4i16_t*)(uintptr_t)a)); }
__device__ __forceinline__ void pv_tile(f32x16 (&o)[2], unsigned vb, pg8::bf16x8 pa0, pg8::bf16x8 pa1, pg8::bf16x8 pa2, pg8::bf16x8 pa3) {
    s16x4 lo[2][4], hi[2][4];
#pragma unroll
    for (int d0 = 0; d0 < 2; ++d0)
#pragma unroll
        for (int ks = 0; ks < 4; ++ks) { lo[d0][ks] = vtr(vb + d0 * 4096 + ks * 1024); hi[d0][ks] = vtr(vb + d0 * 4096 + ks * 1024 + 512); }
    __builtin_amdgcn_sched_barrier(0);
#define PK(d, k) (pg8::bf16x8){lo[d][k][0], lo[d][k][1], lo[d][k][2], lo[d][k][3], hi[d][k][0], hi[d][k][1], hi[d][k][2], hi[d][k][3]}
    o[0] = __builtin_amdgcn_mfma_f32_32x32x16_bf16(pa0, PK(0, 0), o[0], 0, 0, 0); o[1] = __builtin_amdgcn_mfma_f32_32x32x16_bf16(pa0, PK(1, 0), o[1], 0, 0, 0);
    o[0] = __builtin_amdgcn_mfma_f32_32x32x16_bf16(pa1, PK(0, 1), o[0], 0, 0, 0); o[1] = __builtin_amdgcn_mfma_f32_32x32x16_bf16(pa1, PK(1, 1), o[1], 0, 0, 0);
    o[0] = __builtin_amdgcn_mfma_f32_32x32x16_bf16(pa2, PK(0, 2), o[0], 0, 0, 0); o[1] = __builtin_amdgcn_mfma_f32_32x32x16_bf16(pa2, PK(1, 2), o[1], 0, 0, 0);
    o[0] = __builtin_amdgcn_mfma_f32_32x32x16_bf16(pa3, PK(0, 3), o[0], 0, 0, 0); o[1] = __builtin_amdgcn_mfma_f32_32x32x16_bf16(pa3, PK(1, 3), o[1], 0, 0, 0);
#undef PK
}
__device__ __forceinline__ void v_dma(const bf16* vsrc, size_t pitch, LAS unsigned char* slot) {
#pragma unroll
    for (int p = 0; p < 8; ++p)
        __builtin_amdgcn_global_load_lds((const unsigned*)(vsrc + (size_t)(16 * (p & 3)) * pitch + (p >> 2) * 32), (LAS unsigned*)(slot + p * 1024), 16, 0, 0);
}
__device__ __forceinline__ unsigned short bf1(float x) { return (unsigned short)f2bf(x); }

typedef float f32x2_t __attribute__((ext_vector_type(2))); typedef __bf16 bf16x2_t __attribute__((ext_vector_type(2)));
__device__ __forceinline__ unsigned cvtpk_s(float lo, float hi) { f32x2_t v = {lo, hi}; bf16x2_t b = __builtin_convertvector(v, bf16x2_t); return __builtin_bit_cast(unsigned, b); }
__device__ __forceinline__ float fmul_s(float a, float b) { float r; asm("v_mul_f32_e32 %0, %1, %2" : "=v"(r) : "v"(a), "v"(b)); return r; }
__device__ __forceinline__ float fsub_s(float a, float b) { float r; asm("v_sub_f32_e32 %0, %1, %2" : "=v"(r) : "v"(a), "v"(b)); return r; }
constexpr int AT_STAGE = 65536, AT_VOFF = 32768, AT_TPS = 4;
template <int MODE>
__device__ __forceinline__ void attn_phase(const bf16* __restrict__ Q, const bf16* __restrict__ K, const bf16* __restrict__ V, bf16* __restrict__ O, const float* relb, LAS unsigned char* L, int vcu, int G, int wave, int lane, int tid) {
    LAS float* biasL = (LAS float*)(L + XTRA_OFF);
    LAS float* wsf = (LAS float*)(L + XTRA_OFF + 16 * 193 * 4) + wave * 64;
    volatile LAS unsigned* act = (volatile LAS unsigned*)(L + XTRA_OFF + 16 * 193 * 4 + 2048);
    LAS bf16* stg = (LAS bf16*)(L + wave * 4096);
    if (MODE == 1) { constexpr int NBI = (NHEAD * 193 + NWAVES * 64 - 1) / (NWAVES * 64); float bv[NBI];
#pragma unroll
        for (int i = 0; i < NBI; ++i) { const int u = tid + NWAVES * 64 * i, hh = u / 193, ii = u - hh * 193; bv[i] = u < NHEAD * 193 ? relb[hh * 257 + 64 + ii] : 0.f; }
#pragma unroll
        for (int i = 0; i < NBI; ++i) { const int u = tid + NWAVES * 64 * i; if (u < NHEAD * 193) biasL[u] = bv[i] * LOG2E; } }
    __syncthreads();
    const int r32 = lane & 31, hi = lane >> 5;
    const unsigned vlane = ((lane >> 4) & 1) * 32 + (lane & 3) * 8 + (4 * hi + ((lane & 15) >> 2)) * 64;
    const unsigned klane = hi * 1024 + r32 * 16;
    for (int idx = vcu; idx < NB * NHEAD * 8; idx += G) {
        const int bh = idx >> 3, qb = ((idx & 7) + (idx >> 11)) & 7, b = bh >> 4, h = bh & 15;
        const size_t rowbase = (size_t)b * SEQ;
        const int cw = 4 * qb + (wave >> 1), r0 = 256 * qb + 32 * wave, t = r0 + r32;
        const int kt_top = 4 * qb + 3;
        const int lo_w = MODE == 1 ? (cw > 8 ? cw - 8 : 0) : 0;
        const int nstage = MODE == 1 ? (qb >= 2 ? 3 : qb + 1) : qb + 1;
        const LAS float* biasT = biasL + h * 193 - 64;
        pg8::bf16x8 qr[4];
        { const bf16* qp = Q + (rowbase + r0 + r32) * D + h * HD + hi * 8;
#pragma unroll
          for (int d0 = 0; d0 < 4; ++d0) qr[d0] = *(const pg8::bf16x8*)(qp + d0 * 16); }
        const bf16* ksrc = K + (rowbase + lane) * D + h * HD + wave * 8;
        const bf16* vsrc = V + (rowbase + 16 * (wave & 3) + (lane >> 2)) * D + h * HD + (wave >> 2) * 32 + (lane & 3) * 8;
#define AT_DMA(g_, buf_) do { _Pragma("unroll") for (int j_ = 0; j_ < AT_TPS; ++j_) { const int kt_ = kt_top - AT_TPS * (g_) - j_; \
        __builtin_amdgcn_global_load_lds((const unsigned*)(ksrc + (size_t)kt_ * 64 * D), (LAS unsigned*)(L + (buf_) * AT_STAGE + j_ * 8192 + wave * 1024), 16, 0, 0); \
        __builtin_amdgcn_global_load_lds((const unsigned*)(vsrc + (size_t)kt_ * 64 * D), (LAS unsigned*)(L + (buf_) * AT_STAGE + AT_VOFF + j_ * 8192 + wave * 1024), 16, 0, 0); } } while (0)
        AT_DMA(0, 0);
        f32x16 o[2];
#pragma unroll
        for (int r = 0; r < 16; ++r) { o[0][r] = 0.f; o[1][r] = 0.f; }
        float prun = 1.0f, mrun = -INFINITY, lrun = 0.f;
        bool done = false;
        for (int g = 0; g < nstage; ++g) {
            const int buf = g & 1;
            asm volatile("s_waitcnt vmcnt(0)" ::: "memory");
            if (MODE == 0) { if (lane == 0) act[buf * 8 + wave] = done ? 0u : 1u; }
            asm volatile("s_waitcnt lgkmcnt(0)" ::: "memory");
            __syncthreads();
            if (MODE == 0) { unsigned any = 0;
#pragma unroll
                for (int w = 0; w < 8; ++w) any |= act[buf * 8 + w];
                if (!any) break; }
            if (g + 1 < nstage) AT_DMA(g + 1, buf ^ 1);
#pragma nounroll
            for (int j = 0; j < AT_TPS; ++j) {
                const int kt = kt_top - AT_TPS * g - j;
                if (kt <= cw && kt >= lo_w && !done) {
                const unsigned kb = (unsigned)(uintptr_t)(L + buf * AT_STAGE + j * 8192) + klane;
                f32x16 p0, p1;
                { const float cinit = (MODE == 1 && cw - kt >= 3) ? biasT[256] : 0.f;
#pragma unroll
                  for (int r = 0; r < 16; ++r) { p0[r] = cinit; p1[r] = cinit; } }
                pg8::bf16x8 kfr[8];
#pragma unroll
                for (int d0 = 0; d0 < 4; ++d0) { kfr[2 * d0] = *(const LAS pg8::bf16x8*)(uintptr_t)(kb + d0 * 2048); kfr[2 * d0 + 1] = *(const LAS pg8::bf16x8*)(uintptr_t)(kb + d0 * 2048 + 512); }
                __builtin_amdgcn_sched_barrier(0);
#pragma unroll
                for (int d0 = 0; d0 < 4; ++d0) { p0 = __builtin_amdgcn_mfma_f32_32x32x16_bf16(kfr[2 * d0], qr[d0], p0, 0, 0, 0); p1 = __builtin_amdgcn_mfma_f32_32x32x16_bf16(kfr[2 * d0 + 1], qr[d0], p1, 0, 0, 0); }
                if (MODE == 0) {
                    float F0[16], F1[16];
#pragma unroll
                    for (int r = 0; r < 16; ++r) { F0[r] = pg8::rcp(1.0f + pg8::ex2(p0[r])); F1[r] = pg8::rcp(1.0f + pg8::ex2(p1[r])); }
                    if (kt == cw) { const int kbase = 64 * kt + 4 * hi;
#pragma unroll
                        for (int r = 0; r < 16; ++r) { const int kv = kbase + (r & 3) + 8 * (r >> 2); if (kv >= t) F0[r] = 1.0f; if (kv + 32 >= t) F1[r] = 1.0f; } }
                    float g0[8], g1[8], E[8];
#pragma unroll
                    for (int i = 0; i < 4; ++i) { const float ga = fmul_s(fmul_s(F0[4 * i], F0[4 * i + 1]), fmul_s(F0[4 * i + 2], F0[4 * i + 3])), gb = fmul_s(fmul_s(F1[4 * i], F1[4 * i + 1]), fmul_s(F1[4 * i + 2], F1[4 * i + 3]));
                        auto ra = __builtin_amdgcn_permlane32_swap(__float_as_uint(ga), __float_as_uint(ga), false, false); g0[i] = __uint_as_float(ra[0]); g1[i] = __uint_as_float(ra[1]);
                        auto rb = __builtin_amdgcn_permlane32_swap(__float_as_uint(gb), __float_as_uint(gb), false, false); g0[4 + i] = __uint_as_float(rb[0]); g1[4 + i] = __uint_as_float(rb[1]); }
                    float run = prun;
#pragma unroll
                    for (int x = 1; x >= 0; --x)
#pragma unroll
                        for (int i = 3; i >= 0; --i) {
                            const float E1 = run; run *= g1[4 * x + i]; const float E0 = run; run *= g0[4 * x + i]; E[4 * x + i] = hi ? E1 : E0; }
                    prun = run;
#pragma unroll
                    for (int i = 0; i < 4; ++i) { float w = E[i];
#pragma unroll
                        for (int j = 3; j >= 0; --j) { const float wn = fmul_s(w, F0[4 * i + j]); p0[4 * i + j] = fsub_s(w, wn); w = wn; }
                        w = E[4 + i];
#pragma unroll
                        for (int j = 3; j >= 0; --j) { const float wn = fmul_s(w, F1[4 * i + j]); p1[4 * i + j] = fsub_s(w, wn); w = wn; } }
                    done = !__any(prun > 1.0e-16f);
                } else {
                    if (cw - kt < 3) { const int base = t - 64 * kt - 4 * hi;
#pragma unroll
                        for (int r = 0; r < 16; ++r) { int i0 = base - ((r & 3) + 8 * (r >> 2)); int i1 = i0 - 32;
                            i0 = min(max(i0, -128), 128); i1 = min(max(i1, -128), 128);
                            p0[r] += biasT[i0 + 128]; p1[r] += biasT[i1 + 128]; } }
                    float mx = fmaxf(p0[0], p1[0]);
#pragma unroll
                    for (int r = 1; r < 16; ++r) mx = fmaxf(mx, fmaxf(p0[r], p1[r]));
                    { auto rr = __builtin_amdgcn_permlane32_swap(__float_as_uint(mx), __float_as_uint(mx), false, false); mx = fmaxf(__uint_as_float(rr[0]), __uint_as_float(rr[1])); }
                    const float mnew = fmaxf(mrun, mx), alpha = pg8::ex2(mrun - mnew); mrun = mnew;
                    float ls = 0.f;
#pragma unroll
                    for (int r = 0; r < 16; ++r) { p0[r] = pg8::ex2(p0[r] - mnew); p1[r] = pg8::ex2(p1[r] - mnew); ls += p0[r] + p1[r]; }
                    lrun = lrun * alpha + ls;
                    if (kt != cw) { if (hi == 0) wsf[r32] = alpha; asm volatile("s_waitcnt lgkmcnt(0)" ::: "memory");
#pragma unroll
                        for (int r = 0; r < 16; ++r) { const float f = wsf[crow(r, hi)]; o[0][r] *= f; o[1][r] *= f; }
                        asm volatile("s_waitcnt lgkmcnt(0)" ::: "memory"); }
                }
                pg8::u32x4 pw0, pw1, pw2, pw3;
                pw0 = (pg8::u32x4){cvtpk_s(p0[0], p0[1]), cvtpk_s(p0[2], p0[3]), cvtpk_s(p0[4], p0[5]), cvtpk_s(p0[6], p0[7])};
                pw1 = (pg8::u32x4){cvtpk_s(p0[8], p0[9]), cvtpk_s(p0[10], p0[11]), cvtpk_s(p0[12], p0[13]), cvtpk_s(p0[14], p0[15])};
                pw2 = (pg8::u32x4){cvtpk_s(p1[0], p1[1]), cvtpk_s(p1[2], p1[3]), cvtpk_s(p1[4], p1[5]), cvtpk_s(p1[6], p1[7])};
                pw3 = (pg8::u32x4){cvtpk_s(p1[8], p1[9]), cvtpk_s(p1[10], p1[11]), cvtpk_s(p1[12], p1[13]), cvtpk_s(p1[14], p1[15])};
                pv_tile(o, (unsigned)(uintptr_t)(L + buf * AT_STAGE + AT_VOFF + j * 8192) + vlane, __builtin_bit_cast(pg8::bf16x8, pw0), __builtin_bit_cast(pg8::bf16x8, pw1), __builtin_bit_cast(pg8::bf16x8, pw2), __builtin_bit_cast(pg8::bf16x8, pw3));
                }
            }
        }
#undef AT_DMA
        VM_WAIT(); LDS_WAIT();
        __syncthreads();
        float sc[16];
#pragma unroll
        for (int r = 0; r < 16; ++r) sc[r] = 1.0f;
        if (MODE == 1) { float lt; { auto rr = __builtin_amdgcn_permlane32_swap(__float_as_uint(lrun), __float_as_uint(lrun), false, false); lt = __uint_as_float(rr[0]) + __uint_as_float(rr[1]); }
            if (hi == 0) wsf[r32] = pg8::rcp(lt); asm volatile("s_waitcnt lgkmcnt(0)" ::: "memory");
#pragma unroll
            for (int r = 0; r < 16; ++r) sc[r] = wsf[crow(r, hi)];
            asm volatile("s_waitcnt lgkmcnt(0)" ::: "memory"); }
#pragma unroll
        for (int r = 0; r < 16; ++r) { const int q = crow(r, hi); stg[q * 64 + r32] = bf1(o[0][r] * sc[r]); stg[q * 64 + 32 + r32] = bf1(o[1][r] * sc[r]); }
        LDS_WAIT();
        bf16* op = O + (rowbase + r0) * D + h * HD;
#pragma unroll
        for (int i = 0; i < 4; ++i) { const int row = i * 8 + (lane >> 3), ch = lane & 7; const v4u v = *(const LAS v4u*)(stg + row * 64 + ch * 8); *(v4u*)(op + (size_t)row * D + ch * 8) = v; }
        LDS_WAIT();
        __syncthreads();
    }
    LDS_WAIT(); VM_WAIT();
}

constexpr int SB_NT0 = 6, SB_VA = SB_NT0 * 8192, SB_B = 2 * SB_NT0 * 8192, SB_BV = SB_B + 16384;
__device__ __forceinline__ void attn_sb_phase(const bf16* __restrict__ Q, const bf16* __restrict__ K, const bf16* __restrict__ V, bf16* __restrict__ O, LAS unsigned char* L, int vcu, int G, int wave, int lane, int tid) {
    constexpr int MODE = 0;
    volatile LAS unsigned* act = (volatile LAS unsigned*)(L + XTRA_OFF);
    LAS bf16* stg = (LAS bf16*)(L + SB_B + wave * 4096);
    const LAS float* biasT = nullptr; LAS float* wsf = nullptr; (void)biasT; (void)wsf;
    const int r32 = lane & 31, hi = lane >> 5;
    const unsigned vlane = ((lane >> 4) & 1) * 32 + (lane & 3) * 8 + (4 * hi + ((lane & 15) >> 2)) * 64;
    const unsigned klane = hi * 1024 + r32 * 16;
    __syncthreads();
#define SB_UNIT(idx_, b_, h_, qb_) const int bh_ = (idx_) >> 3; qb_ = (((idx_) & 7) + ((idx_) >> 11)) & 7; b_ = bh_ >> 4; h_ = bh_ & 15
#define SB_DMA1(kt_, koff_, voff_) do { __builtin_amdgcn_global_load_lds((const unsigned*)(ksrc + (size_t)(kt_) * 64 * D), (LAS unsigned*)(L + (koff_) + wave * 1024), 16, 0, 0); \
        __builtin_amdgcn_global_load_lds((const unsigned*)(vsrc + (size_t)(kt_) * 64 * D), (LAS unsigned*)(L + (voff_) + wave * 1024), 16, 0, 0); } while (0)
    int idx = vcu; if (idx >= NB * NHEAD * 8) return;
    int b, h, qb; { SB_UNIT(idx, b, h, qb); }
    pg8::bf16x8 qr[4];
    const bf16* ksrc; const bf16* vsrc;
    { const size_t rowbase = (size_t)b * SEQ; const int r0 = 256 * qb + 32 * wave;
      const bf16* qp = Q + (rowbase + r0 + r32) * D + h * HD + hi * 8;
#pragma unroll
      for (int d0 = 0; d0 < 4; ++d0) qr[d0] = *(const pg8::bf16x8*)(qp + d0 * 16);
      ksrc = K + (rowbase + lane) * D + h * HD + wave * 8; vsrc = V + (rowbase + 16 * (wave & 3) + (lane >> 2)) * D + h * HD + (wave >> 2) * 32 + (lane & 3) * 8;
#pragma unroll
      for (int j = 0; j < SB_NT0; ++j) { const int kt = 4 * qb + 3 - j; if (kt >= 0) SB_DMA1(kt, j * 8192, SB_VA + j * 8192); } }
    for (;;) {
        const size_t rowbase = (size_t)b * SEQ;
        const int cw = 4 * qb + (wave >> 1), r0 = 256 * qb + 32 * wave, t = r0 + r32, kt_top = 4 * qb + 3;
        f32x16 o[2];
#pragma unroll
        for (int r = 0; r < 16; ++r) { o[0][r] = 0.f; o[1][r] = 0.f; }
        float prun = 1.0f, mrun = 0.f, lrun = 0.f; (void)mrun; (void)lrun;
        bool done = false;
        asm volatile("s_waitcnt vmcnt(0)" ::: "memory");
        __syncthreads();
        { const int kt_end = kt_top - (SB_NT0 - 1) > 0 ? kt_top - (SB_NT0 - 1) : 0;
#pragma nounroll
          for (int kt = cw; kt >= kt_end; --kt) {
            if (!done) { const int kslot = (kt_top - kt) * 8192, vslot = SB_VA + (kt_top - kt) * 8192;
                const unsigned kb = (unsigned)(uintptr_t)(L + kslot) + klane;
                f32x16 p0, p1;
                { const float cinit = (MODE == 1 && cw - kt >= 3) ? biasT[256] : 0.f;
#pragma unroll
                  for (int r = 0; r < 16; ++r) { p0[r] = cinit; p1[r] = cinit; } }
                pg8::bf16x8 kfr[8];
#pragma unroll
                for (int d0 = 0; d0 < 4; ++d0) { kfr[2 * d0] = *(const LAS pg8::bf16x8*)(uintptr_t)(kb + d0 * 2048); kfr[2 * d0 + 1] = *(const LAS pg8::bf16x8*)(uintptr_t)(kb + d0 * 2048 + 512); }
                __builtin_amdgcn_sched_barrier(0);
#pragma unroll
                for (int d0 = 0; d0 < 4; ++d0) { p0 = __builtin_amdgcn_mfma_f32_32x32x16_bf16(kfr[2 * d0], qr[d0], p0, 0, 0, 0); p1 = __builtin_amdgcn_mfma_f32_32x32x16_bf16(kfr[2 * d0 + 1], qr[d0], p1, 0, 0, 0); }
                if (MODE == 0) {
                    float F0[16], F1[16];
#pragma unroll
                    for (int r = 0; r < 16; ++r) { F0[r] = pg8::rcp(1.0f + pg8::ex2(p0[r])); F1[r] = pg8::rcp(1.0f + pg8::ex2(p1[r])); }
                    if (kt == cw) { const int kbase = 64 * kt + 4 * hi;
#pragma unroll
                        for (int r = 0; r < 16; ++r) { const int kv = kbase + (r & 3) + 8 * (r >> 2); if (kv >= t) F0[r] = 1.0f; if (kv + 32 >= t) F1[r] = 1.0f; } }
                    float g0[8], g1[8], E[8];
#pragma unroll
                    for (int i = 0; i < 4; ++i) { const float ga = fmul_s(fmul_s(F0[4 * i], F0[4 * i + 1]), fmul_s(F0[4 * i + 2], F0[4 * i + 3])), gb = fmul_s(fmul_s(F1[4 * i], F1[4 * i + 1]), fmul_s(F1[4 * i + 2], F1[4 * i + 3]));
                        auto ra = __builtin_amdgcn_permlane32_swap(__float_as_uint(ga), __float_as_uint(ga), false, false); g0[i] = __uint_as_float(ra[0]); g1[i] = __uint_as_float(ra[1]);
                        auto rb = __builtin_amdgcn_permlane32_swap(__float_as_uint(gb), __float_as_uint(gb), false, false); g0[4 + i] = __uint_as_float(rb[0]); g1[4 + i] = __uint_as_float(rb[1]); }
                    float run = prun;
#pragma unroll
                    for (int x = 1; x >= 0; --x)
#pragma unroll
                        for (int i = 3; i >= 0; --i) {
                            const float E1 = run; run *= g1[4 * x + i]; const float E0 = run; run *= g0[4 * x + i]; E[4 * x + i] = hi ? E1 : E0; }
                    prun = run;
#pragma unroll
                    for (int i = 0; i < 4; ++i) { float w = E[i];
#pragma unroll
                        for (int j = 3; j >= 0; --j) { const float wn = fmul_s(w, F0[4 * i + j]); p0[4 * i + j] = fsub_s(w, wn); w = wn; }
                        w = E[4 + i];
#pragma unroll
                        for (int j = 3; j >= 0; --j) { const float wn = fmul_s(w, F1[4 * i + j]); p1[4 * i + j] = fsub_s(w, wn); w = wn; } }
                    done = !__any(prun > 1.0e-16f);
                } else {
                    if (cw - kt < 3) { const int base = t - 64 * kt - 4 * hi;
#pragma unroll
                        for (int r = 0; r < 16; ++r) { int i0 = base - ((r & 3) + 8 * (r >> 2)); int i1 = i0 - 32;
                            i0 = min(max(i0, -128), 128); i1 = min(max(i1, -128), 128);
                            p0[r] += biasT[i0 + 128]; p1[r] += biasT[i1 + 128]; } }
                    float mx = fmaxf(p0[0], p1[0]);
#pragma unroll
                    for (int r = 1; r < 16; ++r) mx = fmaxf(mx, fmaxf(p0[r], p1[r]));
                    { auto rr = __builtin_amdgcn_permlane32_swap(__float_as_uint(mx), __float_as_uint(mx), false, false); mx = fmaxf(__uint_as_float(rr[0]), __uint_as_float(rr[1])); }
                    const float mnew = fmaxf(mrun, mx), alpha = pg8::ex2(mrun - mnew); mrun = mnew;
                    float ls = 0.f;
#pragma unroll
                    for (int r = 0; r < 16; ++r) { p0[r] = pg8::ex2(p0[r] - mnew); p1[r] = pg8::ex2(p1[r] - mnew); ls += p0[r] + p1[r]; }
                    lrun = lrun * alpha + ls;
                    if (kt != cw) { if (hi == 0) wsf[r32] = alpha; asm volatile("s_waitcnt lgkmcnt(0)" ::: "memory");
#pragma unroll
                        for (int r = 0; r < 16; ++r) { const float f = wsf[crow(r, hi)]; o[0][r] *= f; o[1][r] *= f; }
                        asm volatile("s_waitcnt lgkmcnt(0)" ::: "memory"); }
                }
                pg8::u32x4 pw0, pw1, pw2, pw3;
                pw0 = (pg8::u32x4){cvtpk_s(p0[0], p0[1]), cvtpk_s(p0[2], p0[3]), cvtpk_s(p0[4], p0[5]), cvtpk_s(p0[6], p0[7])};
                pw1 = (pg8::u32x4){cvtpk_s(p0[8], p0[9]), cvtpk_s(p0[10], p0[11]), cvtpk_s(p0[12], p0[13]), cvtpk_s(p0[14], p0[15])};
                pw2 = (pg8::u32x4){cvtpk_s(p1[0], p1[1]), cvtpk_s(p1[2], p1[3]), cvtpk_s(p1[4], p1[5]), cvtpk_s(p1[6], p1[7])};
                pw3 = (pg8::u32x4){cvtpk_s(p1[8], p1[9]), cvtpk_s(p1[10], p1[11]), cvtpk_s(p1[12], p1[13]), cvtpk_s(p1[14], p1[15])};
                pv_tile(o, (unsigned)(uintptr_t)(L + vslot) + vlane, __builtin_bit_cast(pg8::bf16x8, pw0), __builtin_bit_cast(pg8::bf16x8, pw1), __builtin_bit_cast(pg8::bf16x8, pw2), __builtin_bit_cast(pg8::bf16x8, pw3));
            }
          } }
        int ktn = kt_top - SB_NT0; int par = 0;
        for (;;) {
            if (lane == 0) act[par * 8 + wave] = (done || ktn < 0) ? 0u : 1u;
            asm volatile("s_waitcnt lgkmcnt(0)" ::: "memory");
            __syncthreads();
            unsigned any = 0;
#pragma unroll
            for (int w = 0; w < 8; ++w) any |= act[par * 8 + w];
            par ^= 1;
            if (!any) break;
            SB_DMA1(ktn, SB_B, SB_BV); if (ktn >= 1) SB_DMA1(ktn - 1, SB_B + 8192, SB_BV + 8192);
            asm volatile("s_waitcnt vmcnt(0)" ::: "memory");
            __syncthreads();
#pragma nounroll
            for (int j = 0; j < 2; ++j) { const int kt = ktn - j;
                if (kt >= 0 && !done) { const int kslot = SB_B + j * 8192, vslot = SB_BV + j * 8192;
                const unsigned kb = (unsigned)(uintptr_t)(L + kslot) + klane;
                f32x16 p0, p1;
                { const float cinit = (MODE == 1 && cw - kt >= 3) ? biasT[256] : 0.f;
#pragma unroll
                  for (int r = 0; r < 16; ++r) { p0[r] = cinit; p1[r] = cinit; } }
                pg8::bf16x8 kfr[8];
#pragma unroll
                for (int d0 = 0; d0 < 4; ++d0) { kfr[2 * d0] = *(const LAS pg8::bf16x8*)(uintptr_t)(kb + d0 * 2048); kfr[2 * d0 + 1] = *(const LAS pg8::bf16x8*)(uintptr_t)(kb + d0 * 2048 + 512); }
                __builtin_amdgcn_sched_barrier(0);
#pragma unroll
                for (int d0 = 0; d0 < 4; ++d0) { p0 = __builtin_amdgcn_mfma_f32_32x32x16_bf16(kfr[2 * d0], qr[d0], p0, 0, 0, 0); p1 = __builtin_amdgcn_mfma_f32_32x32x16_bf16(kfr[2 * d0 + 1], qr[d0], p1, 0, 0, 0); }
                if (MODE == 0) {
                    float F0[16], F1[16];
#pragma unroll
                    for (int r = 0; r < 16; ++r) { F0[r] = pg8::rcp(1.0f + pg8::ex2(p0[r])); F1[r] = pg8::rcp(1.0f + pg8::ex2(p1[r])); }
                    if (kt == cw) { const int kbase = 64 * kt + 4 * hi;
#pragma unroll
                        for (int r = 0; r < 16; ++r) { const int kv = kbase + (r & 3) + 8 * (r >> 2); if (kv >= t) F0[r] = 1.0f; if (kv + 32 >= t) F1[r] = 1.0f; } }
                    float g0[8], g1[8], E[8];
#pragma unroll
                    for (int i = 0; i < 4; ++i) { const float ga = fmul_s(fmul_s(F0[4 * i], F0[4 * i + 1]), fmul_s(F0[4 * i + 2], F0[4 * i + 3])), gb = fmul_s(fmul_s(F1[4 * i], F1[4 * i + 1]), fmul_s(F1[4 * i + 2], F1[4 * i + 3]));
                        auto ra = __builtin_amdgcn_permlane32_swap(__float_as_uint(ga), __float_as_uint(ga), false, false); g0[i] = __uint_as_float(ra[0]); g1[i] = __uint_as_float(ra[1]);
                        auto rb = __builtin_amdgcn_permlane32_swap(__float_as_uint(gb), __float_as_uint(gb), false, false); g0[4 + i] = __uint_as_float(rb[0]); g1[4 + i] = __uint_as_float(rb[1]); }
                    float run = prun;
#pragma unroll
                    for (int x = 1; x >= 0; --x)
#pragma unroll
                        for (int i = 3; i >= 0; --i) {
                            const float E1 = run; run *= g1[4 * x + i]; const float E0 = run; run *= g0[4 * x + i]; E[4 * x + i] = hi ? E1 : E0; }
                    prun = run;
#pragma unroll
                    for (int i = 0; i < 4; ++i) { float w = E[i];
#pragma unroll
                        for (int j = 3; j >= 0; --j) { const float wn = fmul_s(w, F0[4 * i + j]); p0[4 * i + j] = fsub_s(w, wn); w = wn; }
                        w = E[4 + i];
#pragma unroll
                        for (int j = 3; j >= 0; --j) { const float wn = fmul_s(w, F1[4 * i + j]); p1[4 * i + j] = fsub_s(w, wn); w = wn; } }
                    done = !__any(prun > 1.0e-16f);
                } else {
                    if (cw - kt < 3) { const int base = t - 64 * kt - 4 * hi;
#pragma unroll
                        for (int r = 0; r < 16; ++r) { int i0 = base - ((r & 3) + 8 * (r >> 2)); int i1 = i0 - 32;
                            i0 = min(max(i0, -128), 128); i1 = min(max(i1, -128), 128);
                            p0[r] += biasT[i0 + 128]; p1[r] += biasT[i1 + 128]; } }
                    float mx = fmaxf(p0[0], p1[0]);
#pragma unroll
                    for (int r = 1; r < 16; ++r) mx = fmaxf(mx, fmaxf(p0[r], p1[r]));
                    { auto rr = __builtin_amdgcn_permlane32_swap(__float_as_uint(mx), __float_as_uint(mx), false, false); mx = fmaxf(__uint_as_float(rr[0]), __uint_as_float(rr[1])); }
                    const float mnew = fmaxf(mrun, mx), alpha = pg8::ex2(mrun - mnew); mrun = mnew;
                    float ls = 0.f;
#pragma unroll
                    for (int r = 0; r < 16; ++r) { p0[r] = pg8::ex2(p0[r] - mnew); p1[r] = pg8::ex2(p1[r] - mnew); ls += p0[r] + p1[r]; }
                    lrun = lrun * alpha + ls;
                    if (kt != cw) { if (hi == 0) wsf[r32] = alpha; asm volatile("s_waitcnt lgkmcnt(0)" ::: "memory");
#pragma unroll
                        for (int r = 0; r < 16; ++r) { const float f = wsf[crow(r, hi)]; o[0][r] *= f; o[1][r] *= f; }
                        asm volatile("s_waitcnt lgkmcnt(0)" ::: "memory"); }
                }
                pg8::u32x4 pw0, pw1, pw2, pw3;
                pw0 = (pg8::u32x4){cvtpk_s(p0[0], p0[1]), cvtpk_s(p0[2], p0[3]), cvtpk_s(p0[4], p0[5]), cvtpk_s(p0[6], p0[7])};
                pw1 = (pg8::u32x4){cvtpk_s(p0[8], p0[9]), cvtpk_s(p0[10], p0[11]), cvtpk_s(p0[12], p0[13]), cvtpk_s(p0[14], p0[15])};
                pw2 = (pg8::u32x4){cvtpk_s(p1[0], p1[1]), cvtpk_s(p1[2], p1[3]), cvtpk_s(p1[4], p1[5]), cvtpk_s(p1[6], p1[7])};
                pw3 = (pg8::u32x4){cvtpk_s(p1[8], p1[9]), cvtpk_s(p1[10], p1[11]), cvtpk_s(p1[12], p1[13]), cvtpk_s(p1[14], p1[15])};
                pv_tile(o, (unsigned)(uintptr_t)(L + vslot) + vlane, __builtin_bit_cast(pg8::bf16x8, pw0), __builtin_bit_cast(pg8::bf16x8, pw1), __builtin_bit_cast(pg8::bf16x8, pw2), __builtin_bit_cast(pg8::bf16x8, pw3));
                } }
            ktn -= 2;
        }
        const int idx_n = idx + G; const bool more = idx_n < NB * NHEAD * 8;
        int bn = 0, hn = 0, qbn = 0; pg8::bf16x8 qn[4];
        if (more) { SB_UNIT(idx_n, bn, hn, qbn); const size_t rbn = (size_t)bn * SEQ;
            const bf16* qp = Q + (rbn + 256 * qbn + 32 * wave + r32) * D + hn * HD + hi * 8;
#pragma unroll
            for (int d0 = 0; d0 < 4; ++d0) qn[d0] = *(const pg8::bf16x8*)(qp + d0 * 16);
            ksrc = K + (rbn + lane) * D + hn * HD + wave * 8; vsrc = V + (rbn + 16 * (wave & 3) + (lane >> 2)) * D + hn * HD + (wave >> 2) * 32 + (lane & 3) * 8;
#pragma unroll
            for (int j = 0; j < SB_NT0; ++j) { const int kt = 4 * qbn + 3 - j; if (kt >= 0) SB_DMA1(kt, j * 8192, SB_VA + j * 8192); } }
#pragma unroll
        for (int r = 0; r < 16; ++r) { const int q = crow(r, hi); stg[q * 64 + r32] = bf1(o[0][r]); stg[q * 64 + 32 + r32] = bf1(o[1][r]); }
        LDS_WAIT();
        bf16* op = O + (rowbase + r0) * D + h * HD;
#pragma unroll
        for (int i = 0; i < 4; ++i) { const int row = i * 8 + (lane >> 3), ch = lane & 7; const v4u v = *(const LAS v4u*)(stg + row * 64 + ch * 8); *(v4u*)(op + (size_t)row * D + ch * 8) = v; }
        LDS_WAIT();
        if (!more) break;
        idx = idx_n; b = bn; h = hn; qb = qbn;
#pragma unroll
        for (int d0 = 0; d0 < 4; ++d0) qr[d0] = qn[d0];
    }
#undef SB_UNIT
#undef SB_DMA1
    VM_WAIT(); LDS_WAIT(); __syncthreads();
}

constexpr int SP_VBUF = 32768, SP_GATE = 65536, SP_GPITCH = 136;
__device__ __forceinline__ void spatial_phase(bf16* U, const bf16* Vb, const float* vpart, const float* ws, const float* bs, const float* vg, LAS unsigned char* L, int vcu, int G, int wave, int lane, int tid) {
    LAS float* psum = (LAS float*)(L + XTRA_OFF);
    LAS float* rstdL = psum + 512;
    LAS bf16* gateT = (LAS bf16*)(L + SP_GATE);
    const int r32 = lane & 31, hi = lane >> 5, ib = wave & 3, cbw = wave >> 2;
    const unsigned vlane = ((lane >> 4) & 1) * 32 + (lane & 3) * 8 + (4 * hi + ((lane & 15) >> 2)) * 64;
    const int njt = ib < 2 ? 1 : 2;
    for (int win = vcu; win < NB * 16; win += G) {
        const size_t tok0 = (size_t)win * 128;
        { const int j = tid & 127, part = tid >> 7; const f32x4* p = (const f32x4*)(vpart + (tok0 + j) * 48 + part * 12); const f32x4 a = p[0], c = p[1], d = p[2];
          psum[part * 128 + j] = ((a[0] + a[1]) + (a[2] + a[3])) + ((c[0] + c[1]) + (c[2] + c[3])) + ((d[0] + d[1]) + (d[2] + d[3])); }
        __syncthreads();
        if (tid < 128) rstdL[tid] = __builtin_amdgcn_rsqf(((psum[tid] + psum[128 + tid]) + (psum[256 + tid] + psum[384 + tid])) * (1.0f / SGH) + EPSN);
        __syncthreads();
        const bf16* vsrc0 = Vb + (tok0 + 64 * ((wave >> 1) & 1) + (lane >> 2)) * SGH + (wave >> 2) * 64 + (wave & 1) * 32 + (lane & 3) * 8;
        const int vdst0 = (wave >> 2) * 16384 + ((wave >> 1) & 1) * 8192 + (wave & 1) * 4096;
#define SP_DMA(c0_, buf_) do { _Pragma("unroll") for (int k = 0; k < 4; ++k) \
        __builtin_amdgcn_global_load_lds((const unsigned*)(vsrc0 + (size_t)(16 * k) * SGH + (c0_)), (LAS unsigned*)(L + (buf_) * SP_VBUF + vdst0 + k * 1024), 16, 0, 0); } while (0)
        SP_DMA(0, 0);
        pg8::u32x4 pw[2][4]; float bsv[16];
        for (int u = 0; u < 24; ++u) {
            const int g = u / 3, c0 = g * 384 + (u - 3 * g) * 128, buf = u & 1;
            if (u == 0) asm volatile("s_waitcnt vmcnt(0)" ::: "memory");
            else asm volatile("s_waitcnt vmcnt(8)" ::: "memory");
            __syncthreads();
            if (u + 1 < 24) { const int g1 = (u + 1) / 3; SP_DMA(g1 * 384 + (u + 1 - 3 * g1) * 128, buf ^ 1); }
            asm volatile("" ::: "memory");
            v4u uv[4];
#pragma unroll
            for (int k = 0; k < 4; ++k) { const int q = tid + 512 * k; uv[k] = *(const v4u*)(U + (tok0 + (q >> 4)) * SGH + c0 + (q & 15) * 8); }
            if (u == 3 * g) {
#pragma unroll
                for (int jt = 0; jt < 2; ++jt) if (jt < njt) {
                    const float* wrow = ws + ((size_t)g * 128 + 32 * ib + r32) * 128 + 64 * jt + 4 * hi;
#pragma unroll
                    for (int ks = 0; ks < 4; ++ks) { const f32x4 wa = *(const f32x4*)(wrow + 16 * ks), wb = *(const f32x4*)(wrow + 16 * ks + 8);
                        const f32x4 ra = *(const LAS f32x4*)(rstdL + 64 * jt + 16 * ks + 4 * hi), rb = *(const LAS f32x4*)(rstdL + 64 * jt + 16 * ks + 4 * hi + 8);
                        pw[jt][ks] = pg8::pack8(wa * ra, wb * rb); } }
#pragma unroll
                for (int r = 0; r < 16; ++r) bsv[r] = bs[g * 128 + 32 * ib + crow(r, hi)];
            }
            const float vg0 = vg[c0 + cbw * 64 + r32], vg1 = vg[c0 + cbw * 64 + 32 + r32];
            f32x16 o[2];
#pragma unroll
            for (int r = 0; r < 16; ++r) { o[0][r] = 0.f; o[1][r] = 0.f; }
            const unsigned vb = (unsigned)(uintptr_t)(L + buf * SP_VBUF + cbw * 16384) + vlane;
            pv_tile(o, vb, __builtin_bit_cast(pg8::bf16x8, pw[0][0]), __builtin_bit_cast(pg8::bf16x8, pw[0][1]), __builtin_bit_cast(pg8::bf16x8, pw[0][2]), __builtin_bit_cast(pg8::bf16x8, pw[0][3]));
            if (njt == 2) pv_tile(o, vb + 8192, __builtin_bit_cast(pg8::bf16x8, pw[1][0]), __builtin_bit_cast(pg8::bf16x8, pw[1][1]), __builtin_bit_cast(pg8::bf16x8, pw[1][2]), __builtin_bit_cast(pg8::bf16x8, pw[1][3]));
#pragma unroll
            for (int r = 0; r < 16; ++r) { LAS bf16* gp = gateT + (32 * ib + crow(r, hi)) * SP_GPITCH + cbw * 64 + r32;
                gp[0] = bf1(o[0][r] * vg0 + bsv[r]); gp[32] = bf1(o[1][r] * vg1 + bsv[r]); }
            LDS_WAIT(); __syncthreads();
#pragma unroll
            for (int k = 0; k < 4; ++k) { const int q = tid + 512 * k; const v4u gt = *(const LAS v4u*)(gateT + (q >> 4) * SP_GPITCH + (q & 15) * 8);
                v4u y;
#pragma unroll
                for (int e = 0; e < 4; ++e) y[e] = pg8::cvt_pk_bf16(bf_lo(uv[k][e]) * bf_lo(gt[e]), bf_hi(uv[k][e]) * bf_hi(gt[e]));
                *(v4u*)(U + (tok0 + (q >> 4)) * SGH + c0 + (q & 15) * 8) = y; }
        }
#undef SP_DMA
        VM_WAIT(); LDS_WAIT(); __syncthreads();
    }
}

struct Args { const float* in[26]; float* out; unsigned char* ws; };
enum { I_X = 0, I_C, I_NORMG, I_ADAW, I_ADAB, I_SBWQKV, I_SBQG, I_SBKG, I_SBWO, I_SGWIN, I_SGVG, I_SGWS, I_SGBS, I_SGWOUT, I_CAWQKV, I_CAQG, I_CAKG, I_CARELB, I_CAWO, I_FFW13, I_FFW2, I_MOEWR, I_MOEBR, I_MOEW1, I_MOEW3, I_MOEW2 };

#ifndef PHMASK
#define PHMASK 0xFFFFFFFFu
#endif
#define PH(k) (((PHMASK) >> (k)) & 1u)
__device__ __forceinline__ const void* karg(int byte_off) { const void* p; asm volatile("s_load_dwordx2 %0, %1, %2\n\ts_waitcnt lgkmcnt(0)" : "=s"(p) : "s"(__builtin_amdgcn_kernarg_segment_ptr()), "i"(byte_off) : "memory"); return p; }
#define KIN(i) (a.in[i])
#define KOUT (a.out)
#define KWS (a.ws)
#ifndef PROBEMASK
#define PROBEMASK 0u
#endif
#if PROBEMASK
#define TS_BEGIN() do { ts_b = __builtin_amdgcn_s_memrealtime(); asm volatile("" ::: "memory"); } while (0)
#define TS_END(k) do { asm volatile("" ::: "memory"); if (((PROBEMASK) >> (k)) & 1u) ts_sum += __builtin_amdgcn_s_memrealtime() - ts_b; } while (0)
#define TS_SPIN() do { if (blockIdx.x == 0 && threadIdx.x == 0) { const unsigned long long t0_ = __builtin_amdgcn_s_memrealtime(); while (__builtin_amdgcn_s_memrealtime() - t0_ < ts_sum) __builtin_amdgcn_s_sleep(8); } } while (0)
#else
#define TS_BEGIN() do {} while (0)
#define TS_END(k) do {} while (0)
#define TS_SPIN() do {} while (0)
#endif
__global__ void __launch_bounds__(NWAVES * 64, 2) fwd_kernel(Args a) {
    extern __shared__ __attribute__((aligned(16))) unsigned char lds[];
    LAS unsigned char* L = (LAS unsigned char*)lds;
    const int G = gridDim.x, bx = blockIdx.x, vcu = (G % 8 == 0) ? (bx % 8) * (G / 8) + bx / 8 : bx;
#define PHASE_IDS int tid = threadIdx.x; asm volatile("" : "+v"(tid)); const int lane = tid & 63, wave = __builtin_amdgcn_readfirstlane(tid >> 6); const int gwi = wave * G + vcu, NGW = G * NWAVES; (void)gwi; (void)NGW; (void)lane
    volatile LAS unsigned* MISC = (volatile LAS unsigned*)(L + MISC_OFF);
    if (threadIdx.x < 64) MISC[threadIdx.x] = 0u;
    __syncthreads();
#define mod ((float*)(KWS + WS_MOD))
#define gains ((float*)(KWS + WS_GAINS))
#define WQKV0 ((bf16*)(KWS + WS_WQKV0))
#define WQKV1 ((bf16*)(KWS + WS_WQKV1))
#define WQKVC ((bf16*)(KWS + WS_WQKVC))
#define WO0 ((bf16*)(KWS + WS_WO0))
#define WO1 ((bf16*)(KWS + WS_WO1))
#define WOC ((bf16*)(KWS + WS_WOC))
#define WIN ((bf16*)(KWS + WS_WIN))
#define WOUT ((bf16*)(KWS + WS_WOUT))
#define W13_0 ((bf16*)(KWS + WS_W13_0))
#define W13_1 ((bf16*)(KWS + WS_W13_1))
#define W2_0 ((bf16*)(KWS + WS_W2_0))
#define W2_1 ((bf16*)(KWS + WS_W2_1))
#define MOE13 ((bf16*)(KWS + WS_MOE13))
#define MOE2 ((bf16*)(KWS + WS_MOE2))
#define MOE2B ((bf16*)(KWS + WS_MOE2B))
#define cscale2b ((float*)(KWS + WS_CS + 476 * 1024))
#define H ((bf16*)(KWS + WS_H))
#define AS ((bf16*)(KWS + WS_AS))
#define YB ((bf16*)(KWS + WS_AS))
#define ACT ((bf16*)(KWS + WS_ACT))
#define Qb ACT
#define Kb (ACT + (size_t)MTOK * D)
#define Vb (ACT + (size_t)2 * MTOK * D)
#define Ub ACT
#define Vg (ACT + (size_t)MTOK * SGH)
#define rowinfo ((int*)(KWS + WS_ROWINFO))
#define troute ((int*)(KWS + WS_TROUTE))
#define tw ((float*)(KWS + WS_TW))
#define vpart ((float*)(KWS + WS_VPART))
#define cscale ((float*)(KWS + WS_CS))
#define cscale_d ((float*)(KWS + WS_CS + 256 * 1024))
#define cscale_q ((float*)(KWS + WS_CS + 320 * 1024))
#define cscale_w ((float*)(KWS + WS_CS + 384 * 1024))
#define cscale_o ((float*)(KWS + WS_CS + 448 * 1024))
#define Y8 ((unsigned char*)(KWS + WS_AS))
#define hscale ((float*)(KWS + WS_HSC))
#define rscale ((float*)(KWS + WS_RS))
#define X ((bf16*)(KWS + WS_XB))
#define x_in (KIN(I_X))
#define normg (KIN(I_NORMG))
#define ctl ((unsigned*)(KWS + WS_CTL))
    XcdBarrier bar = xcd_barrier_post(ctl + CW_BAR, MISC + 8);
#define GRID_BAR() xcd_barrier(bar)
#define OPP_CONV(site_, drain_) if (PH(0)) { PHASE_IDS; moe3_conv_opp(site_, drain_, KIN(I_MOEW1) + (size_t)NEXP * D * DFE, KIN(I_MOEW3) + (size_t)NEXP * D * DFE, KIN(I_MOEW2) + (size_t)NEXP * DFE * D, \
        (unsigned char*)MOE13, cscale, (unsigned char*)MOE2B, cscale2b, ctl, bar, L, tid, wave, lane); }
#define MOE2_PHASE(cntp_, Bw_, csp_, layer_) { const LAS int* preL_ = (const LAS int*)(L + MISC_OFF + 64); pg8::moe_order_setup((LAS int*)(L + MISC_OFF + 64), cntp_); \
      const int total_ = __builtin_amdgcn_readfirstlane(preL_[8]) * (D / 256), nfull_ = (total_ / G) * G, T_ = total_ - nfull_; \
      const int S_ = T_ == 0 ? 1 : (T_ * 7 <= G ? 7 : (T_ * 2 <= G ? 2 : 1)); \
      pg8::MoeOrderLim S{preL_, D / 256, G, bx, S_ > 1 ? nfull_ : total_}; pg8::Gemm g{ACT, Bw_, 0, 0, DFE / 2, 0}; \
      pg8::EpiMoeOut E{YB, rowinfo, MTOK, csp_}; \
      pg8::gemm_phase<pg8::EpiMoeOut, pg8::MoeOrderLim, true, true, true, false>(L, g, S, E); \
      if (S_ > 1) { pg8::SplitOrder S2{preL_, D / 256, bx, nfull_, T_, S_, DFE / S_}; pg8::Gemm g2{ACT, Bw_, 0, 0, DFE / 2 / S_, DFE / 2}; \
          pg8::EpiMoeSplit E2{E, (float*)H, ctl + CW_SPLIT + (layer_) * 4096, S_}; \
          pg8::gemm_phase<pg8::EpiMoeSplit, pg8::SplitOrder, true, true, true, false>(L, g2, S2, E2); } }
    const float QS = 0.125f * LOG2E;
    unsigned long long ts_b = 0, ts_sum = 0; (void)ts_b; (void)ts_sum;

    TS_BEGIN();
    if (PH(0)) { PHASE_IDS;
        LAS float* cond = (LAS float*)L;
        const float* c = KIN(I_C);
        {   float cv[NB * D / (NWAVES * 64)];
#pragma unroll
            for (int i = 0; i < NB * D / (NWAVES * 64); ++i) cv[i] = c[tid + NWAVES * 64 * i];
#pragma unroll
            for (int i = 0; i < NB * D / (NWAVES * 64); ++i) { const int u = tid + NWAVES * 64 * i, b = u >> 10, k = u & (D - 1); const float v = cv[i]; cond[k * 16 + b] = v / (1.0f + __expf(-v)); } }
        if (bx == 0) for (int gi = tid; gi < 576; gi += NWAVES * 64) { const int set = gi / 192, w = (gi % 192) >> 6, d = gi & 63;
            float v = 1.0f;
            if (w < 2) { const float* src = set == 2 ? (w ? KIN(I_CAKG) : KIN(I_CAQG)) : (w ? KIN(I_SBKG) : KIN(I_SBQG)) + (set == 1 ? HD : 0); v = src[d] * (w ? 1.0f : QS); }
            gains[gi] = v; }
        if (bx == 1) for (int gi = tid; gi < 4 * D; gi += NWAVES * 64) cscale_o[gi] = 1.0f;
        __syncthreads();
        constexpr int C_MOD = 4 * 384, C_QKV = 3 * D / 32, C_WO = 16 * 16, C_WIN = 2 * SGH / 32, C_WOUT = 48 * 16, C_W13 = 2 * DFF / 32, C_W2 = D / 32;
        {
            LAS float* amx = (LAS float*)(L + XTRA_OFF);
            constexpr int WG_TOTAL = 3 * C_QKV + C_WIN + 2 * C_W13 + 2 * NEXP * IT_MOE8;
            int par = 0;
            for (int it = vcu; it < WG_TOTAL; it += G, par ^= 1) {
                int r = it, map = 1, nb = 0, N = 3 * D; const float* W = KIN(I_SBWQKV); unsigned char* dst = (unsigned char*)WQKV0; float* cs = cscale_q;
                if (r < C_QKV) { nb = r; }
                else if ((r -= C_QKV) < C_QKV) { nb = r; W = KIN(I_SBWQKV) + (size_t)D * 3 * D; dst = (unsigned char*)WQKV1; cs = cscale_q + 3 * D; }
                else if ((r -= C_QKV) < C_QKV) { nb = r; W = KIN(I_CAWQKV); dst = (unsigned char*)WQKVC; cs = cscale_q + 6 * D; }
                else if ((r -= C_QKV) < C_WIN) { nb = r; map = 0; N = 2 * SGH; W = KIN(I_SGWIN); dst = (unsigned char*)WIN; cs = cscale_w; }
                else if ((r -= C_WIN) < C_W13) { nb = r; map = 2; N = 2 * DFF; W = KIN(I_FFW13); dst = (unsigned char*)W13_0; cs = cscale_d; }
                else if ((r -= C_W13) < C_W13) { nb = r; map = 2; N = 2 * DFF; W = KIN(I_FFW13) + (size_t)D * 2 * DFF; dst = (unsigned char*)W13_1; cs = cscale_d + 2 * DFF; }
                else if ((r -= C_W13) < NEXP * IT_MOE8) { const int e = r / IT_MOE8; nb = r % IT_MOE8; map = 3; N = DFE; W = KIN(I_MOEW1) + (size_t)e * D * DFE; dst = (unsigned char*)MOE13 + (size_t)e * 2 * DFE * D; cs = cscale + e * 2 * DFE; }
                else { r -= NEXP * IT_MOE8; const int e = r / IT_MOE8; nb = r % IT_MOE8; map = 4; N = DFE; W = KIN(I_MOEW3) + (size_t)e * D * DFE; dst = (unsigned char*)MOE13 + (size_t)e * 2 * DFE * D; cs = cscale + e * 2 * DFE; }
                conv8_wg_item(map, nb, W, N, dst, cs, amx, par, wave, lane);
            }
        }
        __syncthreads();
        {
            LAS float* amx = (LAS float*)(L + XTRA_OFF);
            int par = 0;
            for (int it0 = vcu; it0 < NEXP * IT_MOE2 + ((2 * C_W2 + G - 1) / G) * G; it0 += G, par ^= 1) {
                int it = it0; if (it >= NEXP * IT_MOE2) { const int d = it0 - NEXP * IT_MOE2; it = NEXP * IT_MOE2 + (d % G + G - 64 % G) % G + (d / G) * G; if (it >= NEXP * IT_MOE2 + 2 * C_W2) continue; }
                if (it < NEXP * IT_MOE2) { const int e = it / IT_MOE2; convf8_wg_item<DFE>(it % IT_MOE2, KIN(I_MOEW2) + (size_t)e * DFE * D, D, (unsigned char*)MOE2 + (size_t)e * D * DFE, cscale + NEXP * 2 * DFE + e * D, amx, par, wave, lane); }
                else { const int r = it - NEXP * IT_MOE2, l = r / C_W2; convf8_wg_item<DFF>(r % C_W2, KIN(I_FFW2) + (size_t)l * DFF * D, D, (unsigned char*)W2_0 + (size_t)l * (WS_W2_1 - WS_W2_0), cscale_o + (4 + l) * D, amx, par, wave, lane); }
            }
        }
        constexpr int TOTAL = C_MOD + 3 * C_WO + C_WOUT;
        for (int it = gwi; it < TOTAL; it += NGW) {
            int r = it;
            if (r < C_MOD) { mod_item(r, KIN(I_ADAW), KIN(I_ADAB), mod, cond, lane); continue; } r -= C_MOD;
            if (r < C_WO) { conv_item<0>(r, KIN(I_SBWO), D, D, WO0, lane); continue; } r -= C_WO;
            if (r < C_WO) { conv_item<0>(r, KIN(I_SBWO) + (size_t)D * D, D, D, WO1, lane); continue; } r -= C_WO;
            if (r < C_WO) { conv_item<0>(r, KIN(I_CAWO), D, D, WOC, lane); continue; } r -= C_WO;
            conv_item<0>(r, KIN(I_SGWOUT), SGH, D, WOUT, lane);
        }
    }
    GRID_BAR();
    TS_END(0);

    TS_BEGIN();
    if (PH(1)) { PHASE_IDS; norm_phase<false, true, false, true, false>(x_in, nullptr, H, normg + 0 * D, mod + 0 * MODL, 0, nullptr, nullptr, nullptr, nullptr, nullptr, nullptr, nullptr, nullptr, hscale, L, vcu, G, wave, lane, tid); }
    GRID_BAR();
    TS_END(1);
    TS_BEGIN();
    if (PH(2)) { pg8::Gemm g{H, WQKV0, MTOK, 3 * D, D / 2}; pg8::StaticOrder S; S.init(MTOK, 3 * D, G, bx);
      pg8::EpiQKV E{Qb, gains + 0, hscale, cscale_q};
      pg8::gemm_phase<pg8::EpiQKV, pg8::StaticOrder, true, true, false, true>(L, g, S, E); }
    GRID_BAR();
    TS_END(2);
    TS_BEGIN();
    if (PH(3)) { PHASE_IDS; attn_sb_phase(Qb, Kb, Vb, H, L, vcu, G, wave, lane, tid); }
    GRID_BAR();
    TS_END(3);
    TS_BEGIN();
    if (PH(4)) { pg8::Gemm g{H, WO0, MTOK, D, D}; pg8::StaticOrder S; S.init(MTOK, D, G, bx);
      pg8::EpiResid16<true> E{x_in, X, mod + 0 * MODL + 2 * D, cscale_o};
      pg8::gemm_phase<pg8::EpiResid16<true>, pg8::StaticOrder, true, true>(L, g, S, E); }
    GRID_BAR();
    TS_END(4);
    TS_BEGIN();
    if (PH(1)) { PHASE_IDS; norm_phase<false, true, false, true>(X, nullptr, H, normg + 1 * D, mod + 0 * MODL, 3 * D, nullptr, nullptr, nullptr, nullptr, nullptr, nullptr, nullptr, nullptr, hscale, L, vcu, G, wave, lane, tid); }
    GRID_BAR();
    TS_END(1);
    TS_BEGIN();
    if (PH(5)) { pg8::Gemm g{H, W13_0, MTOK, 2 * DFF, D / 2}; pg8::StaticOrder S; S.init(MTOK, 2 * DFF, G, bx);
      pg8::EpiSwigluQ<true> E{ACT, DFF, 1 << 20, hscale, cscale_d};
      pg8::gemm_phase<pg8::EpiSwigluQ<true>, pg8::StaticOrder, true, true, false, true>(L, g, S, E); }
    GRID_BAR();
    TS_END(5);
    TS_BEGIN();
    if (PH(4)) { pg8::Gemm g{ACT, W2_0, MTOK, D, DFF / 2}; pg8::StaticOrder S; S.init(MTOK, D, G, bx);
      pg8::EpiResid16<false> E{X, X, mod + 0 * MODL + 5 * D, cscale_o + 4 * D};
      pg8::gemm_phase<pg8::EpiResid16<false>, pg8::StaticOrder, true, true, true, false>(L, g, S, E); }
    GRID_BAR();
    TS_END(4);

    TS_BEGIN();
    if (PH(1)) { PHASE_IDS; norm_phase<false, true, false, true>(X, nullptr, H, normg + 2 * D, mod + 1 * MODL, 0, nullptr, nullptr, nullptr, nullptr, nullptr, nullptr, nullptr, nullptr, hscale, L, vcu, G, wave, lane, tid); }
    GRID_BAR();
    TS_END(1);
    TS_BEGIN();
    if (PH(6)) { pg8::Gemm g{H, WIN, MTOK, 2 * SGH, D / 2}; pg8::StaticOrder S; S.init(MTOK, 2 * SGH, G, bx);
      pg8::EpiGeluSG E{Ub, Vg, vpart, hscale, cscale_w};
      pg8::gemm_phase<pg8::EpiGeluSG, pg8::StaticOrder, true, true, false, true>(L, g, S, E); }
    GRID_BAR();
    TS_END(6);
    TS_BEGIN();
    if (PH(7)) { PHASE_IDS; spatial_phase(Ub, Vg, vpart, KIN(I_SGWS), KIN(I_SGBS), KIN(I_SGVG), L, vcu, G, wave, lane, tid); }
    GRID_BAR();
    TS_END(7);
    TS_BEGIN();
    if (PH(4)) { pg8::Gemm g{Ub, WOUT, MTOK, D, SGH}; pg8::StaticOrder S; S.init(MTOK, D, G, bx);
      pg8::EpiResid16<false> E{X, X, mod + 1 * MODL + 2 * D, cscale_o + 3 * D};
      pg8::gemm_phase<pg8::EpiResid16<false>, pg8::StaticOrder, true, true>(L, g, S, E); }
    GRID_BAR();
    TS_END(4);
    TS_BEGIN();
    if (PH(8)) { PHASE_IDS; norm_phase<false, true, true>(X, nullptr, H, normg + 3 * D, mod + 1 * MODL, 3 * D, nullptr, nullptr, nullptr, KIN(I_MOEWR), KIN(I_MOEBR), ctl + CW_CNT, troute, tw, hscale, L, vcu, G, wave, lane, tid); }
    GRID_BAR();
    TS_END(8);
    TS_BEGIN();
    if (PH(9)) { PHASE_IDS; gather_phase((const unsigned char*)H, (unsigned char*)AS, rowinfo, troute, ctl + CW_CNT, hscale, rscale, vcu, G, wave, lane, tid); }
    GRID_BAR();
    TS_END(9);
    TS_BEGIN();
    if (PH(10)) { pg8::moe_order_setup((LAS int*)(L + MISC_OFF + 64), ctl + CW_CNT); pg8::MoeOrder S{(const LAS int*)(L + MISC_OFF + 64), 2 * DFE / 256, G, bx}; pg8::Gemm g{AS, MOE13, 0, 0, D / 2};
      pg8::EpiSwigluQ<true> E{ACT, DFE, 2 * DFE / 256, rscale, cscale};
      pg8::gemm_phase<pg8::EpiSwigluQ<true>, pg8::MoeOrder, true, true, false, true>(L, g, S, E); }
    GRID_BAR();
    TS_END(10);
    TS_BEGIN();
    if (PH(11)) MOE2_PHASE(ctl + CW_CNT, MOE2, cscale + NEXP * 2 * DFE, 0)
    OPP_CONV(0, false)
    GRID_BAR();
    TS_END(11);

    TS_BEGIN();
    TS_BEGIN();
    if (PH(12)) { PHASE_IDS; norm_phase<true, true, false, true>(X, X, H, normg + 4 * D, mod + 2 * MODL, 0, mod + 1 * MODL + 5 * D, YB, tw, nullptr, nullptr, nullptr, nullptr, nullptr, hscale, L, vcu, G, wave, lane, tid); }
    GRID_BAR();
    TS_END(12);
    TS_BEGIN();
    if (PH(2)) { pg8::Gemm g{H, WQKVC, MTOK, 3 * D, D / 2}; pg8::StaticOrder S; S.init(MTOK, 3 * D, G, bx);
      pg8::EpiQKV E{Qb, gains + 384, hscale, cscale_q + 6 * D};
      pg8::gemm_phase<pg8::EpiQKV, pg8::StaticOrder, true, true, false, true>(L, g, S, E); }
    OPP_CONV(1, false)
    GRID_BAR();
    TS_END(2);
    TS_BEGIN();
    if (PH(13)) { PHASE_IDS; attn_phase<1>(Qb, Kb, Vb, H, KIN(I_CARELB), L, vcu, G, wave, lane, tid); }
    OPP_CONV(2, false)
    GRID_BAR();
    TS_END(13);
    TS_BEGIN();
    if (PH(4)) { pg8::Gemm g{H, WOC, MTOK, D, D}; pg8::StaticOrder S; S.init(MTOK, D, G, bx);
      pg8::EpiResid16<false> E{X, X, mod + 2 * MODL + 2 * D, cscale_o + 2 * D};
      pg8::gemm_phase<pg8::EpiResid16<false>, pg8::StaticOrder, true, true>(L, g, S, E); }
    OPP_CONV(3, false)
    GRID_BAR();
    TS_END(4);
    TS_BEGIN();
    if (PH(1)) { PHASE_IDS; norm_phase<false, true, false, true>(X, nullptr, H, normg + 5 * D, mod + 2 * MODL, 3 * D, nullptr, nullptr, nullptr, nullptr, nullptr, nullptr, nullptr, nullptr, hscale, L, vcu, G, wave, lane, tid); }
    GRID_BAR();
    TS_END(1);
    TS_BEGIN();
    if (PH(5)) { pg8::Gemm g{H, W13_1, MTOK, 2 * DFF, D / 2}; pg8::StaticOrder S; S.init(MTOK, 2 * DFF, G, bx);
      pg8::EpiSwigluQ<true> E{ACT, DFF, 1 << 20, hscale, cscale_d + 2 * DFF};
      pg8::gemm_phase<pg8::EpiSwigluQ<true>, pg8::StaticOrder, true, true, false, true>(L, g, S, E); }
    OPP_CONV(4, false)
    GRID_BAR();
    TS_END(5);
    TS_BEGIN();
    if (PH(4)) { pg8::Gemm g{ACT, W2_1, MTOK, D, DFF / 2}; pg8::StaticOrder S; S.init(MTOK, D, G, bx);
      pg8::EpiResid16<false> E{X, X, mod + 2 * MODL + 5 * D, cscale_o + 5 * D};
      pg8::gemm_phase<pg8::EpiResid16<false>, pg8::StaticOrder, true, true, true, false>(L, g, S, E); }
    OPP_CONV(5, false)
    GRID_BAR();
    TS_END(4);

    TS_BEGIN();
    if (PH(1)) { PHASE_IDS; norm_phase<false, true, false, true>(X, nullptr, H, normg + 6 * D, mod + 3 * MODL, 0, nullptr, nullptr, nullptr, nullptr, nullptr, nullptr, nullptr, nullptr, hscale, L, vcu, G, wave, lane, tid); }
    GRID_BAR();
    TS_END(1);
    TS_BEGIN();
    if (PH(2)) { pg8::Gemm g{H, WQKV1, MTOK, 3 * D, D / 2}; pg8::StaticOrder S; S.init(MTOK, 3 * D, G, bx);
      pg8::EpiQKV E{Qb, gains + 192, hscale, cscale_q + 3 * D};
      pg8::gemm_phase<pg8::EpiQKV, pg8::StaticOrder, true, true, false, true>(L, g, S, E); }
    OPP_CONV(6, false)
    GRID_BAR();
    TS_END(2);
    TS_BEGIN();
    if (PH(3)) { PHASE_IDS; attn_sb_phase(Qb, Kb, Vb, H, L, vcu, G, wave, lane, tid); }
    OPP_CONV(7, false)
    GRID_BAR();
    TS_END(3);
    TS_BEGIN();
    if (PH(4)) { pg8::Gemm g{H, WO1, MTOK, D, D}; pg8::StaticOrder S; S.init(MTOK, D, G, bx);
      pg8::EpiResid16<false> E{X, X, mod + 3 * MODL + 2 * D, cscale_o + D};
      pg8::gemm_phase<pg8::EpiResid16<false>, pg8::StaticOrder, true, true>(L, g, S, E); }
    OPP_CONV(8, false)
    GRID_BAR();
    TS_END(4);
    TS_BEGIN();
    if (PH(8)) { PHASE_IDS; norm_phase<false, true, true>(X, nullptr, H, normg + 7 * D, mod + 3 * MODL, 3 * D, nullptr, nullptr, nullptr, KIN(I_MOEWR) + D * NEXP, KIN(I_MOEBR) + NEXP, ctl + CW_CNT + 8 * 64, troute, tw, hscale, L, vcu, G, wave, lane, tid); }
    GRID_BAR();
    TS_END(8);
    TS_BEGIN();
    OPP_CONV(9, true)
    if (PH(9)) { PHASE_IDS; gather_phase((const unsigned char*)H, (unsigned char*)AS, rowinfo, troute, ctl + CW_CNT + 8 * 64, hscale, rscale, vcu, G, wave, lane, tid); }
    GRID_BAR();
    TS_END(9);
    TS_BEGIN();
    if (PH(10)) { pg8::moe_order_setup((LAS int*)(L + MISC_OFF + 64), ctl + CW_CNT + 8 * 64); pg8::MoeOrder S{(const LAS int*)(L + MISC_OFF + 64), 2 * DFE / 256, G, bx}; pg8::Gemm g{AS, MOE13, 0, 0, D / 2};
      pg8::EpiSwigluQ<true> E{ACT, DFE, 2 * DFE / 256, rscale, cscale};
      pg8::gemm_phase<pg8::EpiSwigluQ<true>, pg8::MoeOrder, true, true, false, true>(L, g, S, E); }
    GRID_BAR();
    TS_END(10);
    TS_BEGIN();
    if (PH(11)) MOE2_PHASE(ctl + CW_CNT + 8 * 64, MOE2B, cscale2b, 1)
    GRID_BAR();
    TS_END(11);
    TS_BEGIN();
    if (PH(14)) { PHASE_IDS; norm_phase<true, false, false, false, true, false>(X, KOUT, nullptr, nullptr, nullptr, 0, mod + 3 * MODL + 5 * D, YB, tw, nullptr, nullptr, nullptr, nullptr, nullptr, nullptr, L, vcu, G, wave, lane, tid); }
    TS_END(14);
    TS_SPIN();
#undef GRID_BAR
#undef PHASE_IDS
#undef mod
#undef gains
#undef WQKV0
#undef WQKV1
#undef WQKVC
#undef WO0
#undef WO1
#undef WOC
#undef WIN
#undef WOUT
#undef W13_0
#undef W13_1
#undef W2_0
#undef W2_1
#undef MOE13
#undef MOE2
#undef MOE2B
#undef cscale2b
#undef H
#undef AS
#undef YB
#undef ACT
#undef Qb
#undef Kb
#undef Vb
#undef Ub
#undef Vg
#undef rowinfo
#undef troute
#undef tw
#undef vpart
#undef cscale
#undef cscale_d
#undef cscale_q
#undef cscale_w
#undef cscale_o
#undef Y8
#undef hscale
#undef rscale
#undef X
#undef x_in
#undef normg
#undef ctl
}

extern "C" void kernel_launch(void* const* d_in, const int* in_sizes, int n_in, void* d_out, int out_size, void* d_ws, size_t ws_size, hipStream_t stream) {
    static int grid = 0;
    if (grid == 0) {
        if (n_in != 26 || in_sizes[0] != MTOK * D || out_size != MTOK * D || ws_size < WS_END) { fprintf(stderr, "kernel_launch: unexpected shapes (n_in %d, in0 %d, out %d, ws %zu < %zu)\n", n_in, n_in > 0 ? in_sizes[0] : -1, out_size, ws_size, (size_t)WS_END); grid = -1; return; }
        int dev = 0, cus = 0, per_cu = 0;
        if (hipGetDevice(&dev) != hipSuccess || hipDeviceGetAttribute(&cus, hipDeviceAttributeMultiprocessorCount, dev) != hipSuccess) { grid = -1; return; }
        if (hipFuncSetAttribute((const void*)fwd_kernel, hipFuncAttributeMaxDynamicSharedMemorySize, LDS_BYTES) != hipSuccess) { fprintf(stderr, "kernel_launch: hipFuncSetAttribute failed\n"); grid = -1; return; }
        if (hipOccupancyMaxActiveBlocksPerMultiprocessor(&per_cu, (const void*)fwd_kernel, NWAVES * 64, LDS_BYTES) != hipSuccess || per_cu < 1) { fprintf(stderr, "kernel_launch: occupancy query says %d\n", per_cu); }
        (void)hipGetLastError();
        grid = cus;
    }
    if (grid < 0) return;
    if (hipMemsetAsync((char*)d_ws + WS_CTL, 0, CTL_ZERO_BYTES, stream) != hipSuccess) return;
    Args a{};
    for (int i = 0; i < 26; ++i) a.in[i] = (const float*)d_in[i];
    a.out = (float*)d_out; a.ws = (unsigned char*)d_ws;
    hipLaunchKernelGGL(fwd_kernel, dim3(grid), dim3(NWAVES * 64), LDS_BYTES, stream, a);
}
```

```cpp
#include <hip/hip_runtime.h>
#include <cstdio>
#include <cstdint>
namespace pg8 {
#define PG8_LAS __attribute__((address_space(3)))
typedef unsigned short bf16_t;
typedef short bf16x8 __attribute__((ext_vector_type(8)));
typedef float f32x4 __attribute__((ext_vector_type(4)));
typedef unsigned u32x4 __attribute__((ext_vector_type(4)));
constexpr int BM = 256, BK = 64, HALF = 128, HTB = HALF * BK * 2  , STAGE_BYTES = 8 * HTB, NXCD = 8, WGM = 8;

__host__ __device__ __forceinline__ int lds_byte(int r, int c) { const int st = (r >> 4) * 2 + (c >> 5), rr = r & 15, cc = c & 31, ob = rr * 64 + cc * 2; return st * 1024 + (ob ^ (((ob >> 9) & 1) << 5)); }
__host__ __device__ __forceinline__ void stage_rc(int b, int& R, int& C) { const int st = b / 1024, sb = b % 1024, swz = sb ^ (((sb >> 9) & 1) << 5); R = (st >> 1) * 16 + swz / 64; C = (st & 1) * 32 + (swz % 64) / 2; }
__host__ __device__ __forceinline__ int perm32(int rho) { const int n = rho >> 4, i = rho & 15; return 8 * (i >> 2) + 4 * n + (i & 3); }

struct Unit { int pm, pn, ko, aux; };
struct Gemm { const bf16_t* A; const bf16_t* Bt; int M, N, K, Kp; };

struct StaticOrder {
    static constexpr bool SPLITK = false;
    int nM, nN, nwg, G, c;
    __host__ __device__ __forceinline__ void init(int M, int N, int G_, int c_) { nM = M / BM; nN = N / BM; nwg = nM * nN; G = G_; c = c_; }
    __host__ __device__ __forceinline__ bool next(int i, Unit& u) const {
        const long L = (long)i * G + c; if (L >= nwg) return false;
        int wgid = (int)L; { const int q = nwg / NXCD, r = nwg % NXCD, xcd = wgid % NXCD, off = wgid / NXCD; wgid = (xcd < r ? xcd * (q + 1) : r * (q + 1) + (xcd - r) * q) + off; }
        const int nig = WGM * nN, gid = wgid / nig, fm = gid * WGM, gsz = (nM - fm) < WGM ? (nM - fm) : WGM;
        u.pm = fm + ((wgid % nig) % gsz); u.pn = (wgid % nig) / gsz; return true;
    }
    __device__ __forceinline__ void a_ready(const Unit&) const {}
    __device__ __forceinline__ void done(const Unit&) const {}
};

__device__ __forceinline__ unsigned cvt_pk_bf16(float lo, float hi) { unsigned r; asm volatile("v_cvt_pk_bf16_f32 %0, %1, %2" : "=v"(r) : "v"(lo), "v"(hi)); return r; }
typedef float f32x2 __attribute__((ext_vector_type(2)));
typedef long long pg8_i64x2 __attribute__((ext_vector_type(2)));
__device__ __forceinline__ pg8_i64x2 zero128() { long long z0, z1; asm("v_mov_b64 %0, 0" : "=v"(z0)); asm("v_mov_b64 %0, 0" : "=v"(z1)); return (pg8_i64x2){z0, z1}; }
typedef int i32x4 __attribute__((ext_vector_type(4)));
typedef int i32x8 __attribute__((ext_vector_type(8)));
template <class Epi, class Sched, bool ALIGN_EPI = false, bool SP2 = false, bool F8 = false, bool I8 = false>
__device__ __forceinline__ void gemm_phase(PG8_LAS unsigned char* lds, const Gemm g, const Sched& S, const Epi& E) {
    int tid = threadIdx.x; asm volatile("" : "+v"(tid));
    const int wid = __builtin_amdgcn_readfirstlane(tid >> 6), lane = tid & 63, wr = wid >> 2, wc = wid & 3, fr = lane & 15, fq = lane >> 4;
    const int nt = g.K / BK, K = Sched::SPLITK ? g.Kp : g.K;
    unsigned voffA[2], voffB[2];
#pragma unroll
    for (int i = 0; i < 2; ++i) { int R, C; stage_rc(tid * 16 + i * 8192, R, C); const int Rb = Epi::PERM ? ((R & ~31) + perm32(R & 31)) : R;
        voffA[i] = (unsigned)(R * K + C) * 2u; voffB[i] = (unsigned)(Rb * K + C) * 2u; }
    const size_t kstep = (size_t)(BK * 2);
    const size_t hstep = (size_t)HALF * K * 2;
    const size_t tstep = 2 * hstep;
    const unsigned ldsw = (unsigned)wid * 1024u;
    const int aoff = lds_byte(wr * 64 + fr, fq * 8), boff = lds_byte(wc * 32 + fr, fq * 8);
#define PG8_SA(b, h) (((b) * 2 + (h)) * HTB)
#define PG8_SB(b, h) ((4 + (b) * 2 + (h)) * HTB)
#define PG8_STAGE(bufoff, gbase, voff) do { _Pragma("unroll") for (int _i = 0; _i < 2; ++_i) \
        __builtin_amdgcn_global_load_lds((const unsigned*)((const char*)(gbase) + (voff)[_i]), (PG8_LAS unsigned*)(lds + (bufoff) + ldsw + _i * 8192), 16, 0, 0); } while (0)
#define PG8_LDA(dst, b, h) do { if constexpr (F8) { _Pragma("unroll") for (int m = 0; m < 4; ++m) dst##8[m] = __builtin_shufflevector(*(const PG8_LAS i32x4*)(lds + PG8_SA(b, h) + aoff + m * 2048), *(const PG8_LAS i32x4*)(lds + PG8_SA(b, h) + aoff + m * 2048 + 1024), 0, 1, 2, 3, 4, 5, 6, 7); } \
        else { _Pragma("unroll") for (int m = 0; m < 4; ++m) _Pragma("unroll") for (int k = 0; k < 2; ++k) dst[m][k] = *(const PG8_LAS bf16x8*)(lds + PG8_SA(b, h) + aoff + m * 2048 + k * 1024); } } while (0)
#define PG8_LDB(dst, b, h) do { if constexpr (F8) { _Pragma("unroll") for (int n = 0; n < 2; ++n) dst##8[n] = __builtin_shufflevector(*(const PG8_LAS i32x4*)(lds + PG8_SB(b, h) + boff + n * 2048), *(const PG8_LAS i32x4*)(lds + PG8_SB(b, h) + boff + n * 2048 + 1024), 0, 1, 2, 3, 4, 5, 6, 7); } \
        else { _Pragma("unroll") for (int n = 0; n < 2; ++n) _Pragma("unroll") for (int k = 0; k < 2; ++k) dst[n][k] = *(const PG8_LAS bf16x8*)(lds + PG8_SB(b, h) + boff + n * 2048 + k * 1024); } } while (0)
#define PG8_MMA(ai, bj, At, Bt) do { __builtin_amdgcn_s_setprio(1); _Pragma("unroll") for (int m = 0; m < 4; ++m) _Pragma("unroll") for (int n = 0; n < 2; ++n) { \
        if constexpr (F8) { f32x4 c_; _Pragma("unroll") for (int j_ = 0; j_ < 4; ++j_) c_[j_] = accv[ai][bj][m >> 1][4 * ((m & 1) * 2 + n) + j_]; \
            c_ = __builtin_amdgcn_mfma_scale_f32_16x16x128_f8f6f4(Bt##8[n], At##8[m], c_, 0, 0, 0, 0x7F7F7F7F, 0, 0x7F7F7F7F); \
            _Pragma("unroll") for (int j_ = 0; j_ < 4; ++j_) accv[ai][bj][m >> 1][4 * ((m & 1) * 2 + n) + j_] = c_[j_]; } \
        else if constexpr (I8) { _Pragma("unroll") for (int k = 0; k < 2; ++k) acci[ai][bj][m][n] = __builtin_amdgcn_mfma_i32_16x16x64_i8(__builtin_bit_cast(i32x4, Bt[n][k]), __builtin_bit_cast(i32x4, At[m][k]), acci[ai][bj][m][n], 0, 0, 0); } \
        else { _Pragma("unroll") for (int k = 0; k < 2; ++k) acc[ai][bj][m][n] = __builtin_amdgcn_mfma_f32_16x16x32_bf16(Bt[n][k], At[m][k], acc[ai][bj][m][n], 0, 0, 0); } } \
        __builtin_amdgcn_s_setprio(0); } while (0)
#define PG8_WAIT_V(n) asm volatile("s_waitcnt vmcnt(" #n ")" ::: "memory")
#define PG8_WAIT_L(n) asm volatile("s_waitcnt lgkmcnt(" #n ")" ::: "memory")
#define PG8_BAR __builtin_amdgcn_s_barrier()
#define PG8_SCHED __builtin_amdgcn_sched_barrier(0)
    Unit cur, nxt; int ui = 0;
    if (!S.next(0, cur)) return;
    f32x4 acc[2][2][4][2];
    i32x4 acci[2][2][4][2];
#pragma unroll
    for (int a = 0; a < 2; ++a)
#pragma unroll
        for (int b = 0; b < 2; ++b)
#pragma unroll
            for (int m = 0; m < 4; ++m)
#pragma unroll
                for (int n = 0; n < 2; ++n) acci[a][b][m][n] = (i32x4){0, 0, 0, 0};
    typedef float f32x16v __attribute__((ext_vector_type(16)));
    f32x16v accv[2][2][2];
#pragma unroll
    for (int a = 0; a < 2; ++a)
#pragma unroll
        for (int b = 0; b < 2; ++b)
#pragma unroll
            for (int q = 0; q < 2; ++q)
#pragma unroll
                for (int j = 0; j < 16; ++j) accv[a][b][q][j] = 0.f;
#pragma unroll
    for (int a = 0; a < 2; ++a)
#pragma unroll
        for (int b = 0; b < 2; ++b)
#pragma unroll
            for (int m = 0; m < 4; ++m)
#pragma unroll
                for (int n = 0; n < 2; ++n) acc[a][b][m][n] = (f32x4){0.f, 0.f, 0.f, 0.f};
    bf16x8 At[4][2], B0[2][2], B1[2][2]; i32x8 At8[4], B08[2], B18[2]; (void)At; (void)B0; (void)B1; (void)At8; (void)B08; (void)B18;
    const char* cA = (const char*)g.A + (size_t)cur.pm * tstep; const char* cB = (const char*)g.Bt + (size_t)cur.pn * tstep;
    if constexpr (Sched::SPLITK) { cA += cur.ko; cB += cur.ko; }
    S.a_ready(cur);
    if constexpr (SP2) {
        PG8_STAGE(PG8_SB(0, 0), cB, voffB); PG8_STAGE(PG8_SB(0, 1), cB + hstep, voffB); PG8_STAGE(PG8_SA(0, 0), cA, voffA); PG8_STAGE(PG8_SA(0, 1), cA + hstep, voffA);
        if (wr == 1) PG8_BAR;
        PG8_WAIT_V(2); PG8_BAR;
        PG8_STAGE(PG8_SB(1, 0), cB + kstep, voffB); PG8_STAGE(PG8_SA(1, 0), cA + kstep, voffA); PG8_STAGE(PG8_SB(1, 1), cB + hstep + kstep, voffB);
        PG8_WAIT_V(6); PG8_BAR;
    } else {
        PG8_STAGE(PG8_SB(0, 0), cB, voffB); PG8_STAGE(PG8_SA(0, 0), cA, voffA); PG8_STAGE(PG8_SB(0, 1), cB + hstep, voffB); PG8_STAGE(PG8_SA(0, 1), cA + hstep, voffA);
        if (wr == 1) PG8_BAR;
        PG8_WAIT_V(4); PG8_BAR;
        PG8_STAGE(PG8_SB(1, 0), cB + kstep, voffB); PG8_STAGE(PG8_SA(1, 0), cA + kstep, voffA); PG8_STAGE(PG8_SB(1, 1), cB + hstep + kstep, voffB);
        PG8_WAIT_V(6); PG8_BAR;
    }
    for (;;) {
        const bool has_next = S.next(ui + 1, nxt);
        const char* nA = has_next ? (const char*)g.A + (size_t)nxt.pm * tstep + (Sched::SPLITK ? nxt.ko : 0) : cA; const char* nB = has_next ? (const char*)g.Bt + (size_t)nxt.pn * tstep + (Sched::SPLITK ? nxt.ko : 0) : cB;
#pragma nounroll
        for (int t = 0; t < nt; t += 2) {
            const bool last = (t == nt - 2);
            const char* a1 = cA + (size_t)(t + 1) * kstep;
            const char* a2 = last ? nA : cA + (size_t)(t + 2) * kstep; const char* b2 = last ? nB : cB + (size_t)(t + 2) * kstep;
            const char* a3 = a2 + kstep; const char* b3 = b2 + kstep;
            if (last && has_next) S.a_ready(nxt);
            if constexpr (SP2) {
            PG8_LDB(B0, 0, 0); PG8_LDB(B1, 0, 1); PG8_SCHED; PG8_LDA(At, 0, 0); PG8_STAGE(PG8_SA(1, 1), a1 + hstep, voffA);
            PG8_WAIT_V(8); PG8_WAIT_L(0); PG8_BAR; PG8_MMA(0, 0, At, B0); PG8_MMA(0, 1, At, B1); PG8_BAR; PG8_SCHED;
            PG8_LDA(At, 0, 1); PG8_STAGE(PG8_SB(0, 0), b2, voffB); PG8_STAGE(PG8_SB(0, 1), b2 + hstep, voffB); PG8_STAGE(PG8_SA(0, 0), a2, voffA);
            PG8_WAIT_V(8); PG8_WAIT_L(0); PG8_BAR; PG8_MMA(1, 0, At, B0); PG8_MMA(1, 1, At, B1); PG8_BAR; PG8_SCHED;
            PG8_LDB(B0, 1, 0); PG8_LDB(B1, 1, 1); PG8_SCHED; PG8_LDA(At, 1, 0); PG8_STAGE(PG8_SA(0, 1), a2 + hstep, voffA);
            PG8_WAIT_V(8); PG8_WAIT_L(0); PG8_BAR; PG8_MMA(0, 0, At, B0); PG8_MMA(0, 1, At, B1); PG8_BAR; PG8_SCHED;
            PG8_LDA(At, 1, 1); PG8_STAGE(PG8_SB(1, 0), b3, voffB); PG8_STAGE(PG8_SB(1, 1), b3 + hstep, voffB); PG8_STAGE(PG8_SA(1, 0), a3, voffA);
            PG8_WAIT_V(8); PG8_WAIT_L(0); PG8_BAR; PG8_MMA(1, 0, At, B0); PG8_MMA(1, 1, At, B1); PG8_BAR; PG8_SCHED;
            } else {
            PG8_LDB(B0, 0, 0); PG8_SCHED; PG8_LDA(At, 0, 0); PG8_STAGE(PG8_SA(1, 1), a1 + hstep, voffA);
            PG8_WAIT_L(8); PG8_BAR; PG8_WAIT_L(0); PG8_MMA(0, 0, At, B0); PG8_BAR; PG8_SCHED;
            PG8_LDB(B1, 0, 1); PG8_STAGE(PG8_SB(0, 0), b2, voffB);
            PG8_BAR; PG8_WAIT_L(0); PG8_MMA(0, 1, At, B1); PG8_BAR;
            PG8_LDA(At, 0, 1); PG8_STAGE(PG8_SA(0, 0), a2, voffA);
            PG8_BAR; PG8_WAIT_L(0); PG8_MMA(1, 0, At, B0); PG8_BAR; PG8_SCHED;
            PG8_STAGE(PG8_SB(0, 1), b2 + hstep, voffB);
            PG8_WAIT_V(6); PG8_BAR; PG8_MMA(1, 1, At, B1); PG8_BAR;
            PG8_LDB(B0, 1, 0); PG8_SCHED; PG8_LDA(At, 1, 0); PG8_STAGE(PG8_SA(0, 1), a2 + hstep, voffA);
            PG8_WAIT_L(8); PG8_BAR; PG8_WAIT_L(0); PG8_MMA(0, 0, At, B0); PG8_BAR; PG8_SCHED;
            PG8_LDB(B1, 1, 1); PG8_STAGE(PG8_SB(1, 0), b3, voffB);
            PG8_BAR; PG8_WAIT_L(0); PG8_MMA(0, 1, At, B1); PG8_BAR;
            PG8_LDA(At, 1, 1); PG8_STAGE(PG8_SA(1, 0), a3, voffA);
            PG8_BAR; PG8_WAIT_L(0); PG8_MMA(1, 0, At, B0); PG8_BAR; PG8_SCHED;
            PG8_STAGE(PG8_SB(1, 1), b3 + hstep, voffB);
            PG8_WAIT_V(6); PG8_BAR; PG8_MMA(1, 1, At, B1); PG8_BAR;
            }
        }
        if constexpr (ALIGN_EPI) { if (wr == 0) PG8_BAR; }
        if constexpr (F8) {
#pragma unroll
            for (int a = 0; a < 2; ++a)
#pragma unroll
                for (int b = 0; b < 2; ++b)
#pragma unroll
                    for (int m = 0; m < 4; ++m)
#pragma unroll
                        for (int n = 0; n < 2; ++n)
#pragma unroll
                            for (int j = 0; j < 4; ++j) { acc[a][b][m][n][j] = accv[a][b][m >> 1][4 * ((m & 1) * 2 + n) + j]; accv[a][b][m >> 1][4 * ((m & 1) * 2 + n) + j] = 0.f; } }
        if constexpr (I8) {
#pragma unroll
            for (int a = 0; a < 2; ++a)
#pragma unroll
                for (int b = 0; b < 2; ++b)
#pragma unroll
                    for (int m = 0; m < 4; ++m)
#pragma unroll
                        for (int n = 0; n < 2; ++n) { acc[a][b][m][n] = __builtin_convertvector(acci[a][b][m][n], f32x4); acci[a][b][m][n] = __builtin_bit_cast(i32x4, zero128()); } }
        if constexpr (!Epi::AFTER_DRAIN) { int tid2 = threadIdx.x; asm volatile("" : "+v"(tid2));
            E(acc, cur, wr, wc, tid2 & 15, (tid2 & 63) >> 4); S.done(cur); }
        if (!has_next) break;
#pragma unroll
        for (int a = 0; a < 2; ++a)
#pragma unroll
            for (int b = 0; b < 2; ++b)
#pragma unroll
                for (int m = 0; m < 4; ++m)
#pragma unroll
                    for (int n = 0; n < 2; ++n) acc[a][b][m][n] = __builtin_bit_cast(f32x4, zero128());
        cur = nxt; cA = nA; cB = nB; ++ui;
        if constexpr (ALIGN_EPI) { if (wr == 1) PG8_BAR; }
    }
    PG8_WAIT_V(0);
    if constexpr (!ALIGN_EPI) { if (wr == 0) PG8_BAR; }
    PG8_BAR;
    if constexpr (Epi::AFTER_DRAIN) { E.fused(acc, cur, wr, wc, fr, fq, lds, wid, lane); S.done(cur); }
#undef PG8_SA
#undef PG8_SB
#undef PG8_STAGE
#undef PG8_LDA
#undef PG8_LDB
#undef PG8_MMA
#undef PG8_WAIT_V
#undef PG8_WAIT_L
#undef PG8_BAR
#undef PG8_SCHED
}
}
namespace pg8 {
__device__ __forceinline__ float ex2(float x) { return __builtin_amdgcn_exp2f(x); }
__device__ __forceinline__ float rcp(float x) { return __builtin_amdgcn_rcpf(x); }
__device__ __forceinline__ float silu_f(float a) { return a * rcp(1.0f + ex2(a * -1.4426950408889634f)); }
__device__ __forceinline__ float gelu_t(float x) { const float w = __builtin_fmaf(x * x, 0.044715f * -2.3022081981405e+00f, -2.3022081981405e+00f); return x * rcp(1.0f + ex2(x * w)); }
__device__ __forceinline__ u32x4 pack8(const f32x4 a, const f32x4 b) { u32x4 w; w.x = cvt_pk_bf16(a[0], a[1]); w.y = cvt_pk_bf16(a[2], a[3]); w.z = cvt_pk_bf16(b[0], b[1]); w.w = cvt_pk_bf16(b[2], b[3]); return w; }

struct EpiQKV {
    static constexpr bool PERM = true, AFTER_DRAIN = false;
    bf16_t* QKV; const float* gains; const float* rs; const float* cs;
    __device__ __forceinline__ void operator()(const f32x4 (&acc)[2][2][4][2], const Unit& u, int wr, int wc, int fr, int fq) const {
        const int t = u.pn >> 2, head = (u.pn & 3) * 4 + wc;
        bf16_t* base = QKV + (size_t)t * ((size_t)32768 * 1024);
        const int row0 = u.pm * BM + wr * 64 + fr, col0 = head * 64 + 8 * fq;
        f32x4 gv[2][2], cv[2][2];
        const float* g = gains + 64 * t; const float* cp = cs + (size_t)u.pn * BM + wc * 32 + 8 * fq;
#pragma unroll
        for (int bj = 0; bj < 2; ++bj)
#pragma unroll
            for (int n = 0; n < 2; ++n) { gv[bj][n] = *(const f32x4*)(g + 32 * bj + 8 * fq + 4 * n); cv[bj][n] = *(const f32x4*)(cp + bj * HALF + 4 * n); }
#pragma unroll
        for (int ai = 0; ai < 2; ++ai)
#pragma unroll
            for (int m = 0; m < 4; ++m) { const int row = row0 + ai * HALF + m * 16; const float rsc = rs[row];
                f32x4 x[2][2]; float ss = 0.f;
#pragma unroll
                for (int bj = 0; bj < 2; ++bj)
#pragma unroll
                    for (int n = 0; n < 2; ++n) { x[bj][n] = acc[ai][bj][m][n] * cv[bj][n]; const f32x4 v = x[bj][n]; ss = __builtin_fmaf(v[0], v[0], __builtin_fmaf(v[1], v[1], __builtin_fmaf(v[2], v[2], __builtin_fmaf(v[3], v[3], ss)))); }
                ss += __shfl_xor(ss, 16); ss += __shfl_xor(ss, 32);
                const float r = rsc * (t < 2 ? __builtin_amdgcn_rsqf(ss * rsc * rsc * (1.0f / 64.0f) + 1e-6f) : 1.0f);
                bf16_t* rowp = base + (size_t)row * 1024 + col0;
#pragma unroll
                for (int bj = 0; bj < 2; ++bj) *(u32x4*)(rowp + 32 * bj) = pack8(x[bj][0] * (gv[bj][0] * r), x[bj][1] * (gv[bj][1] * r));
            }
    }
};
struct EpiSwiglu {
    static constexpr bool PERM = true, AFTER_DRAIN = false;
    bf16_t* O; int ldc; int ntl;
    __device__ __forceinline__ void operator()(const f32x4 (&acc)[2][2][4][2], const Unit& u, int wr, int wc, int fr, int fq) const {
        const int pnl = u.pn % ntl; const int row0 = u.pm * BM + wr * 64 + fr, col0 = pnl * 128 + wc * 32 + 8 * fq;
#pragma unroll
        for (int ai = 0; ai < 2; ++ai)
#pragma unroll
            for (int m = 0; m < 4; ++m) { bf16_t* rowp = O + (size_t)(row0 + ai * HALF + m * 16) * ldc + col0;
                f32x4 o0, o1;
#pragma unroll
                for (int j = 0; j < 4; ++j) { o0[j] = silu_f(acc[ai][0][m][0][j]) * acc[ai][1][m][0][j]; o1[j] = silu_f(acc[ai][0][m][1][j]) * acc[ai][1][m][1][j]; }
                *(u32x4*)rowp = pack8(o0, o1); }
    }
};
template <bool OUT8 = false> struct EpiSwigluQ {
    static constexpr bool PERM = true, AFTER_DRAIN = false;
    bf16_t* O; int ldc; int ntl; const float* rs; const float* cs;
    __device__ __forceinline__ void operator()(const f32x4 (&acc)[2][2][4][2], const Unit& u, int wr, int wc, int fr, int fq) const {
        const int pnl = u.pn % ntl; const int row0 = u.pm * BM + wr * 64 + fr, col0 = pnl * 128 + wc * 32 + 8 * fq;
        const float* cp = cs + (size_t)u.pn * BM + wc * 32 + 8 * fq;
        const float osc = OUT8 ? 8.0f : 1.0f;
        const f32x4 ca0 = *(const f32x4*)(cp), ca1 = *(const f32x4*)(cp + 4), cg0 = *(const f32x4*)(cp + HALF) * osc, cg1 = *(const f32x4*)(cp + HALF + 4) * osc;
#pragma unroll
        for (int ai = 0; ai < 2; ++ai)
#pragma unroll
            for (int m = 0; m < 4; ++m) { const int row = row0 + ai * HALF + m * 16; const float r = rs[row], rl = r * -1.4426950408889634f, r2 = r * r;
                f32x4 o0, o1;
#pragma unroll
                for (int n = 0; n < 2; ++n) { const f32x4 ca = n ? ca1 : ca0, cg = n ? cg1 : cg0;
#pragma unroll
                    for (int jp = 0; jp < 2; ++jp) { const f32x2 A = (f32x2){acc[ai][0][m][n][2 * jp], acc[ai][0][m][n][2 * jp + 1]} * (f32x2){ca[2 * jp], ca[2 * jp + 1]};
                        const f32x2 Gv = (f32x2){acc[ai][1][m][n][2 * jp], acc[ai][1][m][n][2 * jp + 1]} * (f32x2){cg[2 * jp], cg[2 * jp + 1]};
                        const f32x2 tt = A * rl; f32x2 ev; ev.x = ex2(tt.x); ev.y = ex2(tt.y);
                        const f32x2 dv = ev + 1.0f; f32x2 qv; qv.x = rcp(dv.x); qv.y = rcp(dv.y);
                        const f32x2 ov = (A * Gv) * (qv * r2);
                        if (n == 0) { o0[2 * jp] = ov.x; o0[2 * jp + 1] = ov.y; } else { o1[2 * jp] = ov.x; o1[2 * jp + 1] = ov.y; } } }
                if constexpr (OUT8) {
#pragma unroll
                    for (int j = 0; j < 4; ++j) { o0[j] = __builtin_amdgcn_fmed3f(o0[j], -440.0f, 440.0f); o1[j] = __builtin_amdgcn_fmed3f(o1[j], -440.0f, 440.0f); }
                    int w0 = 0, w1 = 0; w0 = __builtin_amdgcn_cvt_pk_fp8_f32(o0[0], o0[1], w0, false); w0 = __builtin_amdgcn_cvt_pk_fp8_f32(o0[2], o0[3], w0, true);
                    w1 = __builtin_amdgcn_cvt_pk_fp8_f32(o1[0], o1[1], w1, false); w1 = __builtin_amdgcn_cvt_pk_fp8_f32(o1[2], o1[3], w1, true);
                    typedef int i32x2v __attribute__((ext_vector_type(2)));
                    *(i32x2v*)((unsigned char*)O + (size_t)row * ldc + col0) = (i32x2v){w0, w1};
                } else { bf16_t* rowp = O + (size_t)row * ldc + col0; *(u32x4*)rowp = pack8(o0, o1); } }
    }
};
typedef EpiSwigluQ<false> EpiSwigluF8;
struct EpiGeluSG {
    static constexpr bool PERM = true, AFTER_DRAIN = false;
    bf16_t* U; bf16_t* V; float* vpart; const float* rs; const float* cs;
    __device__ __forceinline__ void operator()(const f32x4 (&acc)[2][2][4][2], const Unit& u, int wr, int wc, int fr, int fq) const {
        const bool isv = u.pn >= 12; const int pnl = isv ? u.pn - 12 : u.pn; bf16_t* base = isv ? V : U;
        const int row0 = u.pm * BM + wr * 64 + fr, col0 = pnl * BM + wc * 32 + 8 * fq;
        const float* cp = cs + (size_t)u.pn * BM + wc * 32 + 8 * fq;
        f32x4 cv[2][2];
#pragma unroll
        for (int bj = 0; bj < 2; ++bj)
#pragma unroll
            for (int n = 0; n < 2; ++n) cv[bj][n] = *(const f32x4*)(cp + bj * HALF + 4 * n);
#pragma unroll
        for (int ai = 0; ai < 2; ++ai)
#pragma unroll
            for (int m = 0; m < 4; ++m) { const int row = row0 + ai * HALF + m * 16; const float rsc = rs[row]; bf16_t* rowp = base + (size_t)row * 3072 + col0; float ss = 0.f; f32x2 ss2 = (f32x2){0.f, 0.f};
#pragma unroll
                for (int bj = 0; bj < 2; ++bj) { f32x4 z0, z1; const f32x4 s0 = cv[bj][0] * rsc, s1 = cv[bj][1] * rsc;
#pragma unroll
                    for (int n = 0; n < 2; ++n) { const f32x4 sv = n ? s1 : s0;
#pragma unroll
                        for (int jp = 0; jp < 2; ++jp) {
                            const f32x2 x = (f32x2){acc[ai][bj][m][n][2 * jp], acc[ai][bj][m][n][2 * jp + 1]} * (f32x2){sv[2 * jp], sv[2 * jp + 1]};
                            const f32x2 w = (x * x) * (0.044715f * -2.3022081981405e+00f) + (-2.3022081981405e+00f), tt = x * w;
                            f32x2 ev; ev.x = ex2(tt.x); ev.y = ex2(tt.y); const f32x2 dv = ev + 1.0f; f32x2 qv; qv.x = rcp(dv.x); qv.y = rcp(dv.y);
                            const f32x2 z = x * qv; ss2 = z * z + ss2;
                            if (n == 0) { z0[2 * jp] = z.x; z0[2 * jp + 1] = z.y; } else { z1[2 * jp] = z.x; z1[2 * jp + 1] = z.y; } } }
                    *(u32x4*)(rowp + bj * HALF) = pack8(z0, z1); }
                ss = ss2.x + ss2.y;
                if (isv) { ss += __shfl_xor(ss, 16); ss += __shfl_xor(ss, 32); if (fq == 0) vpart[(size_t)row * 48 + pnl * 4 + wc] = ss; } }
    }
};
struct EpiResid {
    static constexpr bool PERM = false, AFTER_DRAIN = false;
    const float* xin; float* out; const float* gate; const float* cs;
    __device__ __forceinline__ void operator()(const f32x4 (&acc)[2][2][4][2], const Unit& u, int wr, int wc, int fr, int fq) const {
        const float* gp = gate + (size_t)(u.pm >> 3) * 6144;
        const int row0 = u.pm * BM + wr * 64 + fr, col0 = u.pn * BM + wc * 32 + 4 * fq;
        f32x4 gv[2][2];
#pragma unroll
        for (int bj = 0; bj < 2; ++bj)
#pragma unroll
            for (int n = 0; n < 2; ++n) gv[bj][n] = *(const f32x4*)(gp + col0 + bj * HALF + n * 16) * *(const f32x4*)(cs + col0 + bj * HALF + n * 16);
#pragma unroll
        for (int ai = 0; ai < 2; ++ai)
#pragma unroll
            for (int m = 0; m < 4; ++m) { const size_t off = (size_t)(row0 + ai * HALF + m * 16) * 1024 + col0;
#pragma unroll
                for (int bj = 0; bj < 2; ++bj)
#pragma unroll
                    for (int n = 0; n < 2; ++n) { const f32x4 xv = *(const f32x4*)(xin + off + bj * HALF + n * 16); *(f32x4*)(out + off + bj * HALF + n * 16) = xv + gv[bj][n] * acc[ai][bj][m][n]; } }
    }
};
template <bool XIN32> struct EpiResid16 {
    static constexpr bool PERM = true, AFTER_DRAIN = false;
    const void* xin; bf16_t* out; const float* gate; const float* cs;
    __device__ __forceinline__ void operator()(const f32x4 (&acc)[2][2][4][2], const Unit& u, int wr, int wc, int fr, int fq) const {
        const float* gp = gate + (size_t)(u.pm >> 3) * 6144;
        const int row0 = u.pm * BM + wr * 64 + fr, col0 = u.pn * BM + wc * 32 + 8 * fq;
        f32x4 gv[2][2];
#pragma unroll
        for (int bj = 0; bj < 2; ++bj)
#pragma unroll
            for (int n = 0; n < 2; ++n) gv[bj][n] = *(const f32x4*)(gp + col0 + bj * HALF + 4 * n) * *(const f32x4*)(cs + col0 + bj * HALF + 4 * n);
#pragma unroll
        for (int ai = 0; ai < 2; ++ai)
#pragma unroll
            for (int m = 0; m < 4; ++m) { const size_t off = (size_t)(row0 + ai * HALF + m * 16) * 1024 + col0;
#pragma unroll
                for (int bj = 0; bj < 2; ++bj) { f32x4 x0, x1;
                    if constexpr (XIN32) { x0 = *(const f32x4*)((const float*)xin + off + bj * HALF); x1 = *(const f32x4*)((const float*)xin + off + bj * HALF + 4); }
                    else { const u32x4 w = *(const u32x4*)((const bf16_t*)xin + off + bj * HALF);
                        x0 = (f32x4){__uint_as_float(w.x << 16), __uint_as_float(w.x & 0xffff0000u), __uint_as_float(w.y << 16), __uint_as_float(w.y & 0xffff0000u)};
                        x1 = (f32x4){__uint_as_float(w.z << 16), __uint_as_float(w.z & 0xffff0000u), __uint_as_float(w.w << 16), __uint_as_float(w.w & 0xffff0000u)}; }
                    *(u32x4*)(out + off + bj * HALF) = pack8(x0 + gv[bj][0] * acc[ai][bj][m][0], x1 + gv[bj][1] * acc[ai][bj][m][1]); } }
    }
};
struct EpiMoeOut {
    static constexpr bool PERM = true, AFTER_DRAIN = false;
    bf16_t* Y; const int* rowinfo; int mtok; const float* cs;
    __device__ __forceinline__ void operator()(const f32x4 (&acc)[2][2][4][2], const Unit& u, int wr, int wc, int fr, int fq) const {
        const int row0 = u.pm * BM + wr * 64 + fr, col0 = (u.pn & 3) * BM + wc * 32 + 8 * fq;
        const float* cp = cs + (size_t)u.pn * BM + wc * 32 + 8 * fq;
#pragma unroll
        for (int ai = 0; ai < 2; ++ai)
#pragma unroll
            for (int m = 0; m < 4; ++m) { const int ti = rowinfo[row0 + ai * HALF + m * 16];
                if (ti >= 0) { bf16_t* rowp = Y + ((size_t)(ti & 1) * mtok + (ti >> 1)) * 1024 + col0;
#pragma unroll
                    for (int bj = 0; bj < 2; ++bj) { const f32x4 c0 = *(const f32x4*)(cp + bj * HALF), c1 = *(const f32x4*)(cp + bj * HALF + 4);
                        *(u32x4*)(rowp + bj * HALF) = pack8(acc[ai][bj][m][0] * c0, acc[ai][bj][m][1] * c1); } } }
    }
};
struct MoeOrder {
    static constexpr bool SPLITK = false;
    const PG8_LAS int* pre; int ntl, G, c;
    __device__ __forceinline__ bool next(int i, Unit& u) const {
        StaticOrder so; so.init(__builtin_amdgcn_readfirstlane(pre[8]) * BM, ntl * BM, G, c);
        if (!so.next(i, u)) return false;
        int e = 0;
#pragma unroll
        for (int k = 1; k < 8; ++k) e += (u.pm >= pre[k]) ? 1 : 0;
        u.pn += e * ntl; return true;
    }
    __device__ __forceinline__ void a_ready(const Unit&) const {}
    __device__ __forceinline__ void done(const Unit&) const {}
};
struct MoeOrderLim {
    static constexpr bool SPLITK = false;
    const PG8_LAS int* pre; int ntl, G, c, lim;
    __device__ __forceinline__ bool next(int i, Unit& u) const {
        if (i * G + c >= lim) return false;
        StaticOrder so; so.init(__builtin_amdgcn_readfirstlane(pre[8]) * BM, ntl * BM, G, c);
        if (!so.next(i, u)) return false;
        int e = 0;
#pragma unroll
        for (int k = 1; k < 8; ++k) e += (u.pm >= pre[k]) ? 1 : 0;
        u.pn += e * ntl; return true;
    }
    __device__ __forceinline__ void a_ready(const Unit&) const {}
    __device__ __forceinline__ void done(const Unit&) const {}
};
struct SplitOrder {
    static constexpr bool SPLITK = true;
    const PG8_LAS int* pre; int ntl, c, first, T, S, kbytes;
    __device__ __forceinline__ bool next(int i, Unit& u) const {
        if (i != 0 || c >= T * S) return false;
        const int j = c % T, s = c / T;
        StaticOrder so; so.init(__builtin_amdgcn_readfirstlane(pre[8]) * BM, ntl * BM, 1, first + j);
        if (!so.next(0, u)) return false;
        int e = 0;
#pragma unroll
        for (int k = 1; k < 8; ++k) e += (u.pm >= pre[k]) ? 1 : 0;
        u.pn += e * ntl; u.ko = s * kbytes; u.aux = j | (s << 16); return true;
    }
    __device__ __forceinline__ void a_ready(const Unit&) const {}
    __device__ __forceinline__ void done(const Unit&) const {}
};
struct EpiMoeSplit {
    static constexpr bool PERM = true, AFTER_DRAIN = false;
    EpiMoeOut inner; float* slab; unsigned* cnt; int S;
    __device__ __forceinline__ void operator()(const f32x4 (&acc)[2][2][4][2], const Unit& u, int wr, int wc, int fr, int fq) const {
        const int j = u.aux & 0xffff, s = u.aux >> 16, w = wr * 4 + wc, lane = fr + 16 * fq;
        const __amdgpu_buffer_rsrc_t rs = __builtin_amdgcn_make_buffer_rsrc((void*)slab, (short)0, 0x04000000, 0x00020000);
        const int mybase = (((j * S + s) * 8 + w) * 2048 + lane) * 16;
#pragma unroll
        for (int ai = 0; ai < 2; ++ai)
#pragma unroll
            for (int bj = 0; bj < 2; ++bj)
#pragma unroll
                for (int m = 0; m < 4; ++m)
#pragma unroll
                    for (int n = 0; n < 2; ++n) __builtin_amdgcn_raw_buffer_store_b128(__builtin_bit_cast(u32x4, acc[ai][bj][m][n]), rs, mybase + ((((ai * 2 + bj) * 4 + m) * 2 + n) * 1024), 0, 16);
        asm volatile("s_waitcnt vmcnt(0)" ::: "memory");
        unsigned old = 0;
        if (lane == 0) old = __hip_atomic_fetch_add(cnt + (j * 8 + w) * 4, 1u, __ATOMIC_RELAXED, __HIP_MEMORY_SCOPE_AGENT);
        old = (unsigned)__builtin_amdgcn_readfirstlane((int)old);
        if (old != (unsigned)(S - 1)) return;
        __builtin_amdgcn_fence(__ATOMIC_ACQUIRE, "agent"); asm volatile("s_waitcnt vmcnt(0)" ::: "memory");
        f32x4 tot[2][2][4][2];
#pragma unroll
        for (int ai = 0; ai < 2; ++ai)
#pragma unroll
            for (int bj = 0; bj < 2; ++bj)
#pragma unroll
                for (int m = 0; m < 4; ++m)
#pragma unroll
                    for (int n = 0; n < 2; ++n) tot[ai][bj][m][n] = (f32x4){0.f, 0.f, 0.f, 0.f};
        for (int s2 = 0; s2 < S; ++s2) { const float* p = slab + (size_t)(((j * S + s2) * 8 + w) * 2048 + lane) * 4;
#pragma unroll
            for (int ai = 0; ai < 2; ++ai)
#pragma unroll
                for (int bj = 0; bj < 2; ++bj)
#pragma unroll
                    for (int m = 0; m < 4; ++m)
#pragma unroll
                        for (int n = 0; n < 2; ++n) tot[ai][bj][m][n] += *(const f32x4*)(p + ((((ai * 2 + bj) * 4 + m) * 2 + n) * 256)); }
        int t2 = threadIdx.x; asm volatile("" : "+v"(t2));
        inner(tot, u, wr, wc, t2 & 15, (t2 & 63) >> 4);
    }
};
__device__ __forceinline__ void moe_order_setup(PG8_LAS int* pre, const unsigned* cnt) {
    if (threadIdx.x == 0) { int p = 0; pre[0] = 0;
#pragma unroll
        for (int e = 0; e < 8; ++e) { p += (int)((cnt[64 * e] + 255u) >> 8); pre[e + 1] = p; } }
    __syncthreads();
}
}
#define GAS __attribute__((address_space(1)))
#define LAS __attribute__((address_space(3)))
typedef unsigned short bf16;
typedef unsigned v4u __attribute__((ext_vector_type(4)));
typedef float f32x4 __attribute__((ext_vector_type(4)));
typedef short bf16x8 __attribute__((ext_vector_type(8)));
typedef GAS unsigned gu32;
typedef GAS unsigned long long gu64;
#define RLX_AGENT __ATOMIC_RELAXED, __HIP_MEMORY_SCOPE_AGENT
#define LDS_WAIT() asm volatile("s_waitcnt lgkmcnt(0)" ::: "memory")
#define VM_WAIT() asm volatile("s_waitcnt vmcnt(0)" ::: "memory")
__device__ __forceinline__ unsigned long long rt() { return __builtin_amdgcn_s_memrealtime(); }
__device__ __forceinline__ unsigned f2bf(float f) { unsigned u = __builtin_bit_cast(unsigned, f); return (u + 0x7fffu + ((u >> 16) & 1u)) >> 16; }
__device__ __forceinline__ unsigned pk2(float lo, float hi) { return f2bf(lo) | (f2bf(hi) << 16); }
#define XB_TMO      128
#define XB_XCNT(j)  (256  + 64 * (j))
#define XB_XSUB(j)  (1280 + 64 * (j))
#define XB_XGEN(j)  (2304 + 64 * (j))
#define XB_TOP      3328
#define XB_TOPGEN   3392
#define XCD_BAR_WORDS 3456
#define XB_SPIN_CAP (1u << 22)

__device__ __forceinline__ unsigned xb_ld(unsigned* p)              { return __hip_atomic_load(p, __ATOMIC_RELAXED, __HIP_MEMORY_SCOPE_AGENT); }
__device__ __forceinline__ unsigned xb_add(unsigned* p, unsigned v) { return __hip_atomic_fetch_add(p, v, __ATOMIC_RELAXED, __HIP_MEMORY_SCOPE_AGENT); }
__device__ __forceinline__ unsigned xb_xcc_id() { return (unsigned)__builtin_amdgcn_s_getreg((3 << 11) | 20) & 0xFu; }
#define XB_SPIN(cond, bar) do { unsigned _sp = 0; while (cond) { __builtin_amdgcn_s_sleep(1); \
    if ((++_sp & 255u) == 0u) { if (xb_ld(&(bar)[XB_TMO])) break; if (_sp > XB_SPIN_CAP) { atomicAdd(&(bar)[XB_TMO], 1u); break; } } } } while (0)

struct XcdBarrier {
    unsigned* bar; unsigned x;
    volatile LAS unsigned* st;
};

__device__ __forceinline__ XcdBarrier xcd_barrier_post(unsigned* bar, volatile LAS unsigned* st) {
    XcdBarrier b; b.bar = bar; b.x = xb_xcc_id(); b.st = st;
    if (threadIdx.x == 0) (void)xb_add(&bar[XB_XCNT(b.x)], 1u);
    return b;
}
__device__ __forceinline__ void xcd_barrier_complete(unsigned* bar, unsigned x, unsigned& nloc, unsigned& nx) {
    const unsigned G = gridDim.x * gridDim.y * gridDim.z;
    unsigned sum, cnt, mine, sp = 0u;
    for (;;) {
        sum = 0u; cnt = 0u; mine = 0u;
#pragma unroll
        for (unsigned j = 0; j < 16; ++j) { const unsigned c = xb_ld(&bar[XB_XCNT(j)]); sum += c; cnt += (c > 0u) ? 1u : 0u; mine = (j == x) ? c : mine; }
        if (sum == G) break;
        __builtin_amdgcn_s_sleep(1);
        if ((++sp & 255u) == 0u) { if (xb_ld(&bar[XB_TMO])) break; if (sp > XB_SPIN_CAP) { atomicAdd(&bar[XB_TMO], 1u); break; } }
    }
    nloc = mine > 0u ? mine : 1u; nx = cnt > 0u ? cnt : 1u;
}

__device__ __forceinline__ void xcd_barrier(const XcdBarrier& b) {
    asm volatile("s_waitcnt vmcnt(0)" ::: "memory");
    __syncthreads();
    if (threadIdx.x == 0) {
        unsigned* bar = b.bar;
        __builtin_amdgcn_s_waitcnt(0);
        unsigned nloc = b.st[0], nx = b.st[1];
        if (nloc == 0u) { xcd_barrier_complete(bar, b.x, nloc, nx); b.st[0] = nloc; b.st[1] = nx; }
        const unsigned old = xb_add(&bar[XB_XSUB(b.x)], 1u);
        const unsigned gen = old / nloc;
        if (old + 1u == (gen + 1u) * nloc) {
            __builtin_amdgcn_fence(__ATOMIC_RELEASE, "agent");
            asm volatile("s_waitcnt vmcnt(0)" ::: "memory");
            const unsigned og = xb_add(&bar[XB_TOP], 1u);
            const unsigned tg = og / nx;
            if (og + 1u == (tg + 1u) * nx) xb_add(&bar[XB_TOPGEN], 1u);
            else XB_SPIN(xb_ld(&bar[XB_TOPGEN]) == tg, bar);
            __builtin_amdgcn_fence(__ATOMIC_ACQUIRE, "agent");
            xb_add(&bar[XB_XGEN(b.x)], 1u);
            asm volatile("s_waitcnt vmcnt(0)" ::: "memory");
        } else {
            XB_SPIN(xb_ld(&bar[XB_XGEN(b.x)]) == gen, bar);
            __builtin_amdgcn_fence(__ATOMIC_ACQUIRE, "agent");
            asm volatile("s_waitcnt vmcnt(0)" ::: "memory");
        }
    }
    __syncthreads();
}

constexpr int D = 1024, NB = 16, SEQ = 2048, MTOK = NB * SEQ, NHEAD = 16, HD = 64;
constexpr int SGH = 3072, DFF = 2816, NEXP = 8, DFE = 3584;
constexpr int MODL = NB * 6 * D;
constexpr float EPSN = 1e-6f, LOG2E = 1.4426950408889634f;
constexpr int NWAVES = 8;
constexpr int ASROWS = 2 * MTOK + NEXP * 256;

constexpr size_t MiB = 1u << 20;
constexpr size_t WS_CTL = 0, CTL_ZERO_BYTES = 128 * 1024;
constexpr size_t WS_MOD = 2 * MiB, WS_GAINS = 3 * MiB + 512 * 1024;
constexpr size_t WS_WQKV0 = 4 * MiB, WS_WQKV1 = 10 * MiB, WS_WQKVC = 16 * MiB, WS_WO0 = 22 * MiB, WS_WO1 = 24 * MiB, WS_WOC = 26 * MiB;
constexpr size_t WS_WIN = 28 * MiB, WS_WOUT = 40 * MiB, WS_W13_0 = 46 * MiB, WS_W13_1 = 57 * MiB, WS_W2_0 = 68 * MiB, WS_W2_1 = 68 * MiB + 5632 * 1024;
constexpr size_t WS_MOE13 = 80 * MiB, WS_MOE2 = 192 * MiB;
constexpr size_t WS_H = 248 * MiB;
constexpr size_t WS_AS = 312 * MiB;
constexpr size_t WS_ACT = 444 * MiB;
constexpr size_t WS_ROWINFO = 906 * MiB, WS_TROUTE = 907 * MiB, WS_TW = 908 * MiB, WS_VPART = 909 * MiB;
constexpr size_t WS_CS = 915 * MiB, WS_HSC = 915 * MiB + 512 * 1024, WS_RS = 916 * MiB, WS_XB = 917 * MiB, WS_MOE2B = 981 * MiB, WS_H2 = 1009 * MiB, WS_END = 1041 * MiB;
static_assert(WS_W2_1 + (size_t)1024 * 2816 * 2 <= WS_MOE13 && WS_ACT + (size_t)ASROWS * DFE * 2 <= WS_ROWINFO && WS_AS + (size_t)ASROWS * 1024 * 2 <= WS_ACT, "ws map");
constexpr int CW_BAR = 4096, CW_CNT = 8192, CW_CONV = 9280, CW_SPLIT = 12288, CW_PAN = 20480;

constexpr int LDS_BYTES = 147456, XTRA_OFF = 131072, MISC_OFF = LDS_BYTES - 256;

typedef float f32x16 __attribute__((ext_vector_type(16)));
typedef short s16x4 __attribute__((ext_vector_type(4)));
typedef unsigned u32x2 __attribute__((ext_vector_type(2)));

__device__ __forceinline__ float wave_sum(float v) {
#pragma unroll
    for (int o = 1; o < 64; o <<= 1) v += __shfl_xor(v, o);
    return v;
}
__device__ __forceinline__ float bf_lo(unsigned u) { return __uint_as_float(u << 16); }
__device__ __forceinline__ float bf_hi(unsigned u) { return __uint_as_float(u & 0xffff0000u); }
__device__ __forceinline__ int crow(int r, int hi) { return (r & 3) + 8 * (r >> 2) + 4 * hi; }

__device__ __forceinline__ int map_qkv(int n) { const int L = n & 255; return (n & ~255) | (((L >> 5) & 1) << 7) | ((L >> 6) << 5) | (L & 31); }
__device__ __forceinline__ int map_glu(int n, int half) { const int a = n < half ? n : n - half; return ((a >> 7) << 8) + (n < half ? 0 : 128) + (a & 127); }
template <int MAP> __device__ __forceinline__ void conv_item(int r, const float* __restrict__ W, int K, int N, bf16* dst, int lane) {
    const int nblk = N / 64, kb = r / nblk, nb = r - kb * nblk, n4 = lane & 15, kq = lane >> 4;
    const int ncol = 64 * nb + 4 * n4;
    int drow;
    if (MAP == 0) drow = ncol; else if (MAP == 1) drow = map_qkv(ncol); else if (MAP == 2) drow = map_glu(ncol, N / 2);
    else if (MAP == 3) drow = ((ncol >> 7) << 8) + (ncol & 127); else drow = ((ncol >> 7) << 8) + 128 + (ncol & 127);
    f32x4 f[2][8];
#pragma unroll
    for (int h = 0; h < 2; ++h)
#pragma unroll
        for (int i = 0; i < 8; ++i) f[h][i] = *(const f32x4*)(W + (size_t)(64 * kb + 32 * h + 8 * kq + i) * N + ncol);
#pragma unroll
    for (int h = 0; h < 2; ++h)
#pragma unroll
        for (int j = 0; j < 4; ++j) { v4u o; o.x = pg8::cvt_pk_bf16(f[h][0][j], f[h][1][j]); o.y = pg8::cvt_pk_bf16(f[h][2][j], f[h][3][j]); o.z = pg8::cvt_pk_bf16(f[h][4][j], f[h][5][j]); o.w = pg8::cvt_pk_bf16(f[h][6][j], f[h][7][j]);
            *(GAS v4u*)(dst + (size_t)(drow + j) * K + 64 * kb + 32 * h + 8 * kq) = o; }
}
__device__ __forceinline__ unsigned q4i8(float a, float b, float c, float d) {
    const int ia = (int)__builtin_rintf(a), ib = (int)__builtin_rintf(b), ic = (int)__builtin_rintf(c), id = (int)__builtin_rintf(d);
    return (unsigned)(ia & 255) | ((unsigned)(ib & 255) << 8) | ((unsigned)(ic & 255) << 16) | ((unsigned)id << 24);
}
template <int MAP> __device__ __forceinline__ void conv8_item(int nb, const float* __restrict__ W, int N, unsigned char* dst, float* cscale, int lane) {
    const int n4 = lane & 7, kq = lane >> 3, ncol = 32 * nb + 4 * n4;
    const int drow = MAP == 0 ? ncol : MAP == 1 ? map_qkv(ncol) : MAP == 2 ? map_glu(ncol, N / 2) : ((ncol >> 7) << 8) + (MAP == 4 ? 128 : 0) + (ncol & 127);
    f32x4 mx = (f32x4){0.f, 0.f, 0.f, 0.f};
#pragma unroll 8
    for (int i = 0; i < 128; ++i) { const f32x4 v = *(const f32x4*)(W + (size_t)(8 * i + kq) * N + ncol);
#pragma unroll
        for (int j = 0; j < 4; ++j) mx[j] = fmaxf(mx[j], fabsf(v[j])); }
    float qs[4];
#pragma unroll
    for (int j = 0; j < 4; ++j) { float a = mx[j]; a = fmaxf(a, __shfl_xor(a, 8)); a = fmaxf(a, __shfl_xor(a, 16)); a = fmaxf(a, __shfl_xor(a, 32));
        qs[j] = a > 0.f ? 127.0f / a : 1.0f; if (kq == 0) cscale[drow + j] = a > 0.f ? a * (1.0f / 127.0f) : 1.0f; }
    for (int kb = 0; kb < 8; ++kb) {
        f32x4 f[16];
#pragma unroll
        for (int i = 0; i < 16; ++i) f[i] = *(const f32x4*)(W + (size_t)(128 * kb + 16 * kq + i) * N + ncol);
#pragma unroll
        for (int j = 0; j < 4; ++j) { v4u o;
#pragma unroll
            for (int q = 0; q < 4; ++q) o[q] = q4i8(f[4 * q][j] * qs[j], f[4 * q + 1][j] * qs[j], f[4 * q + 2][j] * qs[j], f[4 * q + 3][j] * qs[j]);
            *(GAS v4u*)(dst + (size_t)(drow + j) * D + 128 * kb + 16 * kq) = o; }
    }
}
template <int KD> __device__ __forceinline__ void convf8_item(int nb, const float* __restrict__ W, int N, unsigned char* dst, float* cscale, int lane) {
    const int n4 = lane & 7, kq = lane >> 3, ncol = 32 * nb + 4 * n4;
    f32x4 mx = (f32x4){0.f, 0.f, 0.f, 0.f};
#pragma unroll 8
    for (int i = 0; i < KD / 8; ++i) { const f32x4 v = *(const f32x4*)(W + (size_t)(8 * i + kq) * N + ncol);
#pragma unroll
        for (int j = 0; j < 4; ++j) mx[j] = fmaxf(mx[j], fabsf(v[j])); }
    float qs[4];
#pragma unroll
    for (int j = 0; j < 4; ++j) { float a = mx[j]; a = fmaxf(a, __shfl_xor(a, 8)); a = fmaxf(a, __shfl_xor(a, 16)); a = fmaxf(a, __shfl_xor(a, 32));
        qs[j] = a > 0.f ? 440.0f / a : 1.0f; if (kq == 0) cscale[ncol + j] = (a > 0.f ? a * (1.0f / 440.0f) : 1.0f) * 0.125f; }
    for (int kb = 0; kb < KD / 128; ++kb) {
        f32x4 f[16];
#pragma unroll
        for (int i = 0; i < 16; ++i) f[i] = *(const f32x4*)(W + (size_t)(128 * kb + 16 * kq + i) * N + ncol);
#pragma unroll
        for (int j = 0; j < 4; ++j) { v4u o;
#pragma unroll
            for (int q = 0; q < 4; ++q) { int w = 0; w = __builtin_amdgcn_cvt_pk_fp8_f32(f[4 * q][j] * qs[j], f[4 * q + 1][j] * qs[j], w, false); w = __builtin_amdgcn_cvt_pk_fp8_f32(f[4 * q + 2][j] * qs[j], f[4 * q + 3][j] * qs[j], w, true); o[q] = (unsigned)w; }
            *(GAS v4u*)(dst + (size_t)(ncol + j) * KD + 128 * kb + 16 * kq) = o; }
    }
}
__device__ __forceinline__ void conv8_wg_item(int MAP, int nb, const float* __restrict__ W, int N, unsigned char* dst, float* cscale, LAS float* amx, int par, int wave, int lane) {
    const int n4 = lane & 7, kq = lane >> 3, ncol = 32 * nb + 4 * n4;
    const int drow = MAP == 0 ? ncol : MAP == 1 ? map_qkv(ncol) : MAP == 2 ? map_glu(ncol, N / 2) : ((ncol >> 7) << 8) + (MAP == 4 ? 128 : 0) + (ncol & 127);
    f32x4 f[16]; f32x4 mx = (f32x4){0.f, 0.f, 0.f, 0.f};
#pragma unroll
    for (int i = 0; i < 16; ++i) { f[i] = *(const f32x4*)(W + (size_t)(128 * wave + 16 * kq + i) * N + ncol);
#pragma unroll
        for (int j = 0; j < 4; ++j) mx[j] = fmaxf(mx[j], fabsf(f[i][j])); }
#pragma unroll
    for (int j = 0; j < 4; ++j) { float a = mx[j]; a = fmaxf(a, __shfl_xor(a, 8)); a = fmaxf(a, __shfl_xor(a, 16)); a = fmaxf(a, __shfl_xor(a, 32)); mx[j] = a; }
    LAS float* ap = amx + par * 256;
    if (kq == 0) *(LAS f32x4*)(ap + wave * 32 + 4 * n4) = mx;
    LDS_WAIT(); __syncthreads();
    f32x4 am = *(const LAS f32x4*)(ap + 4 * n4);
#pragma unroll
    for (int w = 1; w < 8; ++w) { const f32x4 o = *(const LAS f32x4*)(ap + w * 32 + 4 * n4);
#pragma unroll
        for (int j = 0; j < 4; ++j) am[j] = fmaxf(am[j], o[j]); }
    float qs[4];
#pragma unroll
    for (int j = 0; j < 4; ++j) { qs[j] = am[j] > 0.f ? 127.0f / am[j] : 1.0f; if (wave == 0 && kq == 0) cscale[drow + j] = am[j] > 0.f ? am[j] * (1.0f / 127.0f) : 1.0f; }
#pragma unroll
    for (int j = 0; j < 4; ++j) { v4u o;
#pragma unroll
        for (int q = 0; q < 4; ++q) o[q] = q4i8(f[4 * q][j] * qs[j], f[4 * q + 1][j] * qs[j], f[4 * q + 2][j] * qs[j], f[4 * q + 3][j] * qs[j]);
        *(GAS v4u*)(dst + (size_t)(drow + j) * D + 128 * wave + 16 * kq) = o; }
}
template <int KD> __device__ __forceinline__ void convf8_wg_item(int nb, const float* __restrict__ W, int N, unsigned char* dst, float* cscale, LAS float* amx, int par, int wave, int lane) {
    constexpr int RW = KD / 8, NG = RW / 16;
    static_assert(RW % 16 == 0, "rows per wave");
    const int n4 = lane & 7, kq = lane >> 3, ncol = 32 * nb + 4 * n4;
    const float* wp = W + (size_t)(RW * wave) * N + ncol;
    f32x4 mx = (f32x4){0.f, 0.f, 0.f, 0.f};
    constexpr int PB = RW / 32;
    static_assert(RW % 32 == 0, "pass-1 batches");
    for (int b0 = 0; b0 < 4; ++b0) { f32x4 v[PB];
#pragma unroll
        for (int i = 0; i < PB; ++i) v[i] = *(const f32x4*)(wp + (size_t)(8 * (PB * b0 + i) + kq) * N);
#pragma unroll
        for (int i = 0; i < PB; ++i)
#pragma unroll
            for (int j = 0; j < 4; ++j) mx[j] = fmaxf(mx[j], fabsf(v[i][j])); }
#pragma unroll
    for (int j = 0; j < 4; ++j) { float a = mx[j]; a = fmaxf(a, __shfl_xor(a, 8)); a = fmaxf(a, __shfl_xor(a, 16)); a = fmaxf(a, __shfl_xor(a, 32)); mx[j] = a; }
    LAS float* ap = amx + par * 256;
    if (kq == 0) *(LAS f32x4*)(ap + wave * 32 + 4 * n4) = mx;
    LDS_WAIT(); __syncthreads();
    f32x4 am = *(const LAS f32x4*)(ap + 4 * n4);
#pragma unroll
    for (int w = 1; w < 8; ++w) { const f32x4 o = *(const LAS f32x4*)(ap + w * 32 + 4 * n4);
#pragma unroll
        for (int j = 0; j < 4; ++j) am[j] = fmaxf(am[j], o[j]); }
    float qs[4];
#pragma unroll
    for (int j = 0; j < 4; ++j) { qs[j] = am[j] > 0.f ? 440.0f / am[j] : 1.0f; if (wave == 0 && kq == 0) cscale[ncol + j] = (am[j] > 0.f ? am[j] * (1.0f / 440.0f) : 1.0f) * 0.125f; }
    for (int t = 0; t < (NG + 7) / 8; ++t) { const int g = 8 * t + kq;
        if (g < NG) { f32x4 f[16];
#pragma unroll
            for (int i = 0; i < 16; ++i) f[i] = *(const f32x4*)(wp + (size_t)(16 * g + i) * N);
#pragma unroll
            for (int j = 0; j < 4; ++j) { v4u o;
#pragma unroll
                for (int q = 0; q < 4; ++q) { int w = 0; w = __builtin_amdgcn_cvt_pk_fp8_f32(f[4 * q][j] * qs[j], f[4 * q + 1][j] * qs[j], w, false); w = __builtin_amdgcn_cvt_pk_fp8_f32(f[4 * q + 2][j] * qs[j], f[4 * q + 3][j] * qs[j], w, true); o[q] = (unsigned)w; }
                *(GAS v4u*)(dst + (size_t)(ncol + j) * KD + RW * wave + 16 * g) = o; } } }
}
constexpr int IT_MOE8 = DFE / 32, IT_MOE2 = D / 32;
constexpr int IT_MOE = NEXP * (2 * IT_MOE8 + IT_MOE2);
__device__ __forceinline__ void moe_conv_item(int r, const float* w1, const float* w3, const float* w2, unsigned char* W13, float* cscale, bf16* W2, float* cs2, int lane) {
    if (r < NEXP * IT_MOE8) { const int e = r / IT_MOE8; conv8_item<3>(r % IT_MOE8, w1 + (size_t)e * D * DFE, DFE, W13 + (size_t)e * 2 * DFE * D, cscale + e * 2 * DFE, lane); return; }
    r -= NEXP * IT_MOE8;
    if (r < NEXP * IT_MOE8) { const int e = r / IT_MOE8; conv8_item<4>(r % IT_MOE8, w3 + (size_t)e * D * DFE, DFE, W13 + (size_t)e * 2 * DFE * D, cscale + e * 2 * DFE, lane); return; }
    r -= NEXP * IT_MOE8;
    { const int e = r / IT_MOE2; convf8_item<DFE>(r % IT_MOE2, w2 + (size_t)e * DFE * D, D, (unsigned char*)W2 + (size_t)e * D * DFE, cs2 + e * D, lane); }
}
__device__ __forceinline__ void mod_item(int it, const float* __restrict__ ada_w, const float* __restrict__ ada_b, float* mod, const LAS float* cond, int lane) {
    const int i = it / 384, n0 = 16 * (it % 384), n4 = lane & 3, ksub = lane >> 2;
    f32x4 acc[16];
#pragma unroll
    for (int b = 0; b < 16; ++b) acc[b] = (f32x4){0.f, 0.f, 0.f, 0.f};
    const float* wp = ada_w + (size_t)i * D * 6 * D + n0 + 4 * n4;
#pragma unroll 8
    for (int kk = 0; kk < 64; ++kk) { const int k = 16 * kk + ksub;
        const f32x4 w = *(const f32x4*)(wp + (size_t)k * 6 * D);
        const LAS f32x4* cp = (const LAS f32x4*)(cond + k * 16);
#pragma unroll
        for (int q = 0; q < 4; ++q) { const f32x4 c = cp[q];
#pragma unroll
            for (int e = 0; e < 4; ++e) acc[4 * q + e] += w * c[e]; } }
#pragma unroll
    for (int b = 0; b < 16; ++b)
#pragma unroll
        for (int e = 0; e < 4; ++e) { float v = acc[b][e]; v += __shfl_xor(v, 4); v += __shfl_xor(v, 8); v += __shfl_xor(v, 16); v += __shfl_xor(v, 32); acc[b][e] = v; }
    if (ksub == 0) { const f32x4 bv = *(const f32x4*)(ada_b + (size_t)i * 6 * D + n0 + 4 * n4);
#pragma unroll
        for (int b = 0; b < 16; ++b) *(f32x4*)(mod + (size_t)i * MODL + (size_t)b * 6 * D + n0 + 4 * n4) = acc[b] + bv; }
}

template <bool COMBINE, bool NORM, bool ROUTE, bool F8OUT = ROUTE, bool XIN16 = true, bool XOUT16 = true>
__device__ __forceinline__ void norm_phase(const void* xin, void* xout, bf16* H, const float* ng, const float* modl, int sh_off,
                                           const float* g2prev, const bf16* Y, const float* twin,
                                           const float* wr, const float* br, unsigned* cnt, int* troute, float* twout, float* hsc,
                                           LAS unsigned char* L, int vcu, int G, int wave, int lane, int tid) {
    LAS float* wrL = (LAS float*)L;
    if (ROUTE) { float wv[D * NEXP / (NWAVES * 64)];
#pragma unroll
        for (int i = 0; i < D * NEXP / (NWAVES * 64); ++i) wv[i] = wr[tid + NWAVES * 64 * i];
#pragma unroll
        for (int i = 0; i < D * NEXP / (NWAVES * 64); ++i) wrL[tid + NWAVES * 64 * i] = wv[i];
        __syncthreads(); }
    for (int gw = vcu * NWAVES + wave; gw < MTOK / 16; gw += G * NWAVES) {
        const int b = gw >> 7; const size_t row0 = (size_t)gw * 16;
        f32x4 A[4], Bv[4], G2[4];
#pragma unroll
        for (int j = 0; j < 4; ++j) { const int col = 4 * lane + 256 * j;
            if (NORM) { const f32x4 g = *(const f32x4*)(ng + col), sc = *(const f32x4*)(modl + (size_t)b * 6 * D + sh_off + D + col); A[j] = g * (sc + 1.0f); Bv[j] = *(const f32x4*)(modl + (size_t)b * 6 * D + sh_off + col); }
            if (COMBINE) G2[j] = *(const f32x4*)(g2prev + (size_t)b * 6 * D + col); }
        int my_e1 = 0, my_e2 = 0; float my_w1 = 0.f, my_w2 = 0.f;
        u32x2 cw[4], cy0[4], cy1[4]; f32x4 cf[4]; float cw0 = 0.f, cw1 = 0.f;
#pragma unroll
        for (int j = 0; j < 4; ++j) {
            if (XIN16) cw[j] = *(const u32x2*)((const bf16*)xin + row0 * D + 4 * lane + 256 * j); else cf[j] = *(const f32x4*)((const float*)xin + row0 * D + 4 * lane + 256 * j);
            if (COMBINE) { cy0[j] = *(const u32x2*)(Y + row0 * D + 4 * lane + 256 * j); cy1[j] = *(const u32x2*)(Y + ((size_t)MTOK + row0) * D + 4 * lane + 256 * j); } }
        if (COMBINE) { cw0 = twin[2 * row0]; cw1 = twin[2 * row0 + 1]; }
        for (int r = 0; r < 16; ++r) { const size_t row = row0 + r;
            f32x4 x[4]; u32x2 ny0[4], ny1[4]; float nw0 = 0.f, nw1 = 0.f;
            { const size_t nrow = row + (r < 15 ? 1 : 0);
              u32x2 nwd[4]; f32x4 nf[4];
#pragma unroll
              for (int j = 0; j < 4; ++j) {
                if (XIN16) nwd[j] = *(const u32x2*)((const bf16*)xin + nrow * D + 4 * lane + 256 * j); else nf[j] = *(const f32x4*)((const float*)xin + nrow * D + 4 * lane + 256 * j);
                if (COMBINE) { ny0[j] = *(const u32x2*)(Y + nrow * D + 4 * lane + 256 * j); ny1[j] = *(const u32x2*)(Y + ((size_t)MTOK + nrow) * D + 4 * lane + 256 * j); } }
              if (COMBINE) { nw0 = twin[2 * nrow]; nw1 = twin[2 * nrow + 1]; }
#pragma unroll
              for (int j = 0; j < 4; ++j) {
                if (XIN16) { const u32x2 w = cw[j]; x[j] = (f32x4){bf_lo(w.x), bf_hi(w.x), bf_lo(w.y), bf_hi(w.y)}; cw[j] = nwd[j]; }
                else { x[j] = cf[j]; cf[j] = nf[j]; } } }
            if (COMBINE) { const float w0 = cw0, w1 = cw1; cw0 = nw0; cw1 = nw1;
#pragma unroll
                for (int j = 0; j < 4; ++j) { const u32x2 y0 = cy0[j], y1 = cy1[j]; cy0[j] = ny0[j]; cy1[j] = ny1[j];
                    f32x4 t; t[0] = w0 * bf_lo(y0.x) + w1 * bf_lo(y1.x); t[1] = w0 * bf_hi(y0.x) + w1 * bf_hi(y1.x); t[2] = w0 * bf_lo(y0.y) + w1 * bf_lo(y1.y); t[3] = w0 * bf_hi(y0.y) + w1 * bf_hi(y1.y);
                    x[j] = x[j] + G2[j] * t;
                    if (XOUT16) { u32x2 o; o.x = pk2(x[j][0], x[j][1]); o.y = pk2(x[j][2], x[j][3]); *(u32x2*)((bf16*)xout + row * D + 4 * lane + 256 * j) = o; }
                    else *(f32x4*)((float*)xout + row * D + 4 * lane + 256 * j) = x[j]; } }
            if (NORM) { float ss = 0.f;
#pragma unroll
                for (int j = 0; j < 4; ++j) ss += (x[j][0] * x[j][0] + x[j][1] * x[j][1]) + (x[j][2] * x[j][2] + x[j][3] * x[j][3]);
                const float rstd = __builtin_amdgcn_rsqf(wave_sum(ss) * (1.0f / D) + EPSN);
                float lg[8];
#pragma unroll
                for (int e = 0; e < 8; ++e) lg[e] = 0.f;
                f32x4 hv[4]; float amax = 0.f;
#pragma unroll
                for (int j = 0; j < 4; ++j) { hv[j] = x[j] * rstd * A[j] + Bv[j]; amax = fmaxf(amax, fmaxf(fmaxf(fabsf(hv[j][0]), fabsf(hv[j][1])), fmaxf(fabsf(hv[j][2]), fabsf(hv[j][3])))); }
                float qs = 1.0f;
                if (F8OUT) {
#pragma unroll
                    for (int o = 1; o < 64; o <<= 1) amax = fmaxf(amax, __shfl_xor(amax, o));
                    qs = amax > 0.f ? 127.0f / amax : 1.0f;
                    if (lane == 0) hsc[row] = amax > 0.f ? amax * (1.0f / 127.0f) : 1.0f; }
#pragma unroll
                for (int j = 0; j < 4; ++j) { const f32x4 h = hv[j];
                    if (F8OUT) *(unsigned*)((unsigned char*)H + row * D + 4 * lane + 256 * j) = q4i8(h[0] * qs, h[1] * qs, h[2] * qs, h[3] * qs);
                    else { u32x2 o; o.x = pk2(h[0], h[1]); o.y = pk2(h[2], h[3]); *(u32x2*)(H + row * D + 4 * lane + 256 * j) = o; }
                    if (ROUTE) {
#pragma unroll
                        for (int jj = 0; jj < 4; ++jj) { const LAS f32x4* wp = (const LAS f32x4*)(wrL + (4 * lane + 256 * j + jj) * 8); const f32x4 wa = wp[0], wb = wp[1];
#pragma unroll
                            for (int e = 0; e < 4; ++e) { lg[e] += h[jj] * wa[e]; lg[4 + e] += h[jj] * wb[e]; } } } }
                if (ROUTE) {
#pragma unroll
                    for (int e = 0; e < 8; ++e) lg[e] = wave_sum(lg[e]) + br[e];
                    int e1 = 0; float v1 = lg[0];
#pragma unroll
                    for (int e = 1; e < 8; ++e) if (lg[e] > v1) { v1 = lg[e]; e1 = e; }
                    int e2 = -1; float v2 = -INFINITY;
#pragma unroll
                    for (int e = 0; e < 8; ++e) if (e != e1 && lg[e] > v2) { v2 = lg[e]; e2 = e; }
                    const float w1 = 1.0f / (1.0f + __expf(v2 - v1));
                    if (lane == r) { my_e1 = e1; my_e2 = e2; my_w1 = w1; my_w2 = 1.0f - w1; } } } }
        if (ROUTE) {
            const bool valid = lane < 16; int rank1 = 0, rank2 = 0; unsigned mine = 0;
            const unsigned long long lt = (1ull << lane) - 1ull;
#pragma unroll
            for (int e = 0; e < 8; ++e) { const unsigned long long m1 = __ballot(valid && my_e1 == e), m2 = __ballot(valid && my_e2 == e);
                if (my_e1 == e) rank1 = __popcll(m1 & lt);
                if (my_e2 == e) rank2 = __popcll(m1) + __popcll(m2 & lt);
                if (lane == e) mine = (unsigned)(__popcll(m1) + __popcll(m2)); }
            unsigned base = 0;
            if (lane < 8) base = __hip_atomic_fetch_add(cnt + 64 * lane, mine, __ATOMIC_RELAXED, __HIP_MEMORY_SCOPE_AGENT);
            const int b1 = (int)__shfl((int)base, my_e1), b2 = (int)__shfl((int)base, my_e2);
            if (valid) { int4 tr; tr.x = my_e1; tr.y = b1 + rank1; tr.z = my_e2; tr.w = b2 + rank2; *(int4*)(troute + 4 * (row0 + lane)) = tr;
                twout[2 * (row0 + lane)] = my_w1; twout[2 * (row0 + lane) + 1] = my_w2; } }
    }
}

__device__ __forceinline__ void gather_phase(const unsigned char* H8, unsigned char* AS8, int* rowinfo, const int* troute, const unsigned* cnt, const float* hsc, float* rs, int vcu, int G, int wave, int lane, int tid) {
    int mt[8];
#pragma unroll
    for (int e = 0; e < 8; ++e) mt[e] = (int)((cnt[64 * e] + 255u) >> 8);
    for (int gw = vcu * NWAVES + wave; gw < MTOK / 16; gw += G * NWAVES) {
        const size_t m0 = (size_t)gw * 16;
        int R1v = 0, R2v = 0;
        if (lane < 16) { const int4 tr = *(const int4*)(troute + 4 * (m0 + lane));
            int rb1 = 0, rb2 = 0;
#pragma unroll
            for (int k = 0; k < 7; ++k) { rb1 += (tr.x > k) ? mt[k] * 256 : 0; rb2 += (tr.z > k) ? mt[k] * 256 : 0; }
            R1v = rb1 + tr.y; R2v = rb2 + tr.w;
            rowinfo[R1v] = (int)(2 * (m0 + lane)); rowinfo[R2v] = (int)(2 * (m0 + lane) + 1); const float sc = hsc[m0 + lane]; rs[R1v] = sc; rs[R2v] = sc; }
#pragma unroll
        for (int rb = 0; rb < 16; rb += 4) {
            v4u v[4];
#pragma unroll
            for (int q = 0; q < 4; ++q) v[q] = *(const v4u*)(H8 + (m0 + rb + q) * D + lane * 16);
#pragma unroll
            for (int q = 0; q < 4; ++q) { const size_t R1 = (size_t)__builtin_amdgcn_readlane(R1v, rb + q), R2 = (size_t)__builtin_amdgcn_readlane(R2v, rb + q);
                *(v4u*)(AS8 + R1 * D + lane * 16) = v[q]; *(v4u*)(AS8 + R2 * D + lane * 16) = v[q]; } }
    }
    if (vcu == 0) { int rb = 0;
#pragma unroll
        for (int e = 0; e < 8; ++e) { const int c = (int)cnt[64 * e]; for (int R = rb + c + tid; R < rb + mt[e] * 256; R += NWAVES * 64) { rowinfo[R] = -1; rs[R] = 0.f; } rb += mt[e] * 256; } }
}

typedef short v4i16_t __attribute__((ext_vector_type(4)));
__device__ __forceinline__ s16x4 vtr(unsigned a) { return __builtin_bit_cast(s16x4, __builtin_amdgcn_ds_read_tr16_b64_v4i16((LAS v4i16_t*)(uintptr_t)a)); }
__device__ __forceinline__ void pv_tile(f32x16 (&o)[2], unsigned vb, pg8::bf16x8 pa0, pg8::bf16x8 pa1, pg8::bf16x8 pa2, pg8::bf16x8 pa3) {
    s16x4 lo[2][4], hi[2][4];
#pragma unroll
    for (int d0 = 0; d0 < 2; ++d0)
#pragma unroll
        for (int ks = 0; ks < 4; ++ks) { lo[d0][ks] = vtr(vb + d0 * 4096 + ks * 1024); hi[d0][ks] = vtr(vb + d0 * 4096 + ks * 1024 + 512); }
    __builtin_amdgcn_sched_barrier(0);
#define PK(d, k) (pg8::bf16x8){lo[d][k][0], lo[d][k][1], lo[d][k][2], lo[d][k][3], hi[d][k][0], hi[d][k][1], hi[d][k][2], hi[d][k][3]}
    o[0] = __builtin_amdgcn_mfma_f32_32x32x16_bf16(pa0, PK(0, 0), o[0], 0, 0, 0); o[1] = __builtin_amdgcn_mfma_f32_32x32x16_bf16(pa0, PK(1, 0), o[1], 0, 0, 0);
    o[0] = __builtin_amdgcn_mfma_f32_32x32x16_bf16(pa1, PK(0, 1), o[0], 0, 0, 0); o[1] = __builtin_amdgcn_mfma_f32_32x32x16_bf16(pa1, PK(1, 1), o[1], 0, 0, 0);
    o[0] = __builtin_amdgcn_mfma_f32_32x32x16_bf16(pa2, PK(0, 2), o[0], 0, 0, 0); o[1] = __builtin_amdgcn_mfma_f32_32x32x16_bf16(pa2, PK(1, 2), o[1], 0, 0, 0);
    o[0] = __builtin_amdgcn_mfma_f32_32x32x16_bf16(pa3, PK(0, 3), o[0], 0, 0, 0); o[1] = __builtin_amdgcn_mfma_f32_32x32x16_bf16(pa3, PK(1, 3), o[1], 0, 0, 0);
#undef PK
}
__device__ __forceinline__ void v_dma(const bf16* vsrc, size_t pitch, LAS unsigned char* slot) {
#pragma unroll
    for (int p = 0; p < 8; ++p)
        __builtin_amdgcn_global_load_lds((const unsigned*)(vsrc + (size_t)(16 * (p & 3)) * pitch + (p >> 2) * 32), (LAS unsigned*)(slot + p * 1024), 16, 0, 0);
}
__device__ __forceinline__ unsigned short bf1(float x) { return (unsigned short)f2bf(x); }

typedef float f32x2_t __attribute__((ext_vector_type(2))); typedef __bf16 bf16x2_t __attribute__((ext_vector_type(2)));
__device__ __forceinline__ unsigned cvtpk_s(float lo, float hi) { f32x2_t v = {lo, hi}; bf16x2_t b = __builtin_convertvector(v, bf16x2_t); return __builtin_bit_cast(unsigned, b); }
__device__ __forceinline__ float fmul_s(float a, float b) { float r; asm("v_mul_f32_e32 %0, %1, %2" : "=v"(r) : "v"(a), "v"(b)); return r; }
__device__ __forceinline__ float fsub_s(float a, float b) { float r; asm("v_sub_f32_e32 %0, %1, %2" : "=v"(r) : "v"(a), "v"(b)); return r; }
constexpr int AT_STAGE = 65536, AT_VOFF = 32768, AT_TPS = 4;
template <int MODE>
__device__ __forceinline__ void attn_phase(const bf16* __restrict__ Q, const bf16* __restrict__ K, const bf16* __restrict__ V, bf16* __restrict__ O, const float* relb, LAS unsigned char* L, int vcu, int G, int wave, int lane, int tid) {
    LAS float* biasL = (LAS float*)(L + XTRA_OFF);
    LAS float* wsf = (LAS float*)(L + XTRA_OFF + 16 * 193 * 4) + wave * 64;
    volatile LAS unsigned* act = (volatile LAS unsigned*)(L + XTRA_OFF + 16 * 193 * 4 + 2048);
    LAS bf16* stg = (LAS bf16*)(L + wave * 4096);
    if (MODE == 1) { constexpr int NBI = (NHEAD * 193 + NWAVES * 64 - 1) / (NWAVES * 64); float bv[NBI];
#pragma unroll
        for (int i = 0; i < NBI; ++i) { const int u = tid + NWAVES * 64 * i, hh = u / 193, ii = u - hh * 193; bv[i] = u < NHEAD * 193 ? relb[hh * 257 + 64 + ii] : 0.f; }
#pragma unroll
        for (int i = 0; i < NBI; ++i) { const int u = tid + NWAVES * 64 * i; if (u < NHEAD * 193) biasL[u] = bv[i] * LOG2E; } }
    __syncthreads();
    const int r32 = lane & 31, hi = lane >> 5;
    const unsigned vlane = ((lane >> 4) & 1) * 32 + (lane & 3) * 8 + (4 * hi + ((lane & 15) >> 2)) * 64;
    const unsigned klane = hi * 1024 + r32 * 16;
    for (int idx = vcu; idx < NB * NHEAD * 8; idx += G) {
        const int bh = idx >> 3, qb = ((idx & 7) + (idx >> 11)) & 7, b = bh >> 4, h = bh & 15;
        const size_t rowbase = (size_t)b * SEQ;
        const int cw = 4 * qb + (wave >> 1), r0 = 256 * qb + 32 * wave, t = r0 + r32;
        const int kt_top = 4 * qb + 3;
        const int lo_w = MODE == 1 ? (cw > 8 ? cw - 8 : 0) : 0;
        const int nstage = MODE == 1 ? (qb >= 2 ? 3 : qb + 1) : qb + 1;
        const LAS float* biasT = biasL + h * 193 - 64;
        pg8::bf16x8 qr[4];
        { const bf16* qp = Q + (rowbase + r0 + r32) * D + h * HD + hi * 8;
#pragma unroll
          for (int d0 = 0; d0 < 4; ++d0) qr[d0] = *(const pg8::bf16x8*)(qp + d0 * 16); }
        const bf16* ksrc = K + (rowbase + lane) * D + h * HD + wave * 8;
        const bf16* vsrc = V + (rowbase + 16 * (wave & 3) + (lane >> 2)) * D + h * HD + (wave >> 2) * 32 + (lane & 3) * 8;
#define AT_DMA(g_, buf_) do { _Pragma("unroll") for (int j_ = 0; j_ < AT_TPS; ++j_) { const int kt_ = kt_top - AT_TPS * (g_) - j_; \
        __builtin_amdgcn_global_load_lds((const unsigned*)(ksrc + (size_t)kt_ * 64 * D), (LAS unsigned*)(L + (buf_) * AT_STAGE + j_ * 8192 + wave * 1024), 16, 0, 0); \
        __builtin_amdgcn_global_load_lds((const unsigned*)(vsrc + (size_t)kt_ * 64 * D), (LAS unsigned*)(L + (buf_) * AT_STAGE + AT_VOFF + j_ * 8192 + wave * 1024), 16, 0, 0); } } while (0)
        AT_DMA(0, 0);
        f32x16 o[2];
#pragma unroll
        for (int r = 0; r < 16; ++r) { o[0][r] = 0.f; o[1][r] = 0.f; }
        float prun = 1.0f, mrun = -INFINITY, lrun = 0.f;
        bool done = false;
        for (int g = 0; g < nstage; ++g) {
            const int buf = g & 1;
            asm volatile("s_waitcnt vmcnt(0)" ::: "memory");
            if (MODE == 0) { if (lane == 0) act[buf * 8 + wave] = done ? 0u : 1u; }
            asm volatile("s_waitcnt lgkmcnt(0)" ::: "memory");
            __syncthreads();
            if (MODE == 0) { unsigned any = 0;
#pragma unroll
                for (int w = 0; w < 8; ++w) any |= act[buf * 8 + w];
                if (!any) break; }
            if (g + 1 < nstage) AT_DMA(g + 1, buf ^ 1);
#pragma nounroll
            for (int j = 0; j < AT_TPS; ++j) {
                const int kt = kt_top - AT_TPS * g - j;
                if (kt <= cw && kt >= lo_w && !done) {
                const unsigned kb = (unsigned)(uintptr_t)(L + buf * AT_STAGE + j * 8192) + klane;
                f32x16 p0, p1;
                { const float cinit = (MODE == 1 && cw - kt >= 3) ? biasT[256] : 0.f;
#pragma unroll
                  for (int r = 0; r < 16; ++r) { p0[r] = cinit; p1[r] = cinit; } }
                pg8::bf16x8 kfr[8];
#pragma unroll
                for (int d0 = 0; d0 < 4; ++d0) { kfr[2 * d0] = *(const LAS pg8::bf16x8*)(uintptr_t)(kb + d0 * 2048); kfr[2 * d0 + 1] = *(const LAS pg8::bf16x8*)(uintptr_t)(kb + d0 * 2048 + 512); }
                __builtin_amdgcn_sched_barrier(0);
#pragma unroll
                for (int d0 = 0; d0 < 4; ++d0) { p0 = __builtin_amdgcn_mfma_f32_32x32x16_bf16(kfr[2 * d0], qr[d0], p0, 0, 0, 0); p1 = __builtin_amdgcn_mfma_f32_32x32x16_bf16(kfr[2 * d0 + 1], qr[d0], p1, 0, 0, 0); }
                if (MODE == 0) {
                    float F0[16], F1[16];
#pragma unroll
                    for (int r = 0; r < 16; ++r) { F0[r] = pg8::rcp(1.0f + pg8::ex2(p0[r])); F1[r] = pg8::rcp(1.0f + pg8::ex2(p1[r])); }
                    if (kt == cw) { const int kbase = 64 * kt + 4 * hi;
#pragma unroll
                        for (int r = 0; r < 16; ++r) { const int kv = kbase + (r & 3) + 8 * (r >> 2); if (kv >= t) F0[r] = 1.0f; if (kv + 32 >= t) F1[r] = 1.0f; } }
                    float g0[8], g1[8], E[8];
#pragma unroll
                    for (int i = 0; i < 4; ++i) { const float ga = fmul_s(fmul_s(F0[4 * i], F0[4 * i + 1]), fmul_s(F0[4 * i + 2], F0[4 * i + 3])), gb = fmul_s(fmul_s(F1[4 * i], F1[4 * i + 1]), fmul_s(F1[4 * i + 2], F1[4 * i + 3]));
                        auto ra = __builtin_amdgcn_permlane32_swap(__float_as_uint(ga), __float_as_uint(ga), false, false); g0[i] = __uint_as_float(ra[0]); g1[i] = __uint_as_float(ra[1]);
                        auto rb = __builtin_amdgcn_permlane32_swap(__float_as_uint(gb), __float_as_uint(gb), false, false); g0[4 + i] = __uint_as_float(rb[0]); g1[4 + i] = __uint_as_float(rb[1]); }
                    float run = prun;
#pragma unroll
                    for (int x = 1; x >= 0; --x)
#pragma unroll
                        for (int i = 3; i >= 0; --i) {
                            const float E1 = run; run *= g1[4 * x + i]; const float E0 = run; run *= g0[4 * x + i]; E[4 * x + i] = hi ? E1 : E0; }
                    prun = run;
#pragma unroll
                    for (int i = 0; i < 4; ++i) { float w = E[i];
#pragma unroll
                        for (int j = 3; j >= 0; --j) { const float wn = fmul_s(w, F0[4 * i + j]); p0[4 * i + j] = fsub_s(w, wn); w = wn; }
                        w = E[4 + i];
#pragma unroll
                        for (int j = 3; j >= 0; --j) { const float wn = fmul_s(w, F1[4 * i + j]); p1[4 * i + j] = fsub_s(w, wn); w = wn; } }
                    done = !__any(prun > 1.0e-16f);
                } else {
                    if (cw - kt < 3) { const int base = t - 64 * kt - 4 * hi;
#pragma unroll
                        for (int r = 0; r < 16; ++r) { int i0 = base - ((r & 3) + 8 * (r >> 2)); int i1 = i0 - 32;
                            i0 = min(max(i0, -128), 128); i1 = min(max(i1, -128), 128);
                            p0[r] += biasT[i0 + 128]; p1[r] += biasT[i1 + 128]; } }
                    float mx = fmaxf(p0[0], p1[0]);
#pragma unroll
                    for (int r = 1; r < 16; ++r) mx = fmaxf(mx, fmaxf(p0[r], p1[r]));
                    { auto rr = __builtin_amdgcn_permlane32_swap(__float_as_uint(mx), __float_as_uint(mx), false, false); mx = fmaxf(__uint_as_float(rr[0]), __uint_as_float(rr[1])); }
                    const float mnew = fmaxf(mrun, mx), alpha = pg8::ex2(mrun - mnew); mrun = mnew;
                    float ls = 0.f;
#pragma unroll
                    for (int r = 0; r < 16; ++r) { p0[r] = pg8::ex2(p0[r] - mnew); p1[r] = pg8::ex2(p1[r] - mnew); ls += p0[r] + p1[r]; }
                    lrun = lrun * alpha + ls;
                    if (kt != cw) { if (hi == 0) wsf[r32] = alpha; asm volatile("s_waitcnt lgkmcnt(0)" ::: "memory");
#pragma unroll
                        for (int r = 0; r < 16; ++r) { const float f = wsf[crow(r, hi)]; o[0][r] *= f; o[1][r] *= f; }
                        asm volatile("s_waitcnt lgkmcnt(0)" ::: "memory"); }
                }
                pg8::u32x4 pw0, pw1, pw2, pw3;
                pw0 = (pg8::u32x4){cvtpk_s(p0[0], p0[1]), cvtpk_s(p0[2], p0[3]), cvtpk_s(p0[4], p0[5]), cvtpk_s(p0[6], p0[7])};
                pw1 = (pg8::u32x4){cvtpk_s(p0[8], p0[9]), cvtpk_s(p0[10], p0[11]), cvtpk_s(p0[12], p0[13]), cvtpk_s(p0[14], p0[15])};
                pw2 = (pg8::u32x4){cvtpk_s(p1[0], p1[1]), cvtpk_s(p1[2], p1[3]), cvtpk_s(p1[4], p1[5]), cvtpk_s(p1[6], p1[7])};
                pw3 = (pg8::u32x4){cvtpk_s(p1[8], p1[9]), cvtpk_s(p1[10], p1[11]), cvtpk_s(p1[12], p1[13]), cvtpk_s(p1[14], p1[15])};
                pv_tile(o, (unsigned)(uintptr_t)(L + buf * AT_STAGE + AT_VOFF + j * 8192) + vlane, __builtin_bit_cast(pg8::bf16x8, pw0), __builtin_bit_cast(pg8::bf16x8, pw1), __builtin_bit_cast(pg8::bf16x8, pw2), __builtin_bit_cast(pg8::bf16x8, pw3));
                }
            }
        }
#undef AT_DMA
        VM_WAIT(); LDS_WAIT();
        __syncthreads();
        float sc[16];
#pragma unroll
        for (int r = 0; r < 16; ++r) sc[r] = 1.0f;
        if (MODE == 1) { float lt; { auto rr = __builtin_amdgcn_permlane32_swap(__float_as_uint(lrun), __float_as_uint(lrun), false, false); lt = __uint_as_float(rr[0]) + __uint_as_float(rr[1]); }
            if (hi == 0) wsf[r32] = pg8::rcp(lt); asm volatile("s_waitcnt lgkmcnt(0)" ::: "memory");
#pragma unroll
            for (int r = 0; r < 16; ++r) sc[r] = wsf[crow(r, hi)];
            asm volatile("s_waitcnt lgkmcnt(0)" ::: "memory"); }
#pragma unroll
        for (int r = 0; r < 16; ++r) { const int q = crow(r, hi); stg[q * 64 + r32] = bf1(o[0][r] * sc[r]); stg[q * 64 + 32 + r32] = bf1(o[1][r] * sc[r]); }
        LDS_WAIT();
        bf16* op = O + (rowbase + r0) * D + h * HD;
#pragma unroll
        for (int i = 0; i < 4; ++i) { const int row = i * 8 + (lane >> 3), ch = lane & 7; const v4u v = *(const LAS v4u*)(stg + row * 64 + ch * 8); *(v4u*)(op + (size_t)row * D + ch * 8) = v; }
        LDS_WAIT();
        __syncthreads();
    }
    LDS_WAIT(); VM_WAIT();
}

constexpr int SB_NT0 = 6, SB_VA = SB_NT0 * 8192, SB_B = 2 * SB_NT0 * 8192, SB_BV = SB_B + 16384;
__device__ __forceinline__ void attn_sb_phase(const bf16* __restrict__ Q, const bf16* __restrict__ K, const bf16* __restrict__ V, bf16* __restrict__ O, LAS unsigned char* L, int vcu, int G, int wave, int lane, int tid) {
    constexpr int MODE = 0;
    volatile LAS unsigned* act = (volatile LAS unsigned*)(L + XTRA_OFF);
    LAS bf16* stg = (LAS bf16*)(L + SB_B + wave * 4096);
    const LAS float* biasT = nullptr; LAS float* wsf = nullptr; (void)biasT; (void)wsf;
    const int r32 = lane & 31, hi = lane >> 5;
    const unsigned vlane = ((lane >> 4) & 1) * 32 + (lane & 3) * 8 + (4 * hi + ((lane & 15) >> 2)) * 64;
    const unsigned klane = hi * 1024 + r32 * 16;
    __syncthreads();
#define SB_UNIT(idx_, b_, h_, qb_) const int bh_ = (idx_) >> 3; qb_ = (((idx_) & 7) + ((idx_) >> 11)) & 7; b_ = bh_ >> 4; h_ = bh_ & 15
#define SB_DMA1(kt_, koff_, voff_) do { __builtin_amdgcn_global_load_lds((const unsigned*)(ksrc + (size_t)(kt_) * 64 * D), (LAS unsigned*)(L + (koff_) + wave * 1024), 16, 0, 0); \
        __builtin_amdgcn_global_load_lds((const unsigned*)(vsrc + (size_t)(kt_) * 64 * D), (LAS unsigned*)(L + (voff_) + wave * 1024), 16, 0, 0); } while (0)
    int idx = vcu; if (idx >= NB * NHEAD * 8) return;
    int b, h, qb; { SB_UNIT(idx, b, h, qb); }
    pg8::bf16x8 qr[4];
    const bf16* ksrc; const bf16* vsrc;
    { const size_t rowbase = (size_t)b * SEQ; const int r0 = 256 * qb + 32 * wave;
      const bf16* qp = Q + (rowbase + r0 + r32) * D + h * HD + hi * 8;
#pragma unroll
      for (int d0 = 0; d0 < 4; ++d0) qr[d0] = *(const pg8::bf16x8*)(qp + d0 * 16);
      ksrc = K + (rowbase + lane) * D + h * HD + wave * 8; vsrc = V + (rowbase + 16 * (wave & 3) + (lane >> 2)) * D + h * HD + (wave >> 2) * 32 + (lane & 3) * 8;
#pragma unroll
      for (int j = 0; j < SB_NT0; ++j) { const int kt = 4 * qb + 3 - j; if (kt >= 0) SB_DMA1(kt, j * 8192, SB_VA + j * 8192); } }
    for (;;) {
        const size_t rowbase = (size_t)b * SEQ;
        const int cw = 4 * qb + (wave >> 1), r0 = 256 * qb + 32 * wave, t = r0 + r32, kt_top = 4 * qb + 3;
        f32x16 o[2];
#pragma unroll
        for (int r = 0; r < 16; ++r) { o[0][r] = 0.f; o[1][r] = 0.f; }
        float prun = 1.0f, mrun = 0.f, lrun = 0.f; (void)mrun; (void)lrun;
        bool done = false;
        asm volatile("s_waitcnt vmcnt(0)" ::: "memory");
        __syncthreads();
        { const int kt_end = kt_top - (SB_NT0 - 1) > 0 ? kt_top - (SB_NT0 - 1) : 0;
#pragma nounroll
          for (int kt = cw; kt >= kt_end; --kt) {
            if (!done) { const int kslot = (kt_top - kt) * 8192, vslot = SB_VA + (kt_top - kt) * 8192;
                const unsigned kb = (unsigned)(uintptr_t)(L + kslot) + klane;
                f32x16 p0, p1;
                { const float cinit = (MODE == 1 && cw - kt >= 3) ? biasT[256] : 0.f;
#pragma unroll
                  for (int r = 0; r < 16; ++r) { p0[r] = cinit; p1[r] = cinit; } }
                pg8::bf16x8 kfr[8];
#pragma unroll
                for (int d0 = 0; d0 < 4; ++d0) { kfr[2 * d0] = *(const LAS pg8::bf16x8*)(uintptr_t)(kb + d0 * 2048); kfr[2 * d0 + 1] = *(const LAS pg8::bf16x8*)(uintptr_t)(kb + d0 * 2048 + 512); }
                __builtin_amdgcn_sched_barrier(0);
#pragma unroll
                for (int d0 = 0; d0 < 4; ++d0) { p0 = __builtin_amdgcn_mfma_f32_32x32x16_bf16(kfr[2 * d0], qr[d0], p0, 0, 0, 0); p1 = __builtin_amdgcn_mfma_f32_32x32x16_bf16(kfr[2 * d0 + 1], qr[d0], p1, 0, 0, 0); }
                if (MODE == 0) {
                    float F0[16], F1[16];
#pragma unroll
                    for (int r = 0; r < 16; ++r) { F0[r] = pg8::rcp(1.0f + pg8::ex2(p0[r])); F1[r] = pg8::rcp(1.0f + pg8::ex2(p1[r])); }
                    if (kt == cw) { const int kbase = 64 * kt + 4 * hi;
#pragma unroll
                        for (int r = 0; r < 16; ++r) { const int kv = kbase + (r & 3) + 8 * (r >> 2); if (kv >= t) F0[r] = 1.0f; if (kv + 32 >= t) F1[r] = 1.0f; } }
                    float g0[8], g1[8], E[8];
#pragma unroll
                    for (int i = 0; i < 4; ++i) { const float ga = fmul_s(fmul_s(F0[4 * i], F0[4 * i + 1]), fmul_s(F0[4 * i + 2], F0[4 * i + 3])), gb = fmul_s(fmul_s(F1[4 * i], F1[4 * i + 1]), fmul_s(F1[4 * i + 2], F1[4 * i + 3]));
                        auto ra = __builtin_amdgcn_permlane32_swap(__float_as_uint(ga), __float_as_uint(ga), false, false); g0[i] = __uint_as_float(ra[0]); g1[i] = __uint_as_float(ra[1]);
                        auto rb = __builtin_amdgcn_permlane32_swap(__float_as_uint(gb), __float_as_uint(gb), false, false); g0[4 + i] = __uint_as_float(rb[0]); g1[4 + i] = __uint_as_float(rb[1]); }
                    float run = prun;
#pragma unroll
                    for (int x = 1; x >= 0; --x)
#pragma unroll
                        for (int i = 3; i >= 0; --i) {
                            const float E1 = run; run *= g1[4 * x + i]; const float E0 = run; run *= g0[4 * x + i]; E[4 * x + i] = hi ? E1 : E0; }
                    prun = run;
#pragma unroll
                    for (int i = 0; i < 4; ++i) { float w = E[i];
#pragma unroll
                        for (int j = 3; j >= 0; --j) { const float wn = fmul_s(w, F0[4 * i + j]); p0[4 * i + j] = fsub_s(w, wn); w = wn; }
                        w = E[4 + i];
#pragma unroll
                        for (int j = 3; j >= 0; --j) { const float wn = fmul_s(w, F1[4 * i + j]); p1[4 * i + j] = fsub_s(w, wn); w = wn; } }
                    done = !__any(prun > 1.0e-16f);
                } else {
                    if (cw - kt < 3) { const int base = t - 64 * kt - 4 * hi;
#pragma unroll
                        for (int r = 0; r < 16; ++r) { int i0 = base - ((r & 3) + 8 * (r >> 2)); int i1 = i0 - 32;
                            i0 = min(max(i0, -128), 128); i1 = min(max(i1, -128), 128);
                            p0[r] += biasT[i0 + 128]; p1[r] += biasT[i1 + 128]; } }
                    float mx = fmaxf(p0[0], p1[0]);
#pragma unroll
                    for (int r = 1; r < 16; ++r) mx = fmaxf(mx, fmaxf(p0[r], p1[r]));
                    { auto rr = __builtin_amdgcn_permlane32_swap(__float_as_uint(mx), __float_as_uint(mx), false, false); mx = fmaxf(__uint_as_float(rr[0]), __uint_as_float(rr[1])); }
                    const float mnew = fmaxf(mrun, mx), alpha = pg8::ex2(mrun - mnew); mrun = mnew;
                    float ls = 0.f;
#pragma unroll
                    for (int r = 0; r < 16; ++r) { p0[r] = pg8::ex2(p0[r] - mnew); p1[r] = pg8::ex2(p1[r] - mnew); ls += p0[r] + p1[r]; }
                    lrun = lrun * alpha + ls;
                    if (kt != cw) { if (hi == 0) wsf[r32] = alpha; asm volatile("s_waitcnt lgkmcnt(0)" ::: "memory");
#pragma unroll
                        for (int r = 0; r < 16; ++r) { const float f = wsf[crow(r, hi)]; o[0][r] *= f; o[1][r] *= f; }
                        asm volatile("s_waitcnt lgkmcnt(0)" ::: "memory"); }
                }
                pg8::u32x4 pw0, pw1, pw2, pw3;
                pw0 = (pg8::u32x4){cvtpk_s(p0[0], p0[1]), cvtpk_s(p0[2], p0[3]), cvtpk_s(p0[4], p0[5]), cvtpk_s(p0[6], p0[7])};
                pw1 = (pg8::u32x4){cvtpk_s(p0[8], p0[9]), cvtpk_s(p0[10], p0[11]), cvtpk_s(p0[12], p0[13]), cvtpk_s(p0[14], p0[15])};
                pw2 = (pg8::u32x4){cvtpk_s(p1[0], p1[1]), cvtpk_s(p1[2], p1[3]), cvtpk_s(p1[4], p1[5]), cvtpk_s(p1[6], p1[7])};
                pw3 = (pg8::u32x4){cvtpk_s(p1[8], p1[9]), cvtpk_s(p1[10], p1[11]), cvtpk_s(p1[12], p1[13]), cvtpk_s(p1[14], p1[15])};
                pv_tile(o, (unsigned)(uintptr_t)(L + vslot) + vlane, __builtin_bit_cast(pg8::bf16x8, pw0), __builtin_bit_cast(pg8::bf16x8, pw1), __builtin_bit_cast(pg8::bf16x8, pw2), __builtin_bit_cast(pg8::bf16x8, pw3));
            }
          } }
        int ktn = kt_top - SB_NT0; int par = 0;
        for (;;) {
            if (lane == 0) act[par * 8 + wave] = (done || ktn < 0) ? 0u : 1u;
            asm volatile("s_waitcnt lgkmcnt(0)" ::: "memory");
            __syncthreads();
            unsigned any = 0;
#pragma unroll
            for (int w = 0; w < 8; ++w) any |= act[par * 8 + w];
            par ^= 1;
            if (!any) break;
            SB_DMA1(ktn, SB_B, SB_BV); if (ktn >= 1) SB_DMA1(ktn - 1, SB_B + 8192, SB_BV + 8192);
            asm volatile("s_waitcnt vmcnt(0)" ::: "memory");
            __syncthreads();
#pragma nounroll
            for (int j = 0; j < 2; ++j) { const int kt = ktn - j;
                if (kt >= 0 && !done) { const int kslot = SB_B + j * 8192, vslot = SB_BV + j * 8192;
                const unsigned kb = (unsigned)(uintptr_t)(L + kslot) + klane;
                f32x16 p0, p1;
                { const float cinit = (MODE == 1 && cw - kt >= 3) ? biasT[256] : 0.f;
#pragma unroll
                  for (int r = 0; r < 16; ++r) { p0[r] = cinit; p1[r] = cinit; } }
                pg8::bf16x8 kfr[8];
#pragma unroll
                for (int d0 = 0; d0 < 4; ++d0) { kfr[2 * d0] = *(const LAS pg8::bf16x8*)(uintptr_t)(kb + d0 * 2048); kfr[2 * d0 + 1] = *(const LAS pg8::bf16x8*)(uintptr_t)(kb + d0 * 2048 + 512); }
                __builtin_amdgcn_sched_barrier(0);
#pragma unroll
                for (int d0 = 0; d0 < 4; ++d0) { p0 = __builtin_amdgcn_mfma_f32_32x32x16_bf16(kfr[2 * d0], qr[d0], p0, 0, 0, 0); p1 = __builtin_amdgcn_mfma_f32_32x32x16_bf16(kfr[2 * d0 + 1], qr[d0], p1, 0, 0, 0); }
                if (MODE == 0) {
                    float F0[16], F1[16];
#pragma unroll
                    for (int r = 0; r < 16; ++r) { F0[r] = pg8::rcp(1.0f + pg8::ex2(p0[r])); F1[r] = pg8::rcp(1.0f + pg8::ex2(p1[r])); }
                    if (kt == cw) { const int kbase = 64 * kt + 4 * hi;
#pragma unroll
                        for (int r = 0; r < 16; ++r) { const int kv = kbase + (r & 3) + 8 * (r >> 2); if (kv >= t) F0[r] = 1.0f; if (kv + 32 >= t) F1[r] = 1.0f; } }
                    float g0[8], g1[8], E[8];
#pragma unroll
                    for (int i = 0; i < 4; ++i) { const float ga = fmul_s(fmul_s(F0[4 * i], F0[4 * i + 1]), fmul_s(F0[4 * i + 2], F0[4 * i + 3])), gb = fmul_s(fmul_s(F1[4 * i], F1[4 * i + 1]), fmul_s(F1[4 * i + 2], F1[4 * i + 3]));
                        auto ra = __builtin_amdgcn_permlane32_swap(__float_as_uint(ga), __float_as_uint(ga), false, false); g0[i] = __uint_as_float(ra[0]); g1[i] = __uint_as_float(ra[1]);
                        auto rb = __builtin_amdgcn_permlane32_swap(__float_as_uint(gb), __float_as_uint(gb), false, false); g0[4 + i] = __uint_as_float(rb[0]); g1[4 + i] = __uint_as_float(rb[1]); }
                    float run = prun;
#pragma unroll
                    for (int x = 1; x >= 0; --x)
#pragma unroll
                        for (int i = 3; i >= 0; --i) {
                            const float E1 = run; run *= g1[4 * x + i]; const float E0 = run; run *= g0[4 * x + i]; E[4 * x + i] = hi ? E1 : E0; }
                    prun = run;
#pragma unroll
                    for (int i = 0; i < 4; ++i) { float w = E[i];
#pragma unroll
                        for (int j = 3; j >= 0; --j) { const float wn = fmul_s(w, F0[4 * i + j]); p0[4 * i + j] = fsub_s(w, wn); w = wn; }
                        w = E[4 + i];
#pragma unroll
                        for (int j = 3; j >= 0; --j) { const float wn = fmul_s(w, F1[4 * i + j]); p1[4 * i + j] = fsub_s(w, wn); w = wn; } }
                    done = !__any(prun > 1.0e-16f);
                } else {
                    if (cw - kt < 3) { const int base = t - 64 * kt - 4 * hi;
#pragma unroll
                        for (int r = 0; r < 16; ++r) { int i0 = base - ((r & 3) + 8 * (r >> 2)); int i1 = i0 - 32;
                            i0 = min(max(i0, -128), 128); i1 = min(max(i1, -128), 128);
                            p0[r] += biasT[i0 + 128]; p1[r] += biasT[i1 + 128]; } }
                    float mx = fmaxf(p0[0], p1[0]);
#pragma unroll
                    for (int r = 1; r < 16; ++r) mx = fmaxf(mx, fmaxf(p0[r], p1[r]));
                    { auto rr = __builtin_amdgcn_permlane32_swap(__float_as_uint(mx), __float_as_uint(mx), false, false); mx = fmaxf(__uint_as_float(rr[0]), __uint_as_float(rr[1])); }
                    const float mnew = fmaxf(mrun, mx), alpha = pg8::ex2(mrun - mnew); mrun = mnew;
                    float ls = 0.f;
#pragma unroll
                    for (int r = 0; r < 16; ++r) { p0[r] = pg8::ex2(p0[r] - mnew); p1[r] = pg8::ex2(p1[r] - mnew); ls += p0[r] + p1[r]; }
                    lrun = lrun * alpha + ls;
                    if (kt != cw) { if (hi == 0) wsf[r32] = alpha; asm volatile("s_waitcnt lgkmcnt(0)" ::: "memory");
#pragma unroll
                        for (int r = 0; r < 16; ++r) { const float f = wsf[crow(r, hi)]; o[0][r] *= f; o[1][r] *= f; }
                        asm volatile("s_waitcnt lgkmcnt(0)" ::: "memory"); }
                }
                pg8::u32x4 pw0, pw1, pw2, pw3;
                pw0 = (pg8::u32x4){cvtpk_s(p0[0], p0[1]), cvtpk_s(p0[2], p0[3]), cvtpk_s(p0[4], p0[5]), cvtpk_s(p0[6], p0[7])};
                pw1 = (pg8::u32x4){cvtpk_s(p0[8], p0[9]), cvtpk_s(p0[10], p0[11]), cvtpk_s(p0[12], p0[13]), cvtpk_s(p0[14], p0[15])};
                pw2 = (pg8::u32x4){cvtpk_s(p1[0], p1[1]), cvtpk_s(p1[2], p1[3]), cvtpk_s(p1[4], p1[5]), cvtpk_s(p1[6], p1[7])};
                pw3 = (pg8::u32x4){cvtpk_s(p1[8], p1[9]), cvtpk_s(p1[10], p1[11]), cvtpk_s(p1[12], p1[13]), cvtpk_s(p1[14], p1[15])};
                pv_tile(o, (unsigned)(uintptr_t)(L + vslot) + vlane, __builtin_bit_cast(pg8::bf16x8, pw0), __builtin_bit_cast(pg8::bf16x8, pw1), __builtin_bit_cast(pg8::bf16x8, pw2), __builtin_bit_cast(pg8::bf16x8, pw3));
                } }
            ktn -= 2;
        }
        const int idx_n = idx + G; const bool more = idx_n < NB * NHEAD * 8;
        int bn = 0, hn = 0, qbn = 0; pg8::bf16x8 qn[4];
        if (more) { SB_UNIT(idx_n, bn, hn, qbn); const size_t rbn = (size_t)bn * SEQ;
            const bf16* qp = Q + (rbn + 256 * qbn + 32 * wave + r32) * D + hn * HD + hi * 8;
#pragma unroll
            for (int d0 = 0; d0 < 4; ++d0) qn[d0] = *(const pg8::bf16x8*)(qp + d0 * 16);
            ksrc = K + (rbn + lane) * D + hn * HD + wave * 8; vsrc = V + (rbn + 16 * (wave & 3) + (lane >> 2)) * D + hn * HD + (wave >> 2) * 32 + (lane & 3) * 8;
#pragma unroll
            for (int j = 0; j < SB_NT0; ++j) { const int kt = 4 * qbn + 3 - j; if (kt >= 0) SB_DMA1(kt, j * 8192, SB_VA + j * 8192); } }
#pragma unroll
        for (int r = 0; r < 16; ++r) { const int q = crow(r, hi); stg[q * 64 + r32] = bf1(o[0][r]); stg[q * 64 + 32 + r32] = bf1(o[1][r]); }
        LDS_WAIT();
        bf16* op = O + (rowbase + r0) * D + h * HD;
#pragma unroll
        for (int i = 0; i < 4; ++i) { const int row = i * 8 + (lane >> 3), ch = lane & 7; const v4u v = *(const LAS v4u*)(stg + row * 64 + ch * 8); *(v4u*)(op + (size_t)row * D + ch * 8) = v; }
        LDS_WAIT();
        if (!more) break;
        idx = idx_n; b = bn; h = hn; qb = qbn;
#pragma unroll
        for (int d0 = 0; d0 < 4; ++d0) qr[d0] = qn[d0];
    }
#undef SB_UNIT
#undef SB_DMA1
    VM_WAIT(); LDS_WAIT(); __syncthreads();
}

constexpr int SP_VBUF = 32768, SP_GATE = 65536, SP_GPITCH = 136;
__device__ __forceinline__ void spatial_phase(bf16* U, const bf16* Vb, const float* vpart, const float* ws, const float* bs, const float* vg, LAS unsigned char* L, int vcu, int G, int wave, int lane, int tid) {
    LAS float* psum = (LAS float*)(L + XTRA_OFF);
    LAS float* rstdL = psum + 512;
    LAS bf16* gateT = (LAS bf16*)(L + SP_GATE);
    const int r32 = lane & 31, hi = lane >> 5, ib = wave & 3, cbw = wave >> 2;
    const unsigned vlane = ((lane >> 4) & 1) * 32 + (lane & 3) * 8 + (4 * hi + ((lane & 15) >> 2)) * 64;
    const int njt = ib < 2 ? 1 : 2;
    for (int win = vcu; win < NB * 16; win += G) {
        const size_t tok0 = (size_t)win * 128;
        { const int j = tid & 127, part = tid >> 7; const f32x4* p = (const f32x4*)(vpart + (tok0 + j) * 48 + part * 12); const f32x4 a = p[0], c = p[1], d = p[2];
          psum[part * 128 + j] = ((a[0] + a[1]) + (a[2] + a[3])) + ((c[0] + c[1]) + (c[2] + c[3])) + ((d[0] + d[1]) + (d[2] + d[3])); }
        __syncthreads();
        if (tid < 128) rstdL[tid] = __builtin_amdgcn_rsqf(((psum[tid] + psum[128 + tid]) + (psum[256 + tid] + psum[384 + tid])) * (1.0f / SGH) + EPSN);
        __syncthreads();
        const bf16* vsrc0 = Vb + (tok0 + 64 * ((wave >> 1) & 1) + (lane >> 2)) * SGH + (wave >> 2) * 64 + (wave & 1) * 32 + (lane & 3) * 8;
        const int vdst0 = (wave >> 2) * 16384 + ((wave >> 1) & 1) * 8192 + (wave & 1) * 4096;
#define SP_DMA(c0_, buf_) do { _Pragma("unroll") for (int k = 0; k < 4; ++k) \
        __builtin_amdgcn_global_load_lds((const unsigned*)(vsrc0 + (size_t)(16 * k) * SGH + (c0_)), (LAS unsigned*)(L + (buf_) * SP_VBUF + vdst0 + k * 1024), 16, 0, 0); } while (0)
        SP_DMA(0, 0);
        pg8::u32x4 pw[2][4]; float bsv[16];
        for (int u = 0; u < 24; ++u) {
            const int g = u / 3, c0 = g * 384 + (u - 3 * g) * 128, buf = u & 1;
            if (u == 0) asm volatile("s_waitcnt vmcnt(0)" ::: "memory");
            else asm volatile("s_waitcnt vmcnt(8)" ::: "memory");
            __syncthreads();
            if (u + 1 < 24) { const int g1 = (u + 1) / 3; SP_DMA(g1 * 384 + (u + 1 - 3 * g1) * 128, buf ^ 1); }
            asm volatile("" ::: "memory");
            v4u uv[4];
#pragma unroll
            for (int k = 0; k < 4; ++k) { const int q = tid + 512 * k; uv[k] = *(const v4u*)(U + (tok0 + (q >> 4)) * SGH + c0 + (q & 15) * 8); }
            if (u == 3 * g) {
#pragma unroll
                for (int jt = 0; jt < 2; ++jt) if (jt < njt) {
                    const float* wrow = ws + ((size_t)g * 128 + 32 * ib + r32) * 128 + 64 * jt + 4 * hi;
#pragma unroll
                    for (int ks = 0; ks < 4; ++ks) { const f32x4 wa = *(const f32x4*)(wrow + 16 * ks), wb = *(const f32x4*)(wrow + 16 * ks + 8);
                        const f32x4 ra = *(const LAS f32x4*)(rstdL + 64 * jt + 16 * ks + 4 * hi), rb = *(const LAS f32x4*)(rstdL + 64 * jt + 16 * ks + 4 * hi + 8);
                        pw[jt][ks] = pg8::pack8(wa * ra, wb * rb); } }
#pragma unroll
                for (int r = 0; r < 16; ++r) bsv[r] = bs[g * 128 + 32 * ib + crow(r, hi)];
            }
            const float vg0 = vg[c0 + cbw * 64 + r32], vg1 = vg[c0 + cbw * 64 + 32 + r32];
            f32x16 o[2];
#pragma unroll
            for (int r = 0; r < 16; ++r) { o[0][r] = 0.f; o[1][r] = 0.f; }
            const unsigned vb = (unsigned)(uintptr_t)(L + buf * SP_VBUF + cbw * 16384) + vlane;
            pv_tile(o, vb, __builtin_bit_cast(pg8::bf16x8, pw[0][0]), __builtin_bit_cast(pg8::bf16x8, pw[0][1]), __builtin_bit_cast(pg8::bf16x8, pw[0][2]), __builtin_bit_cast(pg8::bf16x8, pw[0][3]));
            if (njt == 2) pv_tile(o, vb + 8192, __builtin_bit_cast(pg8::bf16x8, pw[1][0]), __builtin_bit_cast(pg8::bf16x8, pw[1][1]), __builtin_bit_cast(pg8::bf16x8, pw[1][2]), __builtin_bit_cast(pg8::bf16x8, pw[1][3]));
#pragma unroll
            for (int r = 0; r < 16; ++r) { LAS bf16* gp = gateT + (32 * ib + crow(r, hi)) * SP_GPITCH + cbw * 64 + r32;
                gp[0] = bf1(o[0][r] * vg0 + bsv[r]); gp[32] = bf1(o[1][r] * vg1 + bsv[r]); }
            LDS_WAIT(); __syncthreads();
#pragma unroll
            for (int k = 0; k < 4; ++k) { const int q = tid + 512 * k; const v4u gt = *(const LAS v4u*)(gateT + (q >> 4) * SP_GPITCH + (q & 15) * 8);
                v4u y;
#pragma unroll
                for (int e = 0; e < 4; ++e) y[e] = pg8::cvt_pk_bf16(bf_lo(uv[k][e]) * bf_lo(gt[e]), bf_hi(uv[k][e]) * bf_hi(gt[e]));
                *(v4u*)(U + (tok0 + (q >> 4)) * SGH + c0 + (q & 15) * 8) = y; }
        }
#undef SP_DMA
        VM_WAIT(); LDS_WAIT(); __syncthreads();
    }
}

struct Args { const float* in[26]; float* out; unsigned char* ws; };
enum { I_X = 0, I_C, I_NORMG, I_ADAW, I_ADAB, I_SBWQKV, I_SBQG, I_SBKG, I_SBWO, I_SGWIN, I_SGVG, I_SGWS, I_SGBS, I_SGWOUT, I_CAWQKV, I_CAQG, I_CAKG, I_CARELB, I_CAWO, I_FFW13, I_FFW2, I_MOEWR, I_MOEBR, I_MOEW1, I_MOEW3, I_MOEW2 };

#ifndef PHMASK
#define PHMASK 0xFFFFFFFFu
#endif
#define PH(k) (((PHMASK) >> (k)) & 1u)
__device__ __forceinline__ const void* karg(int byte_off) { const void* p; asm volatile("s_load_dwordx2 %0, %1, %2\n\ts_waitcnt lgkmcnt(0)" : "=s"(p) : "s"(__builtin_amdgcn_kernarg_segment_ptr()), "i"(byte_off) : "memory"); return p; }
#define KIN(i) (a.in[i])
#define KOUT (a.out)
#define KWS (a.ws)
#ifndef PROBEMASK
#define PROBEMASK 0u
#endif
#if PROBEMASK
#define TS_BEGIN() do { ts_b = __builtin_amdgcn_s_memrealtime(); asm volatile("" ::: "memory"); } while (0)
#define TS_END(k) do { asm volatile("" ::: "memory"); if (((PROBEMASK) >> (k)) & 1u) ts_sum += __builtin_amdgcn_s_memrealtime() - ts_b; } while (0)
#define TS_SPIN() do { if (blockIdx.x == 0 && threadIdx.x == 0) { const unsigned long long t0_ = __builtin_amdgcn_s_memrealtime(); while (__builtin_amdgcn_s_memrealtime() - t0_ < ts_sum) __builtin_amdgcn_s_sleep(8); } } while (0)
#else
#define TS_BEGIN() do {} while (0)
#define TS_END(k) do {} while (0)
#define TS_SPIN() do {} while (0)
#endif
__global__ void __launch_bounds__(NWAVES * 64, 2) fwd_kernel(Args a) {
    extern __shared__ __attribute__((aligned(16))) unsigned char lds[];
    LAS unsigned char* L = (LAS unsigned char*)lds;
    const int G = gridDim.x, bx = blockIdx.x, vcu = (G % 8 == 0) ? (bx % 8) * (G / 8) + bx / 8 : bx;
#define PHASE_IDS int tid = threadIdx.x; asm volatile("" : "+v"(tid)); const int lane = tid & 63, wave = __builtin_amdgcn_readfirstlane(tid >> 6); const int gwi = wave * G + vcu, NGW = G * NWAVES; (void)gwi; (void)NGW; (void)lane
    volatile LAS unsigned* MISC = (volatile LAS unsigned*)(L + MISC_OFF);
    if (threadIdx.x < 64) MISC[threadIdx.x] = 0u;
    __syncthreads();
#define mod ((float*)(KWS + WS_MOD))
#define gains ((float*)(KWS + WS_GAINS))
#define WQKV0 ((bf16*)(KWS + WS_WQKV0))
#define WQKV1 ((bf16*)(KWS + WS_WQKV1))
#define WQKVC ((bf16*)(KWS + WS_WQKVC))
#define WO0 ((bf16*)(KWS + WS_WO0))
#define WO1 ((bf16*)(KWS + WS_WO1))
#define WOC ((bf16*)(KWS + WS_WOC))
#define WIN ((bf16*)(KWS + WS_WIN))
#define WOUT ((bf16*)(KWS + WS_WOUT))
#define W13_0 ((bf16*)(KWS + WS_W13_0))
#define W13_1 ((bf16*)(KWS + WS_W13_1))
#define W2_0 ((bf16*)(KWS + WS_W2_0))
#define W2_1 ((bf16*)(KWS + WS_W2_1))
#define MOE13 ((bf16*)(KWS + WS_MOE13))
#define MOE2 ((bf16*)(KWS + WS_MOE2))
#define MOE2B ((bf16*)(KWS + WS_MOE2B))
#define cscale2b ((float*)(KWS + WS_CS + 476 * 1024))
#define H ((bf16*)(KWS + WS_H))
#define H2 ((bf16*)(KWS + WS_H2))
#define AS ((bf16*)(KWS + WS_AS))
#define YB ((bf16*)(KWS + WS_AS))
#define ACT ((bf16*)(KWS + WS_ACT))
#define Qb ACT
#define Kb (ACT + (size_t)MTOK * D)
#define Vb (ACT + (size_t)2 * MTOK * D)
#define Ub ACT
#define Vg (ACT + (size_t)MTOK * SGH)
#define rowinfo ((int*)(KWS + WS_ROWINFO))
#define troute ((int*)(KWS + WS_TROUTE))
#define tw ((float*)(KWS + WS_TW))
#define vpart ((float*)(KWS + WS_VPART))
#define cscale ((float*)(KWS + WS_CS))
#define cscale_d ((float*)(KWS + WS_CS + 256 * 1024))
#define cscale_q ((float*)(KWS + WS_CS + 320 * 1024))
#define cscale_w ((float*)(KWS + WS_CS + 384 * 1024))
#define cscale_o ((float*)(KWS + WS_CS + 448 * 1024))
#define Y8 ((unsigned char*)(KWS + WS_AS))
#define hscale ((float*)(KWS + WS_HSC))
#define rscale ((float*)(KWS + WS_RS))
#define X ((bf16*)(KWS + WS_XB))
#define x_in (KIN(I_X))
#define normg (KIN(I_NORMG))
#define ctl ((unsigned*)(KWS + WS_CTL))
    XcdBarrier bar = xcd_barrier_post(ctl + CW_BAR, MISC + 8);
#define GRID_BAR() xcd_barrier(bar)
#define PANEL_PUBLISH(S_, site_) if (G == 256) { asm volatile("s_waitcnt vmcnt(0)" ::: "memory"); __syncthreads(); \
        if (threadIdx.x == 0) { __builtin_amdgcn_fence(__ATOMIC_RELEASE, "agent"); asm volatile("s_waitcnt vmcnt(0)" ::: "memory"); \
            for (int i_ = 0; ; ++i_) { pg8::Unit u_; if (!S_.next(i_, u_)) break; __hip_atomic_fetch_add(ctl + CW_PAN + (site_) * 2048 + 16 * u_.pm, 1u, __ATOMIC_RELAXED, __HIP_MEMORY_SCOPE_AGENT); } } }
#define PANEL_SEAM() if (G != 256) GRID_BAR()
#define PANEL_WAIT(site_) if (G == 256) { if (threadIdx.x == 0) { unsigned* p_ = ctl + CW_PAN + (site_) * 2048 + 16 * (vcu >> 1); unsigned n_ = 0; \
            while (xb_ld(p_) < 4u && ++n_ < (1u << 22)) __builtin_amdgcn_s_sleep(1); \
            __builtin_amdgcn_fence(__ATOMIC_ACQUIRE, "agent"); asm volatile("s_waitcnt vmcnt(0)" ::: "memory"); } __syncthreads(); }
#define MOE2_PHASE(cntp_, Bw_, csp_, layer_) { const LAS int* preL_ = (const LAS int*)(L + MISC_OFF + 64); pg8::moe_order_setup((LAS int*)(L + MISC_OFF + 64), cntp_); \
      const int total_ = __builtin_amdgcn_readfirstlane(preL_[8]) * (D / 256), nfull_ = (total_ / G) * G, T_ = total_ - nfull_; \
      const int S_ = T_ == 0 ? 1 : (T_ * 7 <= G ? 7 : (T_ * 2 <= G ? 2 : 1)); \
      pg8::MoeOrderLim S{preL_, D / 256, G, bx, S_ > 1 ? nfull_ : total_}; pg8::Gemm g{ACT, Bw_, 0, 0, DFE / 2, 0}; \
      pg8::EpiMoeOut E{YB, rowinfo, MTOK, csp_}; \
      pg8::gemm_phase<pg8::EpiMoeOut, pg8::MoeOrderLim, true, true, true, false>(L, g, S, E); \
      if (S_ > 1) { pg8::SplitOrder S2{preL_, D / 256, bx, nfull_, T_, S_, DFE / S_}; pg8::Gemm g2{ACT, Bw_, 0, 0, DFE / 2 / S_, DFE / 2}; \
          pg8::EpiMoeSplit E2{E, (float*)H, ctl + CW_SPLIT + (layer_) * 4096, S_}; \
          pg8::gemm_phase<pg8::EpiMoeSplit, pg8::SplitOrder, true, true, true, false>(L, g2, S2, E2); } }
    const float QS = 0.125f * LOG2E;
    unsigned long long ts_b = 0, ts_sum = 0; (void)ts_b; (void)ts_sum;

    TS_BEGIN();
    if (PH(0)) { PHASE_IDS;
        LAS float* cond = (LAS float*)L;
        const float* c = KIN(I_C);
        {   float cv[NB * D / (NWAVES * 64)];
#pragma unroll
            for (int i = 0; i < NB * D / (NWAVES * 64); ++i) cv[i] = c[tid + NWAVES * 64 * i];
#pragma unroll
            for (int i = 0; i < NB * D / (NWAVES * 64); ++i) { const int u = tid + NWAVES * 64 * i, b = u >> 10, k = u & (D - 1); const float v = cv[i]; cond[k * 16 + b] = v / (1.0f + __expf(-v)); } }
        if (bx == 0) for (int gi = tid; gi < 576; gi += NWAVES * 64) { const int set = gi / 192, w = (gi % 192) >> 6, d = gi & 63;
            float v = 1.0f;
            if (w < 2) { const float* src = set == 2 ? (w ? KIN(I_CAKG) : KIN(I_CAQG)) : (w ? KIN(I_SBKG) : KIN(I_SBQG)) + (set == 1 ? HD : 0); v = src[d] * (w ? 1.0f : QS); }
            gains[gi] = v; }
        if (bx == 1) for (int gi = tid; gi < 4 * D; gi += NWAVES * 64) cscale_o[gi] = 1.0f;
        __syncthreads();
        constexpr int C_MOD = 4 * 384, C_QKV = 3 * D / 32, C_WO = 16 * 16, C_WIN = 2 * SGH / 32, C_WOUT = 48 * 16, C_W13 = 2 * DFF / 32, C_W2 = D / 32;
        {
            LAS float* amx = (LAS float*)(L + XTRA_OFF);
            constexpr int WG_TOTAL = 3 * C_QKV + C_WIN + 2 * C_W13 + 2 * NEXP * IT_MOE8;
            int par = 0;
            for (int it = vcu; it < WG_TOTAL; it += G, par ^= 1) {
                int r = it, map = 1, nb = 0, N = 3 * D; const float* W = KIN(I_SBWQKV); unsigned char* dst = (unsigned char*)WQKV0; float* cs = cscale_q;
                if (r < C_QKV) { nb = r; }
                else if ((r -= C_QKV) < C_QKV) { nb = r; W = KIN(I_SBWQKV) + (size_t)D * 3 * D; dst = (unsigned char*)WQKV1; cs = cscale_q + 3 * D; }
                else if ((r -= C_QKV) < C_QKV) { nb = r; W = KIN(I_CAWQKV); dst = (unsigned char*)WQKVC; cs = cscale_q + 6 * D; }
                else if ((r -= C_QKV) < C_WIN) { nb = r; map = 0; N = 2 * SGH; W = KIN(I_SGWIN); dst = (unsigned char*)WIN; cs = cscale_w; }
                else if ((r -= C_WIN) < C_W13) { nb = r; map = 2; N = 2 * DFF; W = KIN(I_FFW13); dst = (unsigned char*)W13_0; cs = cscale_d; }
                else if ((r -= C_W13) < C_W13) { nb = r; map = 2; N = 2 * DFF; W = KIN(I_FFW13) + (size_t)D * 2 * DFF; dst = (unsigned char*)W13_1; cs = cscale_d + 2 * DFF; }
                else if ((r -= C_W13) < NEXP * IT_MOE8) { const int e = r / IT_MOE8; nb = r % IT_MOE8; map = 3; N = DFE; W = KIN(I_MOEW1) + (size_t)e * D * DFE; dst = (unsigned char*)MOE13 + (size_t)e * 2 * DFE * D; cs = cscale + e * 2 * DFE; }
                else { r -= NEXP * IT_MOE8; const int e = r / IT_MOE8; nb = r % IT_MOE8; map = 4; N = DFE; W = KIN(I_MOEW3) + (size_t)e * D * DFE; dst = (unsigned char*)MOE13 + (size_t)e * 2 * DFE * D; cs = cscale + e * 2 * DFE; }
                conv8_wg_item(map, nb, W, N, dst, cs, amx, par, wave, lane);
            }
        }
        __syncthreads();
        {
            LAS float* amx = (LAS float*)(L + XTRA_OFF);
            int par = 0;
            for (int it0 = vcu; it0 < NEXP * IT_MOE2 + ((2 * C_W2 + G - 1) / G) * G; it0 += G, par ^= 1) {
                int it = it0; if (it >= NEXP * IT_MOE2) { const int d = it0 - NEXP * IT_MOE2; it = NEXP * IT_MOE2 + (d % G + G - 64 % G) % G + (d / G) * G; if (it >= NEXP * IT_MOE2 + 2 * C_W2) continue; }
                if (it < NEXP * IT_MOE2) { const int e = it / IT_MOE2; convf8_wg_item<DFE>(it % IT_MOE2, KIN(I_MOEW2) + (size_t)e * DFE * D, D, (unsigned char*)MOE2 + (size_t)e * D * DFE, cscale + NEXP * 2 * DFE + e * D, amx, par, wave, lane); }
                else { const int r = it - NEXP * IT_MOE2, l = r / C_W2; convf8_wg_item<DFF>(r % C_W2, KIN(I_FFW2) + (size_t)l * DFF * D, D, (unsigned char*)W2_0 + (size_t)l * (WS_W2_1 - WS_W2_0), cscale_o + (4 + l) * D, amx, par, wave, lane); }
            }
        }
        constexpr int TOTAL = C_MOD + 3 * C_WO + C_WOUT;
        for (int it = gwi; it < TOTAL; it += NGW) {
            int r = it;
            if (r < C_MOD) { mod_item(r, KIN(I_ADAW), KIN(I_ADAB), mod, cond, lane); continue; } r -= C_MOD;
            if (r < C_WO) { conv_item<0>(r, KIN(I_SBWO), D, D, WO0, lane); continue; } r -= C_WO;
            if (r < C_WO) { conv_item<0>(r, KIN(I_SBWO) + (size_t)D * D, D, D, WO1, lane); continue; } r -= C_WO;
            if (r < C_WO) { conv_item<0>(r, KIN(I_CAWO), D, D, WOC, lane); continue; } r -= C_WO;
            conv_item<0>(r, KIN(I_SGWOUT), SGH, D, WOUT, lane);
        }
    }
    GRID_BAR();
    TS_END(0);

    TS_BEGIN();
    if (PH(1)) { PHASE_IDS; norm_phase<false, true, false, true, false>(x_in, nullptr, H, normg + 0 * D, mod + 0 * MODL, 0, nullptr, nullptr, nullptr, nullptr, nullptr, nullptr, nullptr, nullptr, hscale, L, vcu, G, wave, lane, tid); }
    GRID_BAR();
    TS_END(1);
    TS_BEGIN();
    if (PH(2)) { pg8::Gemm g{H, WQKV0, MTOK, 3 * D, D / 2}; pg8::StaticOrder S; S.init(MTOK, 3 * D, G, bx);
      pg8::EpiQKV E{Qb, gains + 0, hscale, cscale_q};
      pg8::gemm_phase<pg8::EpiQKV, pg8::StaticOrder, true, true, false, true>(L, g, S, E); }
    GRID_BAR();
    TS_END(2);
    TS_BEGIN();
    if (PH(3)) { PHASE_IDS; attn_sb_phase(Qb, Kb, Vb, H, L, vcu, G, wave, lane, tid); }
    GRID_BAR();
    TS_END(3);
    TS_BEGIN();
    if (PH(4)) { pg8::Gemm g{H, WO0, MTOK, D, D}; pg8::StaticOrder S; S.init(MTOK, D, G, bx);
      pg8::EpiResid16<true> E{x_in, X, mod + 0 * MODL + 2 * D, cscale_o};
      pg8::gemm_phase<pg8::EpiResid16<true>, pg8::StaticOrder, true, true>(L, g, S, E); PANEL_PUBLISH(S, 0) }
    PANEL_SEAM();
    TS_END(4);
    TS_BEGIN();
    if (PH(1)) { PHASE_IDS; PANEL_WAIT(0) norm_phase<false, true, false, true>(X, nullptr, H2, normg + 1 * D, mod + 0 * MODL, 3 * D, nullptr, nullptr, nullptr, nullptr, nullptr, nullptr, nullptr, nullptr, hscale, L, vcu, G, wave, lane, tid); }
    GRID_BAR();
    TS_END(1);
    TS_BEGIN();
    if (PH(5)) { pg8::Gemm g{H2, W13_0, MTOK, 2 * DFF, D / 2}; pg8::StaticOrder S; S.init(MTOK, 2 * DFF, G, bx);
      pg8::EpiSwigluQ<true> E{ACT, DFF, 1 << 20, hscale, cscale_d};
      pg8::gemm_phase<pg8::EpiSwigluQ<true>, pg8::StaticOrder, true, true, false, true>(L, g, S, E); }
    GRID_BAR();
    TS_END(5);
    TS_BEGIN();
    if (PH(4)) { pg8::Gemm g{ACT, W2_0, MTOK, D, DFF / 2}; pg8::StaticOrder S; S.init(MTOK, D, G, bx);
      pg8::EpiResid16<false> E{X, X, mod + 0 * MODL + 5 * D, cscale_o + 4 * D};
      pg8::gemm_phase<pg8::EpiResid16<false>, pg8::StaticOrder, true, true, true, false>(L, g, S, E); PANEL_PUBLISH(S, 1) }
    PANEL_SEAM();
    TS_END(4);

    TS_BEGIN();
    if (PH(1)) { PHASE_IDS; PANEL_WAIT(1) norm_phase<false, true, false, true>(X, nullptr, H2, normg + 2 * D, mod + 1 * MODL, 0, nullptr, nullptr, nullptr, nullptr, nullptr, nullptr, nullptr, nullptr, hscale, L, vcu, G, wave, lane, tid); }
    GRID_BAR();
    TS_END(1);
    TS_BEGIN();
    if (PH(6)) { pg8::Gemm g{H2, WIN, MTOK, 2 * SGH, D / 2}; pg8::StaticOrder S; S.init(MTOK, 2 * SGH, G, bx);
      pg8::EpiGeluSG E{Ub, Vg, vpart, hscale, cscale_w};
      pg8::gemm_phase<pg8::EpiGeluSG, pg8::StaticOrder, true, true, false, true>(L, g, S, E); }
    GRID_BAR();
    TS_END(6);
    TS_BEGIN();
    if (PH(7)) { PHASE_IDS; spatial_phase(Ub, Vg, vpart, KIN(I_SGWS), KIN(I_SGBS), KIN(I_SGVG), L, vcu, G, wave, lane, tid); }
    GRID_BAR();
    TS_END(7);
    TS_BEGIN();
    if (PH(4)) { pg8::Gemm g{Ub, WOUT, MTOK, D, SGH}; pg8::StaticOrder S; S.init(MTOK, D, G, bx);
      pg8::EpiResid16<false> E{X, X, mod + 1 * MODL + 2 * D, cscale_o + 3 * D};
      pg8::gemm_phase<pg8::EpiResid16<false>, pg8::StaticOrder, true, true>(L, g, S, E); PANEL_PUBLISH(S, 2) }
    PANEL_SEAM();
    TS_END(4);
    TS_BEGIN();
    if (PH(8)) { PHASE_IDS; PANEL_WAIT(2) norm_phase<false, true, true>(X, nullptr, H2, normg + 3 * D, mod + 1 * MODL, 3 * D, nullptr, nullptr, nullptr, KIN(I_MOEWR), KIN(I_MOEBR), ctl + CW_CNT, troute, tw, hscale, L, vcu, G, wave, lane, tid); }
    GRID_BAR();
    TS_END(8);
    TS_BEGIN();
    if (PH(9)) { PHASE_IDS; gather_phase((const unsigned char*)H2, (unsigned char*)AS, rowinfo, troute, ctl + CW_CNT, hscale, rscale, vcu, G, wave, lane, tid); }
    GRID_BAR();
    TS_END(9);
    TS_BEGIN();
    if (PH(10)) { pg8::moe_order_setup((LAS int*)(L + MISC_OFF + 64), ctl + CW_CNT); pg8::MoeOrder S{(const LAS int*)(L + MISC_OFF + 64), 2 * DFE / 256, G, bx}; pg8::Gemm g{AS, MOE13, 0, 0, D / 2};
      pg8::EpiSwigluQ<true> E{ACT, DFE, 2 * DFE / 256, rscale, cscale};
      pg8::gemm_phase<pg8::EpiSwigluQ<true>, pg8::MoeOrder, true, true, false, true>(L, g, S, E); }
    GRID_BAR();
    TS_END(10);
    TS_BEGIN();
    if (PH(11)) MOE2_PHASE(ctl + CW_CNT, MOE2, cscale + NEXP * 2 * DFE, 0)
    if (PH(0)) { PHASE_IDS;
        LAS float* amx = (LAS float*)(L + XTRA_OFF); volatile LAS int* dealw = (volatile LAS int*)(L + XTRA_OFF + 4096);
        const float* w1 = KIN(I_MOEW1) + (size_t)NEXP * D * DFE; const float* w3 = KIN(I_MOEW3) + (size_t)NEXP * D * DFE; const float* w2 = KIN(I_MOEW2) + (size_t)NEXP * DFE * D;
        int par = 0;
        __syncthreads();
        for (;;) {
            if (tid == 0) dealw[par] = (int)__hip_atomic_fetch_add(ctl + CW_CONV, 1u, __ATOMIC_RELAXED, __HIP_MEMORY_SCOPE_AGENT);
            __syncthreads();
            const int itc = dealw[par];
            if (itc >= IT_MOE) break;
            int r = IT_MOE - 1 - itc;
            if (r < 2 * NEXP * IT_MOE8) { const int hi = r >= NEXP * IT_MOE8; r -= hi ? NEXP * IT_MOE8 : 0; const int e = r / IT_MOE8;
                conv8_wg_item(hi ? 4 : 3, r % IT_MOE8, (hi ? w3 : w1) + (size_t)e * D * DFE, DFE, (unsigned char*)MOE13 + (size_t)e * 2 * DFE * D, cscale + e * 2 * DFE, amx, par, wave, lane); }
            else { r -= 2 * NEXP * IT_MOE8; const int e = r / IT_MOE2; convf8_wg_item<DFE>(r % IT_MOE2, w2 + (size_t)e * DFE * D, D, (unsigned char*)MOE2B + (size_t)e * D * DFE, cscale2b + e * D, amx, par, wave, lane); }
            par ^= 1;
        }
    }
    GRID_BAR();
    TS_END(11);

    TS_BEGIN();
    TS_BEGIN();
    if (PH(12)) { PHASE_IDS; norm_phase<true, true, false, true>(X, X, H, normg + 4 * D, mod + 2 * MODL, 0, mod + 1 * MODL + 5 * D, YB, tw, nullptr, nullptr, nullptr, nullptr, nullptr, hscale, L, vcu, G, wave, lane, tid); }
    GRID_BAR();
    TS_END(12);
    TS_BEGIN();
    if (PH(2)) { pg8::Gemm g{H, WQKVC, MTOK, 3 * D, D / 2}; pg8::StaticOrder S; S.init(MTOK, 3 * D, G, bx);
      pg8::EpiQKV E{Qb, gains + 384, hscale, cscale_q + 6 * D};
      pg8::gemm_phase<pg8::EpiQKV, pg8::StaticOrder, true, true, false, true>(L, g, S, E); }
    GRID_BAR();
    TS_END(2);
    TS_BEGIN();
    if (PH(13)) { PHASE_IDS; attn_phase<1>(Qb, Kb, Vb, H, KIN(I_CARELB), L, vcu, G, wave, lane, tid); }
    GRID_BAR();
    TS_END(13);
    TS_BEGIN();
    if (PH(4)) { pg8::Gemm g{H, WOC, MTOK, D, D}; pg8::StaticOrder S; S.init(MTOK, D, G, bx);
      pg8::EpiResid16<false> E{X, X, mod + 2 * MODL + 2 * D, cscale_o + 2 * D};
      pg8::gemm_phase<pg8::EpiResid16<false>, pg8::StaticOrder, true, true>(L, g, S, E); PANEL_PUBLISH(S, 3) }
    PANEL_SEAM();
    TS_END(4);
    TS_BEGIN();
    if (PH(1)) { PHASE_IDS; PANEL_WAIT(3) norm_phase<false, true, false, true>(X, nullptr, H2, normg + 5 * D, mod + 2 * MODL, 3 * D, nullptr, nullptr, nullptr, nullptr, nullptr, nullptr, nullptr, nullptr, hscale, L, vcu, G, wave, lane, tid); }
    GRID_BAR();
    TS_END(1);
    TS_BEGIN();
    if (PH(5)) { pg8::Gemm g{H2, W13_1, MTOK, 2 * DFF, D / 2}; pg8::StaticOrder S; S.init(MTOK, 2 * DFF, G, bx);
      pg8::EpiSwigluQ<true> E{ACT, DFF, 1 << 20, hscale, cscale_d + 2 * DFF};
      pg8::gemm_phase<pg8::EpiSwigluQ<true>, pg8::StaticOrder, true, true, false, true>(L, g, S, E); }
    GRID_BAR();
    TS_END(5);
    TS_BEGIN();
    if (PH(4)) { pg8::Gemm g{ACT, W2_1, MTOK, D, DFF / 2}; pg8::StaticOrder S; S.init(MTOK, D, G, bx);
      pg8::EpiResid16<false> E{X, X, mod + 2 * MODL + 5 * D, cscale_o + 5 * D};
      pg8::gemm_phase<pg8::EpiResid16<false>, pg8::StaticOrder, true, true, true, false>(L, g, S, E); PANEL_PUBLISH(S, 4) }
    PANEL_SEAM();
    TS_END(4);

    TS_BEGIN();
    if (PH(1)) { PHASE_IDS; PANEL_WAIT(4) norm_phase<false, true, false, true>(X, nullptr, H2, normg + 6 * D, mod + 3 * MODL, 0, nullptr, nullptr, nullptr, nullptr, nullptr, nullptr, nullptr, nullptr, hscale, L, vcu, G, wave, lane, tid); }
    GRID_BAR();
    TS_END(1);
    TS_BEGIN();
    if (PH(2)) { pg8::Gemm g{H2, WQKV1, MTOK, 3 * D, D / 2}; pg8::StaticOrder S; S.init(MTOK, 3 * D, G, bx);
      pg8::EpiQKV E{Qb, gains + 192, hscale, cscale_q + 3 * D};
      pg8::gemm_phase<pg8::EpiQKV, pg8::StaticOrder, true, true, false, true>(L, g, S, E); }
    GRID_BAR();
    TS_END(2);
    TS_BEGIN();
    if (PH(3)) { PHASE_IDS; attn_sb_phase(Qb, Kb, Vb, H, L, vcu, G, wave, lane, tid); }
    GRID_BAR();
    TS_END(3);
    TS_BEGIN();
    if (PH(4)) { pg8::Gemm g{H, WO1, MTOK, D, D}; pg8::StaticOrder S; S.init(MTOK, D, G, bx);
      pg8::EpiResid16<false> E{X, X, mod + 3 * MODL + 2 * D, cscale_o + D};
      pg8::gemm_phase<pg8::EpiResid16<false>, pg8::StaticOrder, true, true>(L, g, S, E); PANEL_PUBLISH(S, 5) }
    PANEL_SEAM();
    TS_END(4);
    TS_BEGIN();
    if (PH(8)) { PHASE_IDS; PANEL_WAIT(5) norm_phase<false, true, true>(X, nullptr, H2, normg + 7 * D, mod + 3 * MODL, 3 * D, nullptr, nullptr, nullptr, KIN(I_MOEWR) + D * NEXP, KIN(I_MOEBR) + NEXP, ctl + CW_CNT + 8 * 64, troute, tw, hscale, L, vcu, G, wave, lane, tid); }
    GRID_BAR();
    TS_END(8);
    TS_BEGIN();
    if (PH(9)) { PHASE_IDS; gather_phase((const unsigned char*)H2, (unsigned char*)AS, rowinfo, troute, ctl + CW_CNT + 8 * 64, hscale, rscale, vcu, G, wave, lane, tid); }
    GRID_BAR();
    TS_END(9);
    TS_BEGIN();
    if (PH(10)) { pg8::moe_order_setup((LAS int*)(L + MISC_OFF + 64), ctl + CW_CNT + 8 * 64); pg8::MoeOrder S{(const LAS int*)(L + MISC_OFF + 64), 2 * DFE / 256, G, bx}; pg8::Gemm g{AS, MOE13, 0, 0, D / 2};
      pg8::EpiSwigluQ<true> E{ACT, DFE, 2 * DFE / 256, rscale, cscale};
      pg8::gemm_phase<pg8::EpiSwigluQ<true>, pg8::MoeOrder, true, true, false, true>(L, g, S, E); }
    GRID_BAR();
    TS_END(10);
    TS_BEGIN();
    if (PH(11)) MOE2_PHASE(ctl + CW_CNT + 8 * 64, MOE2B, cscale2b, 1)
    GRID_BAR();
    TS_END(11);
    TS_BEGIN();
    if (PH(14)) { PHASE_IDS; norm_phase<true, false, false, false, true, false>(X, KOUT, nullptr, nullptr, nullptr, 0, mod + 3 * MODL + 5 * D, YB, tw, nullptr, nullptr, nullptr, nullptr, nullptr, nullptr, L, vcu, G, wave, lane, tid); }
    TS_END(14);
    TS_SPIN();
#undef GRID_BAR
#undef PHASE_IDS
#undef mod
#undef gains
#undef WQKV0
#undef WQKV1
#undef WQKVC
#undef WO0
#undef WO1
#undef WOC
#undef WIN
#undef WOUT
#undef W13_0
#undef W13_1
#undef W2_0
#undef W2_1
#undef MOE13
#undef MOE2
#undef MOE2B
#undef cscale2b
#undef H
#undef AS
#undef YB
#undef ACT
#undef Qb
#undef Kb
#undef Vb
#undef Ub
#undef Vg
#undef rowinfo
#undef troute
#undef tw
#undef vpart
#undef cscale
#undef cscale_d
#undef cscale_q
#undef cscale_w
#undef cscale_o
#undef Y8
#undef hscale
#undef rscale
#undef X
#undef x_in
#undef normg
#undef ctl
}

extern "C" void kernel_launch(void* const* d_in, const int* in_sizes, int n_in, void* d_out, int out_size, void* d_ws, size_t ws_size, hipStream_t stream) {
    static int grid = 0;
    if (grid == 0) {
        if (n_in != 26 || in_sizes[0] != MTOK * D || out_size != MTOK * D || ws_size < WS_END) { fprintf(stderr, "kernel_launch: unexpected shapes (n_in %d, in0 %d, out %d, ws %zu < %zu)\n", n_in, n_in > 0 ? in_sizes[0] : -1, out_size, ws_size, (size_t)WS_END); grid = -1; return; }
        int dev = 0, cus = 0, per_cu = 0;
        if (hipGetDevice(&dev) != hipSuccess || hipDeviceGetAttribute(&cus, hipDeviceAttributeMultiprocessorCount, dev) != hipSuccess) { grid = -1; return; }
        if (hipFuncSetAttribute((const void*)fwd_kernel, hipFuncAttributeMaxDynamicSharedMemorySize, LDS_BYTES) != hipSuccess) { fprintf(stderr, "kernel_launch: hipFuncSetAttribute failed\n"); grid = -1; return; }
        if (hipOccupancyMaxActiveBlocksPerMultiprocessor(&per_cu, (const void*)fwd_kernel, NWAVES * 64, LDS_BYTES) != hipSuccess || per_cu < 1) { fprintf(stderr, "kernel_launch: occupancy query says %d\n", per_cu); }
        (void)hipGetLastError();
        grid = cus;
    }
    if (grid < 0) return;
    if (hipMemsetAsync((char*)d_ws + WS_CTL, 0, CTL_ZERO_BYTES, stream) != hipSuccess) return;
    Args a{};
    for (int i = 0; i < 26; ++i) a.in[i] = (const float*)d_in[i];
    a.out = (float*)d_out; a.ws = (unsigned char*)d_ws;
    hipLaunchKernelGGL(fwd_kernel, dim3(grid), dim3(NWAVES * 64), LDS_BYTES, stream, a);
}
```

```cpp
#include <hip/hip_runtime.h>
#include <cstdio>
#include <cstdint>
namespace pg8 {
#define PG8_LAS __attribute__((address_space(3)))
typedef unsigned short bf16_t;
typedef short bf16x8 __attribute__((ext_vector_type(8)));
typedef float f32x4 __attribute__((ext_vector_type(4)));
typedef unsigned u32x4 __attribute__((ext_vector_type(4)));
constexpr int BM = 256, BK = 64, HALF = 128, HTB = HALF * BK * 2  , STAGE_BYTES = 8 * HTB, NXCD = 8, WGM = 8;

__host__ __device__ __forceinline__ int lds_byte(int r, int c) { const int st = (r >> 4) * 2 + (c >> 5), rr = r & 15, cc = c & 31, ob = rr * 64 + cc * 2; return st * 1024 + (ob ^ (((ob >> 9) & 1) << 5)); }
__host__ __device__ __forceinline__ void stage_rc(int b, int& R, int& C) { const int st = b / 1024, sb = b % 1024, swz = sb ^ (((sb >> 9) & 1) << 5); R = (st >> 1) * 16 + swz / 64; C = (st & 1) * 32 + (swz % 64) / 2; }
__host__ __device__ __forceinline__ int perm32(int rho) { const int n = rho >> 4, i = rho & 15; return 8 * (i >> 2) + 4 * n + (i & 3); }

struct Unit { int pm, pn, ko, aux; };
struct Gemm { const bf16_t* A; const bf16_t* Bt; int M, N, K, Kp; };

struct StaticOrder {
    static constexpr bool SPLITK = false;
    int nM, nN, nwg, G, c;
    __host__ __device__ void init(int M, int N, int G_, int c_) { nM = M / BM; nN = N / BM; nwg = nM * nN; G = G_; c = c_; }
    __host__ __device__ bool next(int i, Unit& u) const {
        const long L = (long)i * G + c; if (L >= nwg) return false;
        int wgid = (int)L; { const int q = nwg / NXCD, r = nwg % NXCD, xcd = wgid % NXCD, off = wgid / NXCD; wgid = (xcd < r ? xcd * (q + 1) : r * (q + 1) + (xcd - r) * q) + off; }
        const int nig = WGM * nN, gid = wgid / nig, fm = gid * WGM, gsz = (nM - fm) < WGM ? (nM - fm) : WGM;
        u.pm = fm + ((wgid % nig) % gsz); u.pn = (wgid % nig) / gsz; return true;
    }
    __device__ __forceinline__ void a_ready(const Unit&) const {}
    __device__ __forceinline__ void done(const Unit&) const {}
};

__device__ __forceinline__ unsigned cvt_pk_bf16(float lo, float hi) { unsigned r; asm volatile("v_cvt_pk_bf16_f32 %0, %1, %2" : "=v"(r) : "v"(lo), "v"(hi)); return r; }
typedef float f32x2 __attribute__((ext_vector_type(2)));
typedef long long pg8_i64x2 __attribute__((ext_vector_type(2)));
__device__ __forceinline__ pg8_i64x2 zero128() { long long z0, z1; asm("v_mov_b64 %0, 0" : "=v"(z0)); asm("v_mov_b64 %0, 0" : "=v"(z1)); return (pg8_i64x2){z0, z1}; }
typedef int i32x4 __attribute__((ext_vector_type(4)));
typedef int i32x8 __attribute__((ext_vector_type(8)));
template <class Epi, class Sched, bool ALIGN_EPI = false, bool SP2 = false, bool F8 = false, bool I8 = false>
__device__ __forceinline__ void gemm_phase(PG8_LAS unsigned char* lds, const Gemm g, const Sched& S, const Epi& E) {
    int tid = threadIdx.x; asm volatile("" : "+v"(tid));
    const int wid = __builtin_amdgcn_readfirstlane(tid >> 6), lane = tid & 63, wr = wid >> 2, wc = wid & 3, fr = lane & 15, fq = lane >> 4;
    const int nt = g.K / BK, K = Sched::SPLITK ? g.Kp : g.K;
    unsigned voffA[2], voffB[2];
#pragma unroll
    for (int i = 0; i < 2; ++i) { int R, C; stage_rc(tid * 16 + i * 8192, R, C); const int Rb = Epi::PERM ? ((R & ~31) + perm32(R & 31)) : R;
        voffA[i] = (unsigned)(R * K + C) * 2u; voffB[i] = (unsigned)(Rb * K + C) * 2u; }
    const size_t kstep = (size_t)(BK * 2);
    const size_t hstep = (size_t)HALF * K * 2;
    const size_t tstep = 2 * hstep;
    const unsigned ldsw = (unsigned)wid * 1024u;
    const int aoff = lds_byte(wr * 64 + fr, fq * 8), boff = lds_byte(wc * 32 + fr, fq * 8);
#define PG8_SA(b, h) (((b) * 2 + (h)) * HTB)
#define PG8_SB(b, h) ((4 + (b) * 2 + (h)) * HTB)
#define PG8_STAGE(bufoff, gbase, voff) do { _Pragma("unroll") for (int _i = 0; _i < 2; ++_i) \
        __builtin_amdgcn_global_load_lds((const unsigned*)((const char*)(gbase) + (voff)[_i]), (PG8_LAS unsigned*)(lds + (bufoff) + ldsw + _i * 8192), 16, 0, 0); } while (0)
#define PG8_LDA(dst, b, h) do { if constexpr (F8) { _Pragma("unroll") for (int m = 0; m < 4; ++m) dst##8[m] = __builtin_shufflevector(*(const PG8_LAS i32x4*)(lds + PG8_SA(b, h) + aoff + m * 2048), *(const PG8_LAS i32x4*)(lds + PG8_SA(b, h) + aoff + m * 2048 + 1024), 0, 1, 2, 3, 4, 5, 6, 7); } \
        else { _Pragma("unroll") for (int m = 0; m < 4; ++m) _Pragma("unroll") for (int k = 0; k < 2; ++k) dst[m][k] = *(const PG8_LAS bf16x8*)(lds + PG8_SA(b, h) + aoff + m * 2048 + k * 1024); } } while (0)
#define PG8_LDB(dst, b, h) do { if constexpr (F8) { _Pragma("unroll") for (int n = 0; n < 2; ++n) dst##8[n] = __builtin_shufflevector(*(const PG8_LAS i32x4*)(lds + PG8_SB(b, h) + boff + n * 2048), *(const PG8_LAS i32x4*)(lds + PG8_SB(b, h) + boff + n * 2048 + 1024), 0, 1, 2, 3, 4, 5, 6, 7); } \
        else { _Pragma("unroll") for (int n = 0; n < 2; ++n) _Pragma("unroll") for (int k = 0; k < 2; ++k) dst[n][k] = *(const PG8_LAS bf16x8*)(lds + PG8_SB(b, h) + boff + n * 2048 + k * 1024); } } while (0)
#define PG8_MMA(ai, bj, At, Bt) do { __builtin_amdgcn_s_setprio(1); _Pragma("unroll") for (int m = 0; m < 4; ++m) _Pragma("unroll") for (int n = 0; n < 2; ++n) { \
        if constexpr (F8) { f32x4 c_; _Pragma("unroll") for (int j_ = 0; j_ < 4; ++j_) c_[j_] = accv[ai][bj][m >> 1][4 * ((m & 1) * 2 + n) + j_]; \
            c_ = __builtin_amdgcn_mfma_scale_f32_16x16x128_f8f6f4(Bt##8[n], At##8[m], c_, 0, 0, 0, 0x7F7F7F7F, 0, 0x7F7F7F7F); \
            _Pragma("unroll") for (int j_ = 0; j_ < 4; ++j_) accv[ai][bj][m >> 1][4 * ((m & 1) * 2 + n) + j_] = c_[j_]; } \
        else if constexpr (I8) { _Pragma("unroll") for (int k = 0; k < 2; ++k) acci[ai][bj][m][n] = __builtin_amdgcn_mfma_i32_16x16x64_i8(__builtin_bit_cast(i32x4, Bt[n][k]), __builtin_bit_cast(i32x4, At[m][k]), acci[ai][bj][m][n], 0, 0, 0); } \
        else { _Pragma("unroll") for (int k = 0; k < 2; ++k) acc[ai][bj][m][n] = __builtin_amdgcn_mfma_f32_16x16x32_bf16(Bt[n][k], At[m][k], acc[ai][bj][m][n], 0, 0, 0); } } \
        __builtin_amdgcn_s_setprio(0); } while (0)
#define PG8_WAIT_V(n) asm volatile("s_waitcnt vmcnt(" #n ")" ::: "memory")
#define PG8_WAIT_L(n) asm volatile("s_waitcnt lgkmcnt(" #n ")" ::: "memory")
#define PG8_BAR __builtin_amdgcn_s_barrier()
#define PG8_SCHED __builtin_amdgcn_sched_barrier(0)
    Unit cur, nxt; int ui = 0;
    if (!S.next(0, cur)) return;
    f32x4 acc[2][2][4][2];
    i32x4 acci[2][2][4][2];
#pragma unroll
    for (int a = 0; a < 2; ++a)
#pragma unroll
        for (int b = 0; b < 2; ++b)
#pragma unroll
            for (int m = 0; m < 4; ++m)
#pragma unroll
                for (int n = 0; n < 2; ++n) acci[a][b][m][n] = (i32x4){0, 0, 0, 0};
    typedef float f32x16v __attribute__((ext_vector_type(16)));
    f32x16v accv[2][2][2];
#pragma unroll
    for (int a = 0; a < 2; ++a)
#pragma unroll
        for (int b = 0; b < 2; ++b)
#pragma unroll
            for (int q = 0; q < 2; ++q)
#pragma unroll
                for (int j = 0; j < 16; ++j) accv[a][b][q][j] = 0.f;
#pragma unroll
    for (int a = 0; a < 2; ++a)
#pragma unroll
        for (int b = 0; b < 2; ++b)
#pragma unroll
            for (int m = 0; m < 4; ++m)
#pragma unroll
                for (int n = 0; n < 2; ++n) acc[a][b][m][n] = (f32x4){0.f, 0.f, 0.f, 0.f};
    bf16x8 At[4][2], B0[2][2], B1[2][2]; i32x8 At8[4], B08[2], B18[2]; (void)At; (void)B0; (void)B1; (void)At8; (void)B08; (void)B18;
    const char* cA = (const char*)g.A + (size_t)cur.pm * tstep; const char* cB = (const char*)g.Bt + (size_t)cur.pn * tstep;
    if constexpr (Sched::SPLITK) { cA += cur.ko; cB += cur.ko; }
    S.a_ready(cur);
    if constexpr (SP2) {
        PG8_STAGE(PG8_SB(0, 0), cB, voffB); PG8_STAGE(PG8_SB(0, 1), cB + hstep, voffB); PG8_STAGE(PG8_SA(0, 0), cA, voffA); PG8_STAGE(PG8_SA(0, 1), cA + hstep, voffA);
        if (wr == 1) PG8_BAR;
        PG8_WAIT_V(2); PG8_BAR;
        PG8_STAGE(PG8_SB(1, 0), cB + kstep, voffB); PG8_STAGE(PG8_SA(1, 0), cA + kstep, voffA); PG8_STAGE(PG8_SB(1, 1), cB + hstep + kstep, voffB);
        PG8_WAIT_V(6); PG8_BAR;
    } else {
        PG8_STAGE(PG8_SB(0, 0), cB, voffB); PG8_STAGE(PG8_SA(0, 0), cA, voffA); PG8_STAGE(PG8_SB(0, 1), cB + hstep, voffB); PG8_STAGE(PG8_SA(0, 1), cA + hstep, voffA);
        if (wr == 1) PG8_BAR;
        PG8_WAIT_V(4); PG8_BAR;
        PG8_STAGE(PG8_SB(1, 0), cB + kstep, voffB); PG8_STAGE(PG8_SA(1, 0), cA + kstep, voffA); PG8_STAGE(PG8_SB(1, 1), cB + hstep + kstep, voffB);
        PG8_WAIT_V(6); PG8_BAR;
    }
    for (;;) {
        const bool has_next = S.next(ui + 1, nxt);
        const char* nA = has_next ? (const char*)g.A + (size_t)nxt.pm * tstep + (Sched::SPLITK ? nxt.ko : 0) : cA; const char* nB = has_next ? (const char*)g.Bt + (size_t)nxt.pn * tstep + (Sched::SPLITK ? nxt.ko : 0) : cB;
#pragma nounroll
        for (int t = 0; t < nt; t += 2) {
            const bool last = (t == nt - 2);
            const char* a1 = cA + (size_t)(t + 1) * kstep;
            const char* a2 = last ? nA : cA + (size_t)(t + 2) * kstep; const char* b2 = last ? nB : cB + (size_t)(t + 2) * kstep;
            const char* a3 = a2 + kstep; const char* b3 = b2 + kstep;
            if (last && has_next) S.a_ready(nxt);
            if constexpr (SP2) {
            PG8_LDB(B0, 0, 0); PG8_LDB(B1, 0, 1); PG8_SCHED; PG8_LDA(At, 0, 0); PG8_STAGE(PG8_SA(1, 1), a1 + hstep, voffA);
            PG8_WAIT_V(8); PG8_WAIT_L(0); PG8_BAR; PG8_MMA(0, 0, At, B0); PG8_MMA(0, 1, At, B1); PG8_BAR; PG8_SCHED;
            PG8_LDA(At, 0, 1); PG8_STAGE(PG8_SB(0, 0), b2, voffB); PG8_STAGE(PG8_SB(0, 1), b2 + hstep, voffB); PG8_STAGE(PG8_SA(0, 0), a2, voffA);
            PG8_WAIT_V(8); PG8_WAIT_L(0); PG8_BAR; PG8_MMA(1, 0, At, B0); PG8_MMA(1, 1, At, B1); PG8_BAR; PG8_SCHED;
            PG8_LDB(B0, 1, 0); PG8_LDB(B1, 1, 1); PG8_SCHED; PG8_LDA(At, 1, 0); PG8_STAGE(PG8_SA(0, 1), a2 + hstep, voffA);
            PG8_WAIT_V(8); PG8_WAIT_L(0); PG8_BAR; PG8_MMA(0, 0, At, B0); PG8_MMA(0, 1, At, B1); PG8_BAR; PG8_SCHED;
            PG8_LDA(At, 1, 1); PG8_STAGE(PG8_SB(1, 0), b3, voffB); PG8_STAGE(PG8_SB(1, 1), b3 + hstep, voffB); PG8_STAGE(PG8_SA(1, 0), a3, voffA);
            PG8_WAIT_V(8); PG8_WAIT_L(0); PG8_BAR; PG8_MMA(1, 0, At, B0); PG8_MMA(1, 1, At, B1); PG8_BAR; PG8_SCHED;
            } else {
            PG8_LDB(B0, 0, 0); PG8_SCHED; PG8_LDA(At, 0, 0); PG8_STAGE(PG8_SA(1, 1), a1 + hstep, voffA);
            PG8_WAIT_L(8); PG8_BAR; PG8_WAIT_L(0); PG8_MMA(0, 0, At, B0); PG8_BAR; PG8_SCHED;
            PG8_LDB(B1, 0, 1); PG8_STAGE(PG8_SB(0, 0), b2, voffB);
            PG8_BAR; PG8_WAIT_L(0); PG8_MMA(0, 1, At, B1); PG8_BAR;
            PG8_LDA(At, 0, 1); PG8_STAGE(PG8_SA(0, 0), a2, voffA);
            PG8_BAR; PG8_WAIT_L(0); PG8_MMA(1, 0, At, B0); PG8_BAR; PG8_SCHED;
            PG8_STAGE(PG8_SB(0, 1), b2 + hstep, voffB);
            PG8_WAIT_V(6); PG8_BAR; PG8_MMA(1, 1, At, B1); PG8_BAR;
            PG8_LDB(B0, 1, 0); PG8_SCHED; PG8_LDA(At, 1, 0); PG8_STAGE(PG8_SA(0, 1), a2 + hstep, voffA);
            PG8_WAIT_L(8); PG8_BAR; PG8_WAIT_L(0); PG8_MMA(0, 0, At, B0); PG8_BAR; PG8_SCHED;
            PG8_LDB(B1, 1, 1); PG8_STAGE(PG8_SB(1, 0), b3, voffB);
            PG8_BAR; PG8_WAIT_L(0); PG8_MMA(0, 1, At, B1); PG8_BAR;
            PG8_LDA(At, 1, 1); PG8_STAGE(PG8_SA(1, 0), a3, voffA);
            PG8_BAR; PG8_WAIT_L(0); PG8_MMA(1, 0, At, B0); PG8_BAR; PG8_SCHED;
            PG8_STAGE(PG8_SB(1, 1), b3 + hstep, voffB);
            PG8_WAIT_V(6); PG8_BAR; PG8_MMA(1, 1, At, B1); PG8_BAR;
            }
        }
        if constexpr (ALIGN_EPI) { if (wr == 0) PG8_BAR; }
        if constexpr (F8) {
#pragma unroll
            for (int a = 0; a < 2; ++a)
#pragma unroll
                for (int b = 0; b < 2; ++b)
#pragma unroll
                    for (int m = 0; m < 4; ++m)
#pragma unroll
                        for (int n = 0; n < 2; ++n)
#pragma unroll
                            for (int j = 0; j < 4; ++j) { acc[a][b][m][n][j] = accv[a][b][m >> 1][4 * ((m & 1) * 2 + n) + j]; accv[a][b][m >> 1][4 * ((m & 1) * 2 + n) + j] = 0.f; } }
        if constexpr (I8) {
#pragma unroll
            for (int a = 0; a < 2; ++a)
#pragma unroll
                for (int b = 0; b < 2; ++b)
#pragma unroll
                    for (int m = 0; m < 4; ++m)
#pragma unroll
                        for (int n = 0; n < 2; ++n) { acc[a][b][m][n] = __builtin_convertvector(acci[a][b][m][n], f32x4); acci[a][b][m][n] = __builtin_bit_cast(i32x4, zero128()); } }
        if constexpr (!Epi::AFTER_DRAIN) { int tid2 = threadIdx.x; asm volatile("" : "+v"(tid2));
            E(acc, cur, wr, wc, tid2 & 15, (tid2 & 63) >> 4); S.done(cur); }
        if (!has_next) break;
#pragma unroll
        for (int a = 0; a < 2; ++a)
#pragma unroll
            for (int b = 0; b < 2; ++b)
#pragma unroll
                for (int m = 0; m < 4; ++m)
#pragma unroll
                    for (int n = 0; n < 2; ++n) acc[a][b][m][n] = __builtin_bit_cast(f32x4, zero128());
        cur = nxt; cA = nA; cB = nB; ++ui;
        if constexpr (ALIGN_EPI) { if (wr == 1) PG8_BAR; }
    }
    PG8_WAIT_V(0);
    if constexpr (!ALIGN_EPI) { if (wr == 0) PG8_BAR; }
    PG8_BAR;
    if constexpr (Epi::AFTER_DRAIN) { E.fused(acc, cur, wr, wc, fr, fq, lds, wid, lane); S.done(cur); }
#undef PG8_SA
#undef PG8_SB
#undef PG8_STAGE
#undef PG8_LDA
#undef PG8_LDB
#undef PG8_MMA
#undef PG8_WAIT_V
#undef PG8_WAIT_L
#undef PG8_BAR
#undef PG8_SCHED
}
}
namespace pg8 {
__device__ __forceinline__ float ex2(float x) { return __builtin_amdgcn_exp2f(x); }
__device__ __forceinline__ float rcp(float x) { return __builtin_amdgcn_rcpf(x); }
__device__ __forceinline__ float silu_f(float a) { return a * rcp(1.0f + ex2(a * -1.4426950408889634f)); }
__device__ __forceinline__ float gelu_t(float x) { const float w = __builtin_fmaf(x * x, 0.044715f * -2.3022081981405e+00f, -2.3022081981405e+00f); return x * rcp(1.0f + ex2(x * w)); }
__device__ __forceinline__ u32x4 pack8(const f32x4 a, const f32x4 b) { u32x4 w; w.x = cvt_pk_bf16(a[0], a[1]); w.y = cvt_pk_bf16(a[2], a[3]); w.z = cvt_pk_bf16(b[0], b[1]); w.w = cvt_pk_bf16(b[2], b[3]); return w; }

struct EpiQKV {
    static constexpr bool PERM = true, AFTER_DRAIN = false;
    bf16_t* QKV; const float* gains; const float* rs; const float* cs;
    __device__ __forceinline__ void operator()(const f32x4 (&acc)[2][2][4][2], const Unit& u, int wr, int wc, int fr, int fq) const {
        const int t = u.pn >> 2, head = (u.pn & 3) * 4 + wc;
        bf16_t* base = QKV + (size_t)t * ((size_t)32768 * 1024);
        const int row0 = u.pm * BM + wr * 64 + fr, col0 = head * 64 + 8 * fq;
        f32x4 gv[2][2], cv[2][2];
        const float* g = gains + 64 * t; const float* cp = cs + (size_t)u.pn * BM + wc * 32 + 8 * fq;
#pragma unroll
        for (int bj = 0; bj < 2; ++bj)
#pragma unroll
            for (int n = 0; n < 2; ++n) { gv[bj][n] = *(const f32x4*)(g + 32 * bj + 8 * fq + 4 * n); cv[bj][n] = *(const f32x4*)(cp + bj * HALF + 4 * n); }
#pragma unroll
        for (int ai = 0; ai < 2; ++ai)
#pragma unroll
            for (int m = 0; m < 4; ++m) { const int row = row0 + ai * HALF + m * 16; const float rsc = rs[row];
                f32x4 x[2][2]; float ss = 0.f;
#pragma unroll
                for (int bj = 0; bj < 2; ++bj)
#pragma unroll
                    for (int n = 0; n < 2; ++n) { x[bj][n] = acc[ai][bj][m][n] * cv[bj][n]; const f32x4 v = x[bj][n]; ss = __builtin_fmaf(v[0], v[0], __builtin_fmaf(v[1], v[1], __builtin_fmaf(v[2], v[2], __builtin_fmaf(v[3], v[3], ss)))); }
                ss += __shfl_xor(ss, 16); ss += __shfl_xor(ss, 32);
                const float r = rsc * (t < 2 ? __builtin_amdgcn_rsqf(ss * rsc * rsc * (1.0f / 64.0f) + 1e-6f) : 1.0f);
                bf16_t* rowp = base + (size_t)row * 1024 + col0;
#pragma unroll
                for (int bj = 0; bj < 2; ++bj) *(u32x4*)(rowp + 32 * bj) = pack8(x[bj][0] * (gv[bj][0] * r), x[bj][1] * (gv[bj][1] * r));
            }
    }
};
struct EpiSwiglu {
    static constexpr bool PERM = true, AFTER_DRAIN = false;
    bf16_t* O; int ldc; int ntl;
    __device__ __forceinline__ void operator()(const f32x4 (&acc)[2][2][4][2], const Unit& u, int wr, int wc, int fr, int fq) const {
        const int pnl = u.pn % ntl; const int row0 = u.pm * BM + wr * 64 + fr, col0 = pnl * 128 + wc * 32 + 8 * fq;
#pragma unroll
        for (int ai = 0; ai < 2; ++ai)
#pragma unroll
            for (int m = 0; m < 4; ++m) { bf16_t* rowp = O + (size_t)(row0 + ai * HALF + m * 16) * ldc + col0;
                f32x4 o0, o1;
#pragma unroll
                for (int j = 0; j < 4; ++j) { o0[j] = silu_f(acc[ai][0][m][0][j]) * acc[ai][1][m][0][j]; o1[j] = silu_f(acc[ai][0][m][1][j]) * acc[ai][1][m][1][j]; }
                *(u32x4*)rowp = pack8(o0, o1); }
    }
};
template <bool OUT8 = false> struct EpiSwigluQ {
    static constexpr bool PERM = true, AFTER_DRAIN = false;
    bf16_t* O; int ldc; int ntl; const float* rs; const float* cs;
    __device__ __forceinline__ void operator()(const f32x4 (&acc)[2][2][4][2], const Unit& u, int wr, int wc, int fr, int fq) const {
        const int pnl = u.pn % ntl; const int row0 = u.pm * BM + wr * 64 + fr, col0 = pnl * 128 + wc * 32 + 8 * fq;
        const float* cp = cs + (size_t)u.pn * BM + wc * 32 + 8 * fq;
        const float osc = OUT8 ? 8.0f : 1.0f;
        const f32x4 ca0 = *(const f32x4*)(cp), ca1 = *(const f32x4*)(cp + 4), cg0 = *(const f32x4*)(cp + HALF) * osc, cg1 = *(const f32x4*)(cp + HALF + 4) * osc;
#pragma unroll
        for (int ai = 0; ai < 2; ++ai)
#pragma unroll
            for (int m = 0; m < 4; ++m) { const int row = row0 + ai * HALF + m * 16; const float r = rs[row], rl = r * -1.4426950408889634f, r2 = r * r;
                f32x4 o0, o1;
#pragma unroll
                for (int n = 0; n < 2; ++n) { const f32x4 ca = n ? ca1 : ca0, cg = n ? cg1 : cg0;
#pragma unroll
                    for (int jp = 0; jp < 2; ++jp) { const f32x2 A = (f32x2){acc[ai][0][m][n][2 * jp], acc[ai][0][m][n][2 * jp + 1]} * (f32x2){ca[2 * jp], ca[2 * jp + 1]};
                        const f32x2 Gv = (f32x2){acc[ai][1][m][n][2 * jp], acc[ai][1][m][n][2 * jp + 1]} * (f32x2){cg[2 * jp], cg[2 * jp + 1]};
                        const f32x2 tt = A * rl; f32x2 ev; ev.x = ex2(tt.x); ev.y = ex2(tt.y);
                        const f32x2 dv = ev + 1.0f; f32x2 qv; qv.x = rcp(dv.x); qv.y = rcp(dv.y);
                        const f32x2 ov = (A * Gv) * (qv * r2);
                        if (n == 0) { o0[2 * jp] = ov.x; o0[2 * jp + 1] = ov.y; } else { o1[2 * jp] = ov.x; o1[2 * jp + 1] = ov.y; } } }
                if constexpr (OUT8) {
#pragma unroll
                    for (int j = 0; j < 4; ++j) { o0[j] = __builtin_amdgcn_fmed3f(o0[j], -440.0f, 440.0f); o1[j] = __builtin_amdgcn_fmed3f(o1[j], -440.0f, 440.0f); }
                    int w0 = 0, w1 = 0; w0 = __builtin_amdgcn_cvt_pk_fp8_f32(o0[0], o0[1], w0, false); w0 = __builtin_amdgcn_cvt_pk_fp8_f32(o0[2], o0[3], w0, true);
                    w1 = __builtin_amdgcn_cvt_pk_fp8_f32(o1[0], o1[1], w1, false); w1 = __builtin_amdgcn_cvt_pk_fp8_f32(o1[2], o1[3], w1, true);
                    typedef int i32x2v __attribute__((ext_vector_type(2)));
                    *(i32x2v*)((unsigned char*)O + (size_t)row * ldc + col0) = (i32x2v){w0, w1};
                } else { bf16_t* rowp = O + (size_t)row * ldc + col0; *(u32x4*)rowp = pack8(o0, o1); } }
    }
};
typedef EpiSwigluQ<false> EpiSwigluF8;
struct EpiGeluSG {
    static constexpr bool PERM = true, AFTER_DRAIN = false;
    bf16_t* U; bf16_t* V; float* vpart; const float* rs; const float* cs;
    __device__ __forceinline__ void operator()(const f32x4 (&acc)[2][2][4][2], const Unit& u, int wr, int wc, int fr, int fq) const {
        const bool isv = u.pn >= 12; const int pnl = isv ? u.pn - 12 : u.pn; bf16_t* base = isv ? V : U;
        const int row0 = u.pm * BM + wr * 64 + fr, col0 = pnl * BM + wc * 32 + 8 * fq;
        const float* cp = cs + (size_t)u.pn * BM + wc * 32 + 8 * fq;
        f32x4 cv[2][2];
#pragma unroll
        for (int bj = 0; bj < 2; ++bj)
#pragma unroll
            for (int n = 0; n < 2; ++n) cv[bj][n] = *(const f32x4*)(cp + bj * HALF + 4 * n);
#pragma unroll
        for (int ai = 0; ai < 2; ++ai)
#pragma unroll
            for (int m = 0; m < 4; ++m) { const int row = row0 + ai * HALF + m * 16; const float rsc = rs[row]; bf16_t* rowp = base + (size_t)row * 3072 + col0; float ss = 0.f; f32x2 ss2 = (f32x2){0.f, 0.f};
#pragma unroll
                for (int bj = 0; bj < 2; ++bj) { f32x4 z0, z1; const f32x4 s0 = cv[bj][0] * rsc, s1 = cv[bj][1] * rsc;
#pragma unroll
                    for (int n = 0; n < 2; ++n) { const f32x4 sv = n ? s1 : s0;
#pragma unroll
                        for (int jp = 0; jp < 2; ++jp) {
                            const f32x2 x = (f32x2){acc[ai][bj][m][n][2 * jp], acc[ai][bj][m][n][2 * jp + 1]} * (f32x2){sv[2 * jp], sv[2 * jp + 1]};
                            const f32x2 w = (x * x) * (0.044715f * -2.3022081981405e+00f) + (-2.3022081981405e+00f), tt = x * w;
                            f32x2 ev; ev.x = ex2(tt.x); ev.y = ex2(tt.y); const f32x2 dv = ev + 1.0f; f32x2 qv; qv.x = rcp(dv.x); qv.y = rcp(dv.y);
                            const f32x2 z = x * qv; ss2 = z * z + ss2;
                            if (n == 0) { z0[2 * jp] = z.x; z0[2 * jp + 1] = z.y; } else { z1[2 * jp] = z.x; z1[2 * jp + 1] = z.y; } } }
                    *(u32x4*)(rowp + bj * HALF) = pack8(z0, z1); }
                ss = ss2.x + ss2.y;
                if (isv) { ss += __shfl_xor(ss, 16); ss += __shfl_xor(ss, 32); if (fq == 0) vpart[(size_t)row * 48 + pnl * 4 + wc] = ss; } }
    }
};
struct EpiResid {
    static constexpr bool PERM = false, AFTER_DRAIN = false;
    const float* xin; float* out; const float* gate; const float* cs;
    __device__ __forceinline__ void operator()(const f32x4 (&acc)[2][2][4][2], const Unit& u, int wr, int wc, int fr, int fq) const {
        const float* gp = gate + (size_t)(u.pm >> 3) * 6144;
        const int row0 = u.pm * BM + wr * 64 + fr, col0 = u.pn * BM + wc * 32 + 4 * fq;
        f32x4 gv[2][2];
#pragma unroll
        for (int bj = 0; bj < 2; ++bj)
#pragma unroll
            for (int n = 0; n < 2; ++n) gv[bj][n] = *(const f32x4*)(gp + col0 + bj * HALF + n * 16) * *(const f32x4*)(cs + col0 + bj * HALF + n * 16);
#pragma unroll
        for (int ai = 0; ai < 2; ++ai)
#pragma unroll
            for (int m = 0; m < 4; ++m) { const size_t off = (size_t)(row0 + ai * HALF + m * 16) * 1024 + col0;
#pragma unroll
                for (int bj = 0; bj < 2; ++bj)
#pragma unroll
                    for (int n = 0; n < 2; ++n) { const f32x4 xv = *(const f32x4*)(xin + off + bj * HALF + n * 16); *(f32x4*)(out + off + bj * HALF + n * 16) = xv + gv[bj][n] * acc[ai][bj][m][n]; } }
    }
};
template <bool XIN32> struct EpiResid16 {
    static constexpr bool PERM = true, AFTER_DRAIN = false;
    const void* xin; bf16_t* out; const float* gate; const float* cs;
    __device__ __forceinline__ void operator()(const f32x4 (&acc)[2][2][4][2], const Unit& u, int wr, int wc, int fr, int fq) const {
        const float* gp = gate + (size_t)(u.pm >> 3) * 6144;
        const int row0 = u.pm * BM + wr * 64 + fr, col0 = u.pn * BM + wc * 32 + 8 * fq;
        f32x4 gv[2][2];
#pragma unroll
        for (int bj = 0; bj < 2; ++bj)
#pragma unroll
            for (int n = 0; n < 2; ++n) gv[bj][n] = *(const f32x4*)(gp + col0 + bj * HALF + 4 * n) * *(const f32x4*)(cs + col0 + bj * HALF + 4 * n);
#pragma unroll
        for (int ai = 0; ai < 2; ++ai)
#pragma unroll
            for (int m = 0; m < 4; ++m) { const size_t off = (size_t)(row0 + ai * HALF + m * 16) * 1024 + col0;
#pragma unroll
                for (int bj = 0; bj < 2; ++bj) { f32x4 x0, x1;
                    if constexpr (XIN32) { x0 = *(const f32x4*)((const float*)xin + off + bj * HALF); x1 = *(const f32x4*)((const float*)xin + off + bj * HALF + 4); }
                    else { const u32x4 w = *(const u32x4*)((const bf16_t*)xin + off + bj * HALF);
                        x0 = (f32x4){__uint_as_float(w.x << 16), __uint_as_float(w.x & 0xffff0000u), __uint_as_float(w.y << 16), __uint_as_float(w.y & 0xffff0000u)};
                        x1 = (f32x4){__uint_as_float(w.z << 16), __uint_as_float(w.z & 0xffff0000u), __uint_as_float(w.w << 16), __uint_as_float(w.w & 0xffff0000u)}; }
                    *(u32x4*)(out + off + bj * HALF) = pack8(x0 + gv[bj][0] * acc[ai][bj][m][0], x1 + gv[bj][1] * acc[ai][bj][m][1]); } }
    }
};
struct EpiMoeOut {
    static constexpr bool PERM = true, AFTER_DRAIN = false;
    bf16_t* Y; const int* rowinfo; int mtok; const float* cs;
    __device__ __forceinline__ void operator()(const f32x4 (&acc)[2][2][4][2], const Unit& u, int wr, int wc, int fr, int fq) const {
        const int row0 = u.pm * BM + wr * 64 + fr, col0 = (u.pn & 3) * BM + wc * 32 + 8 * fq;
        const float* cp = cs + (size_t)u.pn * BM + wc * 32 + 8 * fq;
#pragma unroll
        for (int ai = 0; ai < 2; ++ai)
#pragma unroll
            for (int m = 0; m < 4; ++m) { const int ti = rowinfo[row0 + ai * HALF + m * 16];
                if (ti >= 0) { bf16_t* rowp = Y + ((size_t)(ti & 1) * mtok + (ti >> 1)) * 1024 + col0;
#pragma unroll
                    for (int bj = 0; bj < 2; ++bj) { const f32x4 c0 = *(const f32x4*)(cp + bj * HALF), c1 = *(const f32x4*)(cp + bj * HALF + 4);
                        *(u32x4*)(rowp + bj * HALF) = pack8(acc[ai][bj][m][0] * c0, acc[ai][bj][m][1] * c1); } } }
    }
};
struct MoeOrder {
    static constexpr bool SPLITK = false;
    const PG8_LAS int* pre; int ntl, G, c;
    __device__ __forceinline__ bool next(int i, Unit& u) const {
        StaticOrder so; so.init(__builtin_amdgcn_readfirstlane(pre[8]) * BM, ntl * BM, G, c);
        if (!so.next(i, u)) return false;
        int e = 0;
#pragma unroll
        for (int k = 1; k < 8; ++k) e += (u.pm >= pre[k]) ? 1 : 0;
        u.pn += e * ntl; return true;
    }
    __device__ __forceinline__ void a_ready(const Unit&) const {}
    __device__ __forceinline__ void done(const Unit&) const {}
};
struct MoeOrderLim {
    static constexpr bool SPLITK = false;
    const PG8_LAS int* pre; int ntl, G, c, lim;
    __device__ __forceinline__ bool next(int i, Unit& u) const {
        if (i * G + c >= lim) return false;
        StaticOrder so; so.init(__builtin_amdgcn_readfirstlane(pre[8]) * BM, ntl * BM, G, c);
        if (!so.next(i, u)) return false;
        int e = 0;
#pragma unroll
        for (int k = 1; k < 8; ++k) e += (u.pm >= pre[k]) ? 1 : 0;
        u.pn += e * ntl; return true;
    }
    __device__ __forceinline__ void a_ready(const Unit&) const {}
    __device__ __forceinline__ void done(const Unit&) const {}
};
struct SplitOrder {
    static constexpr bool SPLITK = true;
    const PG8_LAS int* pre; int ntl, c, first, T, S, kbytes;
    __device__ __forceinline__ bool next(int i, Unit& u) const {
        if (i != 0 || c >= T * S) return false;
        const int j = c % T, s = c / T;
        StaticOrder so; so.init(__builtin_amdgcn_readfirstlane(pre[8]) * BM, ntl * BM, 1, first + j);
        if (!so.next(0, u)) return false;
        int e = 0;
#pragma unroll
        for (int k = 1; k < 8; ++k) e += (u.pm >= pre[k]) ? 1 : 0;
        u.pn += e * ntl; u.ko = s * kbytes; u.aux = j | (s << 16); return true;
    }
    __device__ __forceinline__ void a_ready(const Unit&) const {}
    __device__ __forceinline__ void done(const Unit&) const {}
};
struct EpiMoeSplit {
    static constexpr bool PERM = true, AFTER_DRAIN = false;
    EpiMoeOut inner; float* slab; unsigned* cnt; int S;
    __device__ __forceinline__ void operator()(const f32x4 (&acc)[2][2][4][2], const Unit& u, int wr, int wc, int fr, int fq) const {
        const int j = u.aux & 0xffff, s = u.aux >> 16, w = wr * 4 + wc, lane = fr + 16 * fq;
        const __amdgpu_buffer_rsrc_t rs = __builtin_amdgcn_make_buffer_rsrc((void*)slab, (short)0, 0x04000000, 0x00020000);
        const int mybase = (((j * S + s) * 8 + w) * 2048 + lane) * 16;
#pragma unroll
        for (int ai = 0; ai < 2; ++ai)
#pragma unroll
            for (int bj = 0; bj < 2; ++bj)
#pragma unroll
                for (int m = 0; m < 4; ++m)
#pragma unroll
                    for (int n = 0; n < 2; ++n) __builtin_amdgcn_raw_buffer_store_b128(__builtin_bit_cast(u32x4, acc[ai][bj][m][n]), rs, mybase + ((((ai * 2 + bj) * 4 + m) * 2 + n) * 1024), 0, 16);
        asm volatile("s_waitcnt vmcnt(0)" ::: "memory");
        unsigned old = 0;
        if (lane == 0) old = __hip_atomic_fetch_add(cnt + (j * 8 + w) * 4, 1u, __ATOMIC_RELAXED, __HIP_MEMORY_SCOPE_AGENT);
        old = (unsigned)__builtin_amdgcn_readfirstlane((int)old);
        if (old != (unsigned)(S - 1)) return;
        __builtin_amdgcn_fence(__ATOMIC_ACQUIRE, "agent"); asm volatile("s_waitcnt vmcnt(0)" ::: "memory");
        f32x4 tot[2][2][4][2];
#pragma unroll
        for (int ai = 0; ai < 2; ++ai)
#pragma unroll
            for (int bj = 0; bj < 2; ++bj)
#pragma unroll
                for (int m = 0; m < 4; ++m)
#pragma unroll
                    for (int n = 0; n < 2; ++n) tot[ai][bj][m][n] = (f32x4){0.f, 0.f, 0.f, 0.f};
        for (int s2 = 0; s2 < S; ++s2) { const float* p = slab + (size_t)(((j * S + s2) * 8 + w) * 2048 + lane) * 4;
#pragma unroll
            for (int ai = 0; ai < 2; ++ai)
#pragma unroll
                for (int bj = 0; bj < 2; ++bj)
#pragma unroll
                    for (int m = 0; m < 4; ++m)
#pragma unroll
                        for (int n = 0; n < 2; ++n) tot[ai][bj][m][n] += *(const f32x4*)(p + ((((ai * 2 + bj) * 4 + m) * 2 + n) * 256)); }
        inner(tot, u, wr, wc, fr, fq);
    }
};
__device__ __forceinline__ void moe_order_setup(PG8_LAS int* pre, const unsigned* cnt) {
    if (threadIdx.x == 0) { int p = 0; pre[0] = 0;
#pragma unroll
        for (int e = 0; e < 8; ++e) { p += (int)((cnt[64 * e] + 255u) >> 8); pre[e + 1] = p; } }
    __syncthreads();
}
}
#define GAS __attribute__((address_space(1)))
#define LAS __attribute__((address_space(3)))
typedef unsigned short bf16;
typedef unsigned v4u __attribute__((ext_vector_type(4)));
typedef float f32x4 __attribute__((ext_vector_type(4)));
typedef short bf16x8 __attribute__((ext_vector_type(8)));
typedef GAS unsigned gu32;
typedef GAS unsigned long long gu64;
#define RLX_AGENT __ATOMIC_RELAXED, __HIP_MEMORY_SCOPE_AGENT
#define LDS_WAIT() asm volatile("s_waitcnt lgkmcnt(0)" ::: "memory")
#define VM_WAIT() asm volatile("s_waitcnt vmcnt(0)" ::: "memory")
__device__ __forceinline__ unsigned long long rt() { return __builtin_amdgcn_s_memrealtime(); }
__device__ __forceinline__ unsigned f2bf(float f) { unsigned u = __builtin_bit_cast(unsigned, f); return (u + 0x7fffu + ((u >> 16) & 1u)) >> 16; }
__device__ __forceinline__ unsigned pk2(float lo, float hi) { return f2bf(lo) | (f2bf(hi) << 16); }
#define XB_TMO      128
#define XB_XCNT(j)  (256  + 64 * (j))
#define XB_XSUB(j)  (1280 + 64 * (j))
#define XB_XGEN(j)  (2304 + 64 * (j))
#define XB_TOP      3328
#define XB_TOPGEN   3392
#define XCD_BAR_WORDS 3456
#define XB_SPIN_CAP (1u << 22)

__device__ __forceinline__ unsigned xb_ld(unsigned* p)              { return __hip_atomic_load(p, __ATOMIC_RELAXED, __HIP_MEMORY_SCOPE_AGENT); }
__device__ __forceinline__ unsigned xb_add(unsigned* p, unsigned v) { return __hip_atomic_fetch_add(p, v, __ATOMIC_RELAXED, __HIP_MEMORY_SCOPE_AGENT); }
__device__ __forceinline__ unsigned xb_xcc_id() { return (unsigned)__builtin_amdgcn_s_getreg((3 << 11) | 20) & 0xFu; }
#define XB_SPIN(cond, bar) do { unsigned _sp = 0; while (cond) { __builtin_amdgcn_s_sleep(1); \
    if ((++_sp & 255u) == 0u) { if (xb_ld(&(bar)[XB_TMO])) break; if (_sp > XB_SPIN_CAP) { atomicAdd(&(bar)[XB_TMO], 1u); break; } } } } while (0)

struct XcdBarrier {
    unsigned* bar; unsigned x;
    volatile LAS unsigned* st;
};

__device__ __forceinline__ XcdBarrier xcd_barrier_post(unsigned* bar, volatile LAS unsigned* st) {
    XcdBarrier b; b.bar = bar; b.x = xb_xcc_id(); b.st = st;
    if (threadIdx.x == 0) (void)xb_add(&bar[XB_XCNT(b.x)], 1u);
    return b;
}
__device__ __forceinline__ void xcd_barrier_complete(unsigned* bar, unsigned x, unsigned& nloc, unsigned& nx) {
    const unsigned G = gridDim.x * gridDim.y * gridDim.z;
    unsigned sum, cnt, mine, sp = 0u;
    for (;;) {
        sum = 0u; cnt = 0u; mine = 0u;
#pragma unroll
        for (unsigned j = 0; j < 16; ++j) { const unsigned c = xb_ld(&bar[XB_XCNT(j)]); sum += c; cnt += (c > 0u) ? 1u : 0u; mine = (j == x) ? c : mine; }
        if (sum == G) break;
        __builtin_amdgcn_s_sleep(1);
        if ((++sp & 255u) == 0u) { if (xb_ld(&bar[XB_TMO])) break; if (sp > XB_SPIN_CAP) { atomicAdd(&bar[XB_TMO], 1u); break; } }
    }
    nloc = mine > 0u ? mine : 1u; nx = cnt > 0u ? cnt : 1u;
}

__device__ __forceinline__ void xcd_barrier(const XcdBarrier& b) {
    asm volatile("s_waitcnt vmcnt(0)" ::: "memory");
    __syncthreads();
    if (threadIdx.x == 0) {
        unsigned* bar = b.bar;
        __builtin_amdgcn_s_waitcnt(0);
        unsigned nloc = b.st[0], nx = b.st[1];
        if (nloc == 0u) { xcd_barrier_complete(bar, b.x, nloc, nx); b.st[0] = nloc; b.st[1] = nx; }
        const unsigned old = xb_add(&bar[XB_XSUB(b.x)], 1u);
        const unsigned gen = old / nloc;
        if (old + 1u == (gen + 1u) * nloc) {
            __builtin_amdgcn_fence(__ATOMIC_RELEASE, "agent");
            asm volatile("s_waitcnt vmcnt(0)" ::: "memory");
            const unsigned og = xb_add(&bar[XB_TOP], 1u);
            const unsigned tg = og / nx;
            if (og + 1u == (tg + 1u) * nx) xb_add(&bar[XB_TOPGEN], 1u);
            else XB_SPIN(xb_ld(&bar[XB_TOPGEN]) == tg, bar);
            __builtin_amdgcn_fence(__ATOMIC_ACQUIRE, "agent");
            xb_add(&bar[XB_XGEN(b.x)], 1u);
            asm volatile("s_waitcnt vmcnt(0)" ::: "memory");
        } else {
            XB_SPIN(xb_ld(&bar[XB_XGEN(b.x)]) == gen, bar);
            __builtin_amdgcn_fence(__ATOMIC_ACQUIRE, "agent");
            asm volatile("s_waitcnt vmcnt(0)" ::: "memory");
        }
    }
    __syncthreads();
}

constexpr int D = 1024, NB = 16, SEQ = 2048, MTOK = NB * SEQ, NHEAD = 16, HD = 64;
constexpr int SGH = 3072, DFF = 2816, NEXP = 8, DFE = 3584;
constexpr int MODL = NB * 6 * D;
constexpr float EPSN = 1e-6f, LOG2E = 1.4426950408889634f;
constexpr int NWAVES = 8;
constexpr int ASROWS = 2 * MTOK + NEXP * 256;

constexpr size_t MiB = 1u << 20;
constexpr size_t WS_CTL = 0, CTL_ZERO_BYTES = 96 * 1024;
constexpr size_t WS_MOD = 2 * MiB, WS_GAINS = 3 * MiB + 512 * 1024;
constexpr size_t WS_WQKV0 = 4 * MiB, WS_WQKV1 = 10 * MiB, WS_WQKVC = 16 * MiB, WS_WO0 = 22 * MiB, WS_WO1 = 24 * MiB, WS_WOC = 26 * MiB;
constexpr size_t WS_WIN = 28 * MiB, WS_WOUT = 40 * MiB, WS_W13_0 = 46 * MiB, WS_W13_1 = 57 * MiB, WS_W2_0 = 68 * MiB, WS_W2_1 = 68 * MiB + 5632 * 1024;
constexpr size_t WS_MOE13 = 80 * MiB, WS_MOE2 = 192 * MiB;
constexpr size_t WS_H = 248 * MiB;
constexpr size_t WS_AS = 312 * MiB;
constexpr size_t WS_ACT = 444 * MiB;
constexpr size_t WS_ROWINFO = 906 * MiB, WS_TROUTE = 907 * MiB, WS_TW = 908 * MiB, WS_VPART = 909 * MiB;
constexpr size_t WS_CS = 915 * MiB, WS_HSC = 915 * MiB + 512 * 1024, WS_RS = 916 * MiB, WS_XB = 917 * MiB, WS_MOE2B = 981 * MiB, WS_END = 1009 * MiB;
static_assert(WS_W2_1 + (size_t)1024 * 2816 * 2 <= WS_MOE13 && WS_ACT + (size_t)ASROWS * DFE * 2 <= WS_ROWINFO && WS_AS + (size_t)ASROWS * 1024 * 2 <= WS_ACT, "ws map");
constexpr int CW_BAR = 4096, CW_CNT = 8192, CW_CONV = 9280, CW_SPLIT = 12288;

constexpr int LDS_BYTES = 147456, XTRA_OFF = 131072, MISC_OFF = LDS_BYTES - 256;

typedef float f32x16 __attribute__((ext_vector_type(16)));
typedef short s16x4 __attribute__((ext_vector_type(4)));
typedef unsigned u32x2 __attribute__((ext_vector_type(2)));

__device__ __forceinline__ float wave_sum(float v) {
#pragma unroll
    for (int o = 1; o < 64; o <<= 1) v += __shfl_xor(v, o);
    return v;
}
__device__ __forceinline__ float bf_lo(unsigned u) { return __uint_as_float(u << 16); }
__device__ __forceinline__ float bf_hi(unsigned u) { return __uint_as_float(u & 0xffff0000u); }
__device__ __forceinline__ int crow(int r, int hi) { return (r & 3) + 8 * (r >> 2) + 4 * hi; }

__device__ __forceinline__ int map_qkv(int n) { const int L = n & 255; return (n & ~255) | (((L >> 5) & 1) << 7) | ((L >> 6) << 5) | (L & 31); }
__device__ __forceinline__ int map_glu(int n, int half) { const int a = n < half ? n : n - half; return ((a >> 7) << 8) + (n < half ? 0 : 128) + (a & 127); }
template <int MAP> __device__ __forceinline__ void conv_item(int r, const float* __restrict__ W, int K, int N, bf16* dst, int lane) {
    const int nblk = N / 64, kb = r / nblk, nb = r - kb * nblk, n4 = lane & 15, kq = lane >> 4;
    const int ncol = 64 * nb + 4 * n4;
    int drow;
    if (MAP == 0) drow = ncol; else if (MAP == 1) drow = map_qkv(ncol); else if (MAP == 2) drow = map_glu(ncol, N / 2);
    else if (MAP == 3) drow = ((ncol >> 7) << 8) + (ncol & 127); else drow = ((ncol >> 7) << 8) + 128 + (ncol & 127);
    f32x4 f[2][8];
#pragma unroll
    for (int h = 0; h < 2; ++h)
#pragma unroll
        for (int i = 0; i < 8; ++i) f[h][i] = *(const f32x4*)(W + (size_t)(64 * kb + 32 * h + 8 * kq + i) * N + ncol);
#pragma unroll
    for (int h = 0; h < 2; ++h)
#pragma unroll
        for (int j = 0; j < 4; ++j) { v4u o; o.x = pg8::cvt_pk_bf16(f[h][0][j], f[h][1][j]); o.y = pg8::cvt_pk_bf16(f[h][2][j], f[h][3][j]); o.z = pg8::cvt_pk_bf16(f[h][4][j], f[h][5][j]); o.w = pg8::cvt_pk_bf16(f[h][6][j], f[h][7][j]);
            *(GAS v4u*)(dst + (size_t)(drow + j) * K + 64 * kb + 32 * h + 8 * kq) = o; }
}
__device__ __forceinline__ unsigned q4i8(float a, float b, float c, float d) {
    const int ia = (int)__builtin_rintf(a), ib = (int)__builtin_rintf(b), ic = (int)__builtin_rintf(c), id = (int)__builtin_rintf(d);
    return (unsigned)(ia & 255) | ((unsigned)(ib & 255) << 8) | ((unsigned)(ic & 255) << 16) | ((unsigned)id << 24);
}
template <int MAP> __device__ __forceinline__ void conv8_item(int nb, const float* __restrict__ W, int N, unsigned char* dst, float* cscale, int lane) {
    const int n4 = lane & 7, kq = lane >> 3, ncol = 32 * nb + 4 * n4;
    const int drow = MAP == 0 ? ncol : MAP == 1 ? map_qkv(ncol) : MAP == 2 ? map_glu(ncol, N / 2) : ((ncol >> 7) << 8) + (MAP == 4 ? 128 : 0) + (ncol & 127);
    f32x4 mx = (f32x4){0.f, 0.f, 0.f, 0.f};
#pragma unroll 8
    for (int i = 0; i < 128; ++i) { const f32x4 v = *(const f32x4*)(W + (size_t)(8 * i + kq) * N + ncol);
#pragma unroll
        for (int j = 0; j < 4; ++j) mx[j] = fmaxf(mx[j], fabsf(v[j])); }
    float qs[4];
#pragma unroll
    for (int j = 0; j < 4; ++j) { float a = mx[j]; a = fmaxf(a, __shfl_xor(a, 8)); a = fmaxf(a, __shfl_xor(a, 16)); a = fmaxf(a, __shfl_xor(a, 32));
        qs[j] = a > 0.f ? 127.0f / a : 1.0f; if (kq == 0) cscale[drow + j] = a > 0.f ? a * (1.0f / 127.0f) : 1.0f; }
    for (int kb = 0; kb < 8; ++kb) {
        f32x4 f[16];
#pragma unroll
        for (int i = 0; i < 16; ++i) f[i] = *(const f32x4*)(W + (size_t)(128 * kb + 16 * kq + i) * N + ncol);
#pragma unroll
        for (int j = 0; j < 4; ++j) { v4u o;
#pragma unroll
            for (int q = 0; q < 4; ++q) o[q] = q4i8(f[4 * q][j] * qs[j], f[4 * q + 1][j] * qs[j], f[4 * q + 2][j] * qs[j], f[4 * q + 3][j] * qs[j]);
            *(GAS v4u*)(dst + (size_t)(drow + j) * D + 128 * kb + 16 * kq) = o; }
    }
}
template <int KD> __device__ __forceinline__ void convf8_item(int nb, const float* __restrict__ W, int N, unsigned char* dst, float* cscale, int lane) {
    const int n4 = lane & 7, kq = lane >> 3, ncol = 32 * nb + 4 * n4;
    f32x4 mx = (f32x4){0.f, 0.f, 0.f, 0.f};
#pragma unroll 8
    for (int i = 0; i < KD / 8; ++i) { const f32x4 v = *(const f32x4*)(W + (size_t)(8 * i + kq) * N + ncol);
#pragma unroll
        for (int j = 0; j < 4; ++j) mx[j] = fmaxf(mx[j], fabsf(v[j])); }
    float qs[4];
#pragma unroll
    for (int j = 0; j < 4; ++j) { float a = mx[j]; a = fmaxf(a, __shfl_xor(a, 8)); a = fmaxf(a, __shfl_xor(a, 16)); a = fmaxf(a, __shfl_xor(a, 32));
        qs[j] = a > 0.f ? 440.0f / a : 1.0f; if (kq == 0) cscale[ncol + j] = (a > 0.f ? a * (1.0f / 440.0f) : 1.0f) * 0.125f; }
    for (int kb = 0; kb < KD / 128; ++kb) {
        f32x4 f[16];
#pragma unroll
        for (int i = 0; i < 16; ++i) f[i] = *(const f32x4*)(W + (size_t)(128 * kb + 16 * kq + i) * N + ncol);
#pragma unroll
        for (int j = 0; j < 4; ++j) { v4u o;
#pragma unroll
            for (int q = 0; q < 4; ++q) { int w = 0; w = __builtin_amdgcn_cvt_pk_fp8_f32(f[4 * q][j] * qs[j], f[4 * q + 1][j] * qs[j], w, false); w = __builtin_amdgcn_cvt_pk_fp8_f32(f[4 * q + 2][j] * qs[j], f[4 * q + 3][j] * qs[j], w, true); o[q] = (unsigned)w; }
            *(GAS v4u*)(dst + (size_t)(ncol + j) * KD + 128 * kb + 16 * kq) = o; }
    }
}
__device__ __forceinline__ void conv8_wg_item(int MAP, int nb, const float* __restrict__ W, int N, unsigned char* dst, float* cscale, LAS float* amx, int par, int wave, int lane) {
    const int n4 = lane & 7, kq = lane >> 3, ncol = 32 * nb + 4 * n4;
    const int drow = MAP == 0 ? ncol : MAP == 1 ? map_qkv(ncol) : MAP == 2 ? map_glu(ncol, N / 2) : ((ncol >> 7) << 8) + (MAP == 4 ? 128 : 0) + (ncol & 127);
    f32x4 f[16]; f32x4 mx = (f32x4){0.f, 0.f, 0.f, 0.f};
#pragma unroll
    for (int i = 0; i < 16; ++i) { f[i] = *(const f32x4*)(W + (size_t)(128 * wave + 16 * kq + i) * N + ncol);
#pragma unroll
        for (int j = 0; j < 4; ++j) mx[j] = fmaxf(mx[j], fabsf(f[i][j])); }
#pragma unroll
    for (int j = 0; j < 4; ++j) { float a = mx[j]; a = fmaxf(a, __shfl_xor(a, 8)); a = fmaxf(a, __shfl_xor(a, 16)); a = fmaxf(a, __shfl_xor(a, 32)); mx[j] = a; }
    LAS float* ap = amx + par * 256;
    if (kq == 0) *(LAS f32x4*)(ap + wave * 32 + 4 * n4) = mx;
    LDS_WAIT(); __syncthreads();
    f32x4 am = *(const LAS f32x4*)(ap + 4 * n4);
#pragma unroll
    for (int w = 1; w < 8; ++w) { const f32x4 o = *(const LAS f32x4*)(ap + w * 32 + 4 * n4);
#pragma unroll
        for (int j = 0; j < 4; ++j) am[j] = fmaxf(am[j], o[j]); }
    float qs[4];
#pragma unroll
    for (int j = 0; j < 4; ++j) { qs[j] = am[j] > 0.f ? 127.0f / am[j] : 1.0f; if (wave == 0 && kq == 0) cscale[drow + j] = am[j] > 0.f ? am[j] * (1.0f / 127.0f) : 1.0f; }
#pragma unroll
    for (int j = 0; j < 4; ++j) { v4u o;
#pragma unroll
        for (int q = 0; q < 4; ++q) o[q] = q4i8(f[4 * q][j] * qs[j], f[4 * q + 1][j] * qs[j], f[4 * q + 2][j] * qs[j], f[4 * q + 3][j] * qs[j]);
        *(GAS v4u*)(dst + (size_t)(drow + j) * D + 128 * wave + 16 * kq) = o; }
}
template <int KD> __device__ __forceinline__ void convf8_wg_item(int nb, const float* __restrict__ W, int N, unsigned char* dst, float* cscale, LAS float* amx, int par, int wave, int lane) {
    constexpr int RW = KD / 8, NG = RW / 16;
    static_assert(RW % 16 == 0, "rows per wave");
    const int n4 = lane & 7, kq = lane >> 3, ncol = 32 * nb + 4 * n4;
    const float* wp = W + (size_t)(RW * wave) * N + ncol;
    f32x4 mx = (f32x4){0.f, 0.f, 0.f, 0.f};
    constexpr int PB = RW / 32;
    static_assert(RW % 32 == 0, "pass-1 batches");
    for (int b0 = 0; b0 < 4; ++b0) { f32x4 v[PB];
#pragma unroll
        for (int i = 0; i < PB; ++i) v[i] = *(const f32x4*)(wp + (size_t)(8 * (PB * b0 + i) + kq) * N);
#pragma unroll
        for (int i = 0; i < PB; ++i)
#pragma unroll
            for (int j = 0; j < 4; ++j) mx[j] = fmaxf(mx[j], fabsf(v[i][j])); }
#pragma unroll
    for (int j = 0; j < 4; ++j) { float a = mx[j]; a = fmaxf(a, __shfl_xor(a, 8)); a = fmaxf(a, __shfl_xor(a, 16)); a = fmaxf(a, __shfl_xor(a, 32)); mx[j] = a; }
    LAS float* ap = amx + par * 256;
    if (kq == 0) *(LAS f32x4*)(ap + wave * 32 + 4 * n4) = mx;
    LDS_WAIT(); __syncthreads();
    f32x4 am = *(const LAS f32x4*)(ap + 4 * n4);
#pragma unroll
    for (int w = 1; w < 8; ++w) { const f32x4 o = *(const LAS f32x4*)(ap + w * 32 + 4 * n4);
#pragma unroll
        for (int j = 0; j < 4; ++j) am[j] = fmaxf(am[j], o[j]); }
    float qs[4];
#pragma unroll
    for (int j = 0; j < 4; ++j) { qs[j] = am[j] > 0.f ? 440.0f / am[j] : 1.0f; if (wave == 0 && kq == 0) cscale[ncol + j] = (am[j] > 0.f ? am[j] * (1.0f / 440.0f) : 1.0f) * 0.125f; }
    for (int t = 0; t < (NG + 7) / 8; ++t) { const int g = 8 * t + kq;
        if (g < NG) { f32x4 f[16];
#pragma unroll
            for (int i = 0; i < 16; ++i) f[i] = *(const f32x4*)(wp + (size_t)(16 * g + i) * N);
#pragma unroll
            for (int j = 0; j < 4; ++j) { v4u o;
#pragma unroll
                for (int q = 0; q < 4; ++q) { int w = 0; w = __builtin_amdgcn_cvt_pk_fp8_f32(f[4 * q][j] * qs[j], f[4 * q + 1][j] * qs[j], w, false); w = __builtin_amdgcn_cvt_pk_fp8_f32(f[4 * q + 2][j] * qs[j], f[4 * q + 3][j] * qs[j], w, true); o[q] = (unsigned)w; }
                *(GAS v4u*)(dst + (size_t)(ncol + j) * KD + RW * wave + 16 * g) = o; } } }
}
constexpr int IT_MOE8 = DFE / 32, IT_MOE2 = D / 32;
constexpr int IT_MOE = NEXP * (2 * IT_MOE8 + IT_MOE2);
__device__ __forceinline__ void moe_conv_item(int r, const float* w1, const float* w3, const float* w2, unsigned char* W13, float* cscale, bf16* W2, float* cs2, int lane) {
    if (r < NEXP * IT_MOE8) { const int e = r / IT_MOE8; conv8_item<3>(r % IT_MOE8, w1 + (size_t)e * D * DFE, DFE, W13 + (size_t)e * 2 * DFE * D, cscale + e * 2 * DFE, lane); return; }
    r -= NEXP * IT_MOE8;
    if (r < NEXP * IT_MOE8) { const int e = r / IT_MOE8; conv8_item<4>(r % IT_MOE8, w3 + (size_t)e * D * DFE, DFE, W13 + (size_t)e * 2 * DFE * D, cscale + e * 2 * DFE, lane); return; }
    r -= NEXP * IT_MOE8;
    { const int e = r / IT_MOE2; convf8_item<DFE>(r % IT_MOE2, w2 + (size_t)e * DFE * D, D, (unsigned char*)W2 + (size_t)e * D * DFE, cs2 + e * D, lane); }
}
__device__ __forceinline__ void mod_item(int it, const float* __restrict__ ada_w, const float* __restrict__ ada_b, float* mod, const LAS float* cond, int lane) {
    const int i = it / 384, n0 = 16 * (it % 384), n4 = lane & 3, ksub = lane >> 2;
    f32x4 acc[16];
#pragma unroll
    for (int b = 0; b < 16; ++b) acc[b] = (f32x4){0.f, 0.f, 0.f, 0.f};
    const float* wp = ada_w + (size_t)i * D * 6 * D + n0 + 4 * n4;
#pragma unroll 8
    for (int kk = 0; kk < 64; ++kk) { const int k = 16 * kk + ksub;
        const f32x4 w = *(const f32x4*)(wp + (size_t)k * 6 * D);
        const LAS f32x4* cp = (const LAS f32x4*)(cond + k * 16);
#pragma unroll
        for (int q = 0; q < 4; ++q) { const f32x4 c = cp[q];
#pragma unroll
            for (int e = 0; e < 4; ++e) acc[4 * q + e] += w * c[e]; } }
#pragma unroll
    for (int b = 0; b < 16; ++b)
#pragma unroll
        for (int e = 0; e < 4; ++e) { float v = acc[b][e]; v += __shfl_xor(v, 4); v += __shfl_xor(v, 8); v += __shfl_xor(v, 16); v += __shfl_xor(v, 32); acc[b][e] = v; }
    if (ksub == 0) { const f32x4 bv = *(const f32x4*)(ada_b + (size_t)i * 6 * D + n0 + 4 * n4);
#pragma unroll
        for (int b = 0; b < 16; ++b) *(f32x4*)(mod + (size_t)i * MODL + (size_t)b * 6 * D + n0 + 4 * n4) = acc[b] + bv; }
}

template <bool COMBINE, bool NORM, bool ROUTE, bool F8OUT = ROUTE, bool XIN16 = true, bool XOUT16 = true>
__device__ __forceinline__ void norm_phase(const void* xin, void* xout, bf16* H, const float* ng, const float* modl, int sh_off,
                                           const float* g2prev, const bf16* Y, const float* twin,
                                           const float* wr, const float* br, unsigned* cnt, int* troute, float* twout, float* hsc,
                                           LAS unsigned char* L, int vcu, int G, int wave, int lane, int tid) {
    LAS float* wrL = (LAS float*)L;
    if (ROUTE) { float wv[D * NEXP / (NWAVES * 64)];
#pragma unroll
        for (int i = 0; i < D * NEXP / (NWAVES * 64); ++i) wv[i] = wr[tid + NWAVES * 64 * i];
#pragma unroll
        for (int i = 0; i < D * NEXP / (NWAVES * 64); ++i) wrL[tid + NWAVES * 64 * i] = wv[i];
        __syncthreads(); }
    for (int gw = vcu * NWAVES + wave; gw < MTOK / 16; gw += G * NWAVES) {
        const int b = gw >> 7; const size_t row0 = (size_t)gw * 16;
        f32x4 A[4], Bv[4], G2[4];
#pragma unroll
        for (int j = 0; j < 4; ++j) { const int col = 4 * lane + 256 * j;
            if (NORM) { const f32x4 g = *(const f32x4*)(ng + col), sc = *(const f32x4*)(modl + (size_t)b * 6 * D + sh_off + D + col); A[j] = g * (sc + 1.0f); Bv[j] = *(const f32x4*)(modl + (size_t)b * 6 * D + sh_off + col); }
            if (COMBINE) G2[j] = *(const f32x4*)(g2prev + (size_t)b * 6 * D + col); }
        int my_e1 = 0, my_e2 = 0; float my_w1 = 0.f, my_w2 = 0.f;
        u32x2 cw[4], cy0[4], cy1[4]; f32x4 cf[4]; float cw0 = 0.f, cw1 = 0.f;
#pragma unroll
        for (int j = 0; j < 4; ++j) {
            if (XIN16) cw[j] = *(const u32x2*)((const bf16*)xin + row0 * D + 4 * lane + 256 * j); else cf[j] = *(const f32x4*)((const float*)xin + row0 * D + 4 * lane + 256 * j);
            if (COMBINE) { cy0[j] = *(const u32x2*)(Y + row0 * D + 4 * lane + 256 * j); cy1[j] = *(const u32x2*)(Y + ((size_t)MTOK + row0) * D + 4 * lane + 256 * j); } }
        if (COMBINE) { cw0 = twin[2 * row0]; cw1 = twin[2 * row0 + 1]; }
        for (int r = 0; r < 16; ++r) { const size_t row = row0 + r;
            f32x4 x[4]; u32x2 ny0[4], ny1[4]; float nw0 = 0.f, nw1 = 0.f;
            { const size_t nrow = row + (r < 15 ? 1 : 0);
              u32x2 nwd[4]; f32x4 nf[4];
#pragma unroll
              for (int j = 0; j < 4; ++j) {
                if (XIN16) nwd[j] = *(const u32x2*)((const bf16*)xin + nrow * D + 4 * lane + 256 * j); else nf[j] = *(const f32x4*)((const float*)xin + nrow * D + 4 * lane + 256 * j);
                if (COMBINE) { ny0[j] = *(const u32x2*)(Y + nrow * D + 4 * lane + 256 * j); ny1[j] = *(const u32x2*)(Y + ((size_t)MTOK + nrow) * D + 4 * lane + 256 * j); } }
              if (COMBINE) { nw0 = twin[2 * nrow]; nw1 = twin[2 * nrow + 1]; }
#pragma unroll
              for (int j = 0; j < 4; ++j) {
                if (XIN16) { const u32x2 w = cw[j]; x[j] = (f32x4){bf_lo(w.x), bf_hi(w.x), bf_lo(w.y), bf_hi(w.y)}; cw[j] = nwd[j]; }
                else { x[j] = cf[j]; cf[j] = nf[j]; } } }
            if (COMBINE) { const float w0 = cw0, w1 = cw1; cw0 = nw0; cw1 = nw1;
#pragma unroll
                for (int j = 0; j < 4; ++j) { const u32x2 y0 = cy0[j], y1 = cy1[j]; cy0[j] = ny0[j]; cy1[j] = ny1[j];
                    f32x4 t; t[0] = w0 * bf_lo(y0.x) + w1 * bf_lo(y1.x); t[1] = w0 * bf_hi(y0.x) + w1 * bf_hi(y1.x); t[2] = w0 * bf_lo(y0.y) + w1 * bf_lo(y1.y); t[3] = w0 * bf_hi(y0.y) + w1 * bf_hi(y1.y);
                    x[j] = x[j] + G2[j] * t;
                    if (XOUT16) { u32x2 o; o.x = pk2(x[j][0], x[j][1]); o.y = pk2(x[j][2], x[j][3]); *(u32x2*)((bf16*)xout + row * D + 4 * lane + 256 * j) = o; }
                    else *(f32x4*)((float*)xout + row * D + 4 * lane + 256 * j) = x[j]; } }
            if (NORM) { float ss = 0.f;
#pragma unroll
                for (int j = 0; j < 4; ++j) ss += (x[j][0] * x[j][0] + x[j][1] * x[j][1]) + (x[j][2] * x[j][2] + x[j][3] * x[j][3]);
                const float rstd = __builtin_amdgcn_rsqf(wave_sum(ss) * (1.0f / D) + EPSN);
                float lg[8];
#pragma unroll
                for (int e = 0; e < 8; ++e) lg[e] = 0.f;
                f32x4 hv[4]; float amax = 0.f;
#pragma unroll
                for (int j = 0; j < 4; ++j) { hv[j] = x[j] * rstd * A[j] + Bv[j]; amax = fmaxf(amax, fmaxf(fmaxf(fabsf(hv[j][0]), fabsf(hv[j][1])), fmaxf(fabsf(hv[j][2]), fabsf(hv[j][3])))); }
                float qs = 1.0f;
                if (F8OUT) {
#pragma unroll
                    for (int o = 1; o < 64; o <<= 1) amax = fmaxf(amax, __shfl_xor(amax, o));
                    qs = amax > 0.f ? 127.0f / amax : 1.0f;
                    if (lane == 0) hsc[row] = amax > 0.f ? amax * (1.0f / 127.0f) : 1.0f; }
#pragma unroll
                for (int j = 0; j < 4; ++j) { const f32x4 h = hv[j];
                    if (F8OUT) *(unsigned*)((unsigned char*)H + row * D + 4 * lane + 256 * j) = q4i8(h[0] * qs, h[1] * qs, h[2] * qs, h[3] * qs);
                    else { u32x2 o; o.x = pk2(h[0], h[1]); o.y = pk2(h[2], h[3]); *(u32x2*)(H + row * D + 4 * lane + 256 * j) = o; }
                    if (ROUTE) {
#pragma unroll
                        for (int jj = 0; jj < 4; ++jj) { const LAS f32x4* wp = (const LAS f32x4*)(wrL + (4 * lane + 256 * j + jj) * 8); const f32x4 wa = wp[0], wb = wp[1];
#pragma unroll
                            for (int e = 0; e < 4; ++e) { lg[e] += h[jj] * wa[e]; lg[4 + e] += h[jj] * wb[e]; } } } }
                if (ROUTE) {
#pragma unroll
                    for (int e = 0; e < 8; ++e) lg[e] = wave_sum(lg[e]) + br[e];
                    int e1 = 0; float v1 = lg[0];
#pragma unroll
                    for (int e = 1; e < 8; ++e) if (lg[e] > v1) { v1 = lg[e]; e1 = e; }
                    int e2 = -1; float v2 = -INFINITY;
#pragma unroll
                    for (int e = 0; e < 8; ++e) if (e != e1 && lg[e] > v2) { v2 = lg[e]; e2 = e; }
                    const float w1 = 1.0f / (1.0f + __expf(v2 - v1));
                    if (lane == r) { my_e1 = e1; my_e2 = e2; my_w1 = w1; my_w2 = 1.0f - w1; } } } }
        if (ROUTE) {
            const bool valid = lane < 16; int rank1 = 0, rank2 = 0; unsigned mine = 0;
            const unsigned long long lt = (1ull << lane) - 1ull;
#pragma unroll
            for (int e = 0; e < 8; ++e) { const unsigned long long m1 = __ballot(valid && my_e1 == e), m2 = __ballot(valid && my_e2 == e);
                if (my_e1 == e) rank1 = __popcll(m1 & lt);
                if (my_e2 == e) rank2 = __popcll(m1) + __popcll(m2 & lt);
                if (lane == e) mine = (unsigned)(__popcll(m1) + __popcll(m2)); }
            unsigned base = 0;
            if (lane < 8) base = __hip_atomic_fetch_add(cnt + 64 * lane, mine, __ATOMIC_RELAXED, __HIP_MEMORY_SCOPE_AGENT);
            const int b1 = (int)__shfl((int)base, my_e1), b2 = (int)__shfl((int)base, my_e2);
            if (valid) { int4 tr; tr.x = my_e1; tr.y = b1 + rank1; tr.z = my_e2; tr.w = b2 + rank2; *(int4*)(troute + 4 * (row0 + lane)) = tr;
                twout[2 * (row0 + lane)] = my_w1; twout[2 * (row0 + lane) + 1] = my_w2; } }
    }
}

__device__ __forceinline__ void gather_phase(const unsigned char* H8, unsigned char* AS8, int* rowinfo, const int* troute, const unsigned* cnt, const float* hsc, float* rs, int vcu, int G, int wave, int lane, int tid) {
    int mt[8];
#pragma unroll
    for (int e = 0; e < 8; ++e) mt[e] = (int)((cnt[64 * e] + 255u) >> 8);
    for (int gw = vcu * NWAVES + wave; gw < MTOK / 16; gw += G * NWAVES) {
        const size_t m0 = (size_t)gw * 16;
        int R1v = 0, R2v = 0;
        if (lane < 16) { const int4 tr = *(const int4*)(troute + 4 * (m0 + lane));
            int rb1 = 0, rb2 = 0;
#pragma unroll
            for (int k = 0; k < 7; ++k) { rb1 += (tr.x > k) ? mt[k] * 256 : 0; rb2 += (tr.z > k) ? mt[k] * 256 : 0; }
            R1v = rb1 + tr.y; R2v = rb2 + tr.w;
            rowinfo[R1v] = (int)(2 * (m0 + lane)); rowinfo[R2v] = (int)(2 * (m0 + lane) + 1); const float sc = hsc[m0 + lane]; rs[R1v] = sc; rs[R2v] = sc; }
#pragma unroll
        for (int rb = 0; rb < 16; rb += 4) {
            v4u v[4];
#pragma unroll
            for (int q = 0; q < 4; ++q) v[q] = *(const v4u*)(H8 + (m0 + rb + q) * D + lane * 16);
#pragma unroll
            for (int q = 0; q < 4; ++q) { const size_t R1 = (size_t)__builtin_amdgcn_readlane(R1v, rb + q), R2 = (size_t)__builtin_amdgcn_readlane(R2v, rb + q);
                *(v4u*)(AS8 + R1 * D + lane * 16) = v[q]; *(v4u*)(AS8 + R2 * D + lane * 16) = v[q]; } }
    }
    if (vcu == 0) { int rb = 0;
#pragma unroll
        for (int e = 0; e < 8; ++e) { const int c = (int)cnt[64 * e]; for (int R = rb + c + tid; R < rb + mt[e] * 256; R += NWAVES * 64) { rowinfo[R] = -1; rs[R] = 0.f; } rb += mt[e] * 256; } }
}

typedef short v4i16_t __attribute__((ext_vector_type(4)));
__device__ __forceinline__ s16x4 vtr(unsigned a) { return __builtin_bit_cast(s16x4, __builtin_amdgcn_ds_read_tr16_b64_v4i16((LAS v4i16_t*)(uintptr_t)a)); }
__device__ __forceinline__ void pv_tile(f32x16 (&o)[2], unsigned vb, pg8::bf16x8 pa0, pg8::bf16x8 pa1, pg8::bf16x8 pa2, pg8::bf16x8 pa3) {
    s16x4 lo[2][4], hi[2][4];
#pragma unroll
    for (int d0 = 0; d0 < 2; ++d0)
#pragma unroll
        for (int ks = 0; ks < 4; ++ks) { lo[d0][ks] = vtr(vb + d0 * 4096 + ks * 1024); hi[d0][ks] = vtr(vb + d0 * 4096 + ks * 1024 + 512); }
    __builtin_amdgcn_sched_barrier(0);
#define PK(d, k) (pg8::bf16x8){lo[d][k][0], lo[d][k][1], lo[d][k][2], lo[d][k][3], hi[d][k][0], hi[d][k][1], hi[d][k][2], hi[d][k][3]}
    o[0] = __builtin_amdgcn_mfma_f32_32x32x16_bf16(pa0, PK(0, 0), o[0], 0, 0, 0); o[1] = __builtin_amdgcn_mfma_f32_32x32x16_bf16(pa0, PK(1, 0), o[1], 0, 0, 0);
    o[0] = __builtin_amdgcn_mfma_f32_32x32x16_bf16(pa1, PK(0, 1), o[0], 0, 0, 0); o[1] = __builtin_amdgcn_mfma_f32_32x32x16_bf16(pa1, PK(1, 1), o[1], 0, 0, 0);
    o[0] = __builtin_amdgcn_mfma_f32_32x32x16_bf16(pa2, PK(0, 2), o[0], 0, 0, 0); o[1] = __builtin_amdgcn_mfma_f32_32x32x16_bf16(pa2, PK(1, 2), o[1], 0, 0, 0);
    o[0] = __builtin_amdgcn_mfma_f32_32x32x16_bf16(pa3, PK(0, 3), o[0], 0, 0, 0); o[1] = __builtin_amdgcn_mfma_f32_32x32x16_bf16(pa3, PK(1, 3), o[1], 0, 0, 0);
#undef PK
}
__device__ __forceinline__ void v_dma(const bf16* vsrc, size_t pitch, LAS unsigned char* slot) {
#pragma unroll
    for (int p = 0; p < 8; ++p)
        __builtin_amdgcn_global_load_lds((const unsigned*)(vsrc + (size_t)(16 * (p & 3)) * pitch + (p >> 2) * 32), (LAS unsigned*)(slot + p * 1024), 16, 0, 0);
}
__device__ __forceinline__ unsigned short bf1(float x) { return (unsigned short)f2bf(x); }

typedef float f32x2_t __attribute__((ext_vector_type(2))); typedef __bf16 bf16x2_t __attribute__((ext_vector_type(2)));
__device__ __forceinline__ unsigned cvtpk_s(float lo, float hi) { f32x2_t v = {lo, hi}; bf16x2_t b = __builtin_convertvector(v, bf16x2_t); return __builtin_bit_cast(unsigned, b); }
__device__ __forceinline__ float fmul_s(float a, float b) { float r; asm("v_mul_f32_e32 %0, %1, %2" : "=v"(r) : "v"(a), "v"(b)); return r; }
__device__ __forceinline__ float fsub_s(float a, float b) { float r; asm("v_sub_f32_e32 %0, %1, %2" : "=v"(r) : "v"(a), "v"(b)); return r; }
constexpr int AT_STAGE = 65536, AT_VOFF = 32768, AT_TPS = 4;
template <int MODE>
__device__ __forceinline__ void attn_phase(const bf16* __restrict__ Q, const bf16* __restrict__ K, const bf16* __restrict__ V, bf16* __restrict__ O, const float* relb, LAS unsigned char* L, int vcu, int G, int wave, int lane, int tid) {
    LAS float* biasL = (LAS float*)(L + XTRA_OFF);
    LAS float* wsf = (LAS float*)(L + XTRA_OFF + 16 * 193 * 4) + wave * 64;
    volatile LAS unsigned* act = (volatile LAS unsigned*)(L + XTRA_OFF + 16 * 193 * 4 + 2048);
    LAS bf16* stg = (LAS bf16*)(L + wave * 4096);
    if (MODE == 1) { constexpr int NBI = (NHEAD * 193 + NWAVES * 64 - 1) / (NWAVES * 64); float bv[NBI];
#pragma unroll
        for (int i = 0; i < NBI; ++i) { const int u = tid + NWAVES * 64 * i, hh = u / 193, ii = u - hh * 193; bv[i] = u < NHEAD * 193 ? relb[hh * 257 + 64 + ii] : 0.f; }
#pragma unroll
        for (int i = 0; i < NBI; ++i) { const int u = tid + NWAVES * 64 * i; if (u < NHEAD * 193) biasL[u] = bv[i] * LOG2E; } }
    __syncthreads();
    const int r32 = lane & 31, hi = lane >> 5;
    const unsigned vlane = ((lane >> 4) & 1) * 32 + (lane & 3) * 8 + (4 * hi + ((lane & 15) >> 2)) * 64;
    const unsigned klane = hi * 1024 + r32 * 16;
    for (int idx = vcu; idx < NB * NHEAD * 8; idx += G) {
        const int bh = idx >> 3, qb = ((idx & 7) + (idx >> 8)) & 7, b = bh >> 4, h = bh & 15;
        const size_t rowbase = (size_t)b * SEQ;
        const int cw = 4 * qb + (wave >> 1), r0 = 256 * qb + 32 * wave, t = r0 + r32;
        const int kt_top = 4 * qb + 3;
        const int lo_w = MODE == 1 ? (cw > 8 ? cw - 8 : 0) : 0;
        const int nstage = MODE == 1 ? (qb >= 2 ? 3 : qb + 1) : qb + 1;
        const LAS float* biasT = biasL + h * 193 - 64;
        pg8::bf16x8 qr[4];
        { const bf16* qp = Q + (rowbase + r0 + r32) * D + h * HD + hi * 8;
#pragma unroll
          for (int d0 = 0; d0 < 4; ++d0) qr[d0] = *(const pg8::bf16x8*)(qp + d0 * 16); }
        const bf16* ksrc = K + (rowbase + lane) * D + h * HD + wave * 8;
        const bf16* vsrc = V + (rowbase + 16 * (wave & 3) + (lane >> 2)) * D + h * HD + (wave >> 2) * 32 + (lane & 3) * 8;
#define AT_DMA(g_, buf_) do { _Pragma("unroll") for (int j_ = 0; j_ < AT_TPS; ++j_) { const int kt_ = kt_top - AT_TPS * (g_) - j_; \
        __builtin_amdgcn_global_load_lds((const unsigned*)(ksrc + (size_t)kt_ * 64 * D), (LAS unsigned*)(L + (buf_) * AT_STAGE + j_ * 8192 + wave * 1024), 16, 0, 0); \
        __builtin_amdgcn_global_load_lds((const unsigned*)(vsrc + (size_t)kt_ * 64 * D), (LAS unsigned*)(L + (buf_) * AT_STAGE + AT_VOFF + j_ * 8192 + wave * 1024), 16, 0, 0); } } while (0)
        AT_DMA(0, 0);
        f32x16 o[2];
#pragma unroll
        for (int r = 0; r < 16; ++r) { o[0][r] = 0.f; o[1][r] = 0.f; }
        float prun = 1.0f, mrun = -INFINITY, lrun = 0.f;
        bool done = false;
        for (int g = 0; g < nstage; ++g) {
            const int buf = g & 1;
            asm volatile("s_waitcnt vmcnt(0)" ::: "memory");
            if (MODE == 0) { if (lane == 0) act[buf * 8 + wave] = done ? 0u : 1u; }
            asm volatile("s_waitcnt lgkmcnt(0)" ::: "memory");
            __syncthreads();
            if (MODE == 0) { unsigned any = 0;
#pragma unroll
                for (int w = 0; w < 8; ++w) any |= act[buf * 8 + w];
                if (!any) break; }
            if (g + 1 < nstage) AT_DMA(g + 1, buf ^ 1);
#pragma nounroll
            for (int j = 0; j < AT_TPS; ++j) {
                const int kt = kt_top - AT_TPS * g - j;
                if (kt <= cw && kt >= lo_w && !done) {
                const unsigned kb = (unsigned)(uintptr_t)(L + buf * AT_STAGE + j * 8192) + klane;
                f32x16 p0, p1;
                { const float cinit = (MODE == 1 && cw - kt >= 3) ? biasT[256] : 0.f;
#pragma unroll
                  for (int r = 0; r < 16; ++r) { p0[r] = cinit; p1[r] = cinit; } }
                pg8::bf16x8 kfr[8];
#pragma unroll
                for (int d0 = 0; d0 < 4; ++d0) { kfr[2 * d0] = *(const LAS pg8::bf16x8*)(uintptr_t)(kb + d0 * 2048); kfr[2 * d0 + 1] = *(const LAS pg8::bf16x8*)(uintptr_t)(kb + d0 * 2048 + 512); }
                __builtin_amdgcn_sched_barrier(0);
#pragma unroll
                for (int d0 = 0; d0 < 4; ++d0) { p0 = __builtin_amdgcn_mfma_f32_32x32x16_bf16(kfr[2 * d0], qr[d0], p0, 0, 0, 0); p1 = __builtin_amdgcn_mfma_f32_32x32x16_bf16(kfr[2 * d0 + 1], qr[d0], p1, 0, 0, 0); }
                if (MODE == 0) {
                    float F0[16], F1[16];
#pragma unroll
                    for (int r = 0; r < 16; ++r) { F0[r] = pg8::rcp(1.0f + pg8::ex2(p0[r])); F1[r] = pg8::rcp(1.0f + pg8::ex2(p1[r])); }
                    if (kt == cw) { const int kbase = 64 * kt + 4 * hi;
#pragma unroll
                        for (int r = 0; r < 16; ++r) { const int kv = kbase + (r & 3) + 8 * (r >> 2); if (kv >= t) F0[r] = 1.0f; if (kv + 32 >= t) F1[r] = 1.0f; } }
                    float g0[8], g1[8], E[8];
#pragma unroll
                    for (int i = 0; i < 4; ++i) { const float ga = fmul_s(fmul_s(F0[4 * i], F0[4 * i + 1]), fmul_s(F0[4 * i + 2], F0[4 * i + 3])), gb = fmul_s(fmul_s(F1[4 * i], F1[4 * i + 1]), fmul_s(F1[4 * i + 2], F1[4 * i + 3]));
                        auto ra = __builtin_amdgcn_permlane32_swap(__float_as_uint(ga), __float_as_uint(ga), false, false); g0[i] = __uint_as_float(ra[0]); g1[i] = __uint_as_float(ra[1]);
                        auto rb = __builtin_amdgcn_permlane32_swap(__float_as_uint(gb), __float_as_uint(gb), false, false); g0[4 + i] = __uint_as_float(rb[0]); g1[4 + i] = __uint_as_float(rb[1]); }
                    float run = prun;
#pragma unroll
                    for (int x = 1; x >= 0; --x)
#pragma unroll
                        for (int i = 3; i >= 0; --i) {
                            const float E1 = run; run *= g1[4 * x + i]; const float E0 = run; run *= g0[4 * x + i]; E[4 * x + i] = hi ? E1 : E0; }
                    prun = run;
#pragma unroll
                    for (int i = 0; i < 4; ++i) { float w = E[i];
#pragma unroll
                        for (int j = 3; j >= 0; --j) { const float wn = fmul_s(w, F0[4 * i + j]); p0[4 * i + j] = fsub_s(w, wn); w = wn; }
                        w = E[4 + i];
#pragma unroll
                        for (int j = 3; j >= 0; --j) { const float wn = fmul_s(w, F1[4 * i + j]); p1[4 * i + j] = fsub_s(w, wn); w = wn; } }
                    done = !__any(prun > 1.0e-16f);
                } else {
                    if (cw - kt < 3) { const int base = t - 64 * kt - 4 * hi;
#pragma unroll
                        for (int r = 0; r < 16; ++r) { int i0 = base - ((r & 3) + 8 * (r >> 2)); int i1 = i0 - 32;
                            i0 = min(max(i0, -128), 128); i1 = min(max(i1, -128), 128);
                            p0[r] += biasT[i0 + 128]; p1[r] += biasT[i1 + 128]; } }
                    float mx = fmaxf(p0[0], p1[0]);
#pragma unroll
                    for (int r = 1; r < 16; ++r) mx = fmaxf(mx, fmaxf(p0[r], p1[r]));
                    { auto rr = __builtin_amdgcn_permlane32_swap(__float_as_uint(mx), __float_as_uint(mx), false, false); mx = fmaxf(__uint_as_float(rr[0]), __uint_as_float(rr[1])); }
                    const float mnew = fmaxf(mrun, mx), alpha = pg8::ex2(mrun - mnew); mrun = mnew;
                    float ls = 0.f;
#pragma unroll
                    for (int r = 0; r < 16; ++r) { p0[r] = pg8::ex2(p0[r] - mnew); p1[r] = pg8::ex2(p1[r] - mnew); ls += p0[r] + p1[r]; }
                    lrun = lrun * alpha + ls;
                    if (kt != cw) { if (hi == 0) wsf[r32] = alpha; asm volatile("s_waitcnt lgkmcnt(0)" ::: "memory");
#pragma unroll
                        for (int r = 0; r < 16; ++r) { const float f = wsf[crow(r, hi)]; o[0][r] *= f; o[1][r] *= f; }
                        asm volatile("s_waitcnt lgkmcnt(0)" ::: "memory"); }
                }
                pg8::u32x4 pw0, pw1, pw2, pw3;
                pw0 = (pg8::u32x4){cvtpk_s(p0[0], p0[1]), cvtpk_s(p0[2], p0[3]), cvtpk_s(p0[4], p0[5]), cvtpk_s(p0[6], p0[7])};
                pw1 = (pg8::u32x4){cvtpk_s(p0[8], p0[9]), cvtpk_s(p0[10], p0[11]), cvtpk_s(p0[12], p0[13]), cvtpk_s(p0[14], p0[15])};
                pw2 = (pg8::u32x4){cvtpk_s(p1[0], p1[1]), cvtpk_s(p1[2], p1[3]), cvtpk_s(p1[4], p1[5]), cvtpk_s(p1[6], p1[7])};
                pw3 = (pg8::u32x4){cvtpk_s(p1[8], p1[9]), cvtpk_s(p1[10], p1[11]), cvtpk_s(p1[12], p1[13]), cvtpk_s(p1[14], p1[15])};
                pv_tile(o, (unsigned)(uintptr_t)(L + buf * AT_STAGE + AT_VOFF + j * 8192) + vlane, __builtin_bit_cast(pg8::bf16x8, pw0), __builtin_bit_cast(pg8::bf16x8, pw1), __builtin_bit_cast(pg8::bf16x8, pw2), __builtin_bit_cast(pg8::bf16x8, pw3));
                }
            }
        }
#undef AT_DMA
        VM_WAIT(); LDS_WAIT();
        __syncthreads();
        float sc[16];
#pragma unroll
        for (int r = 0; r < 16; ++r) sc[r] = 1.0f;
        if (MODE == 1) { float lt; { auto rr = __builtin_amdgcn_permlane32_swap(__float_as_uint(lrun), __float_as_uint(lrun), false, false); lt = __uint_as_float(rr[0]) + __uint_as_float(rr[1]); }
            if (hi == 0) wsf[r32] = pg8::rcp(lt); asm volatile("s_waitcnt lgkmcnt(0)" ::: "memory");
#pragma unroll
            for (int r = 0; r < 16; ++r) sc[r] = wsf[crow(r, hi)];
            asm volatile("s_waitcnt lgkmcnt(0)" ::: "memory"); }
#pragma unroll
        for (int r = 0; r < 16; ++r) { const int q = crow(r, hi); stg[q * 64 + r32] = bf1(o[0][r] * sc[r]); stg[q * 64 + 32 + r32] = bf1(o[1][r] * sc[r]); }
        LDS_WAIT();
        bf16* op = O + (rowbase + r0) * D + h * HD;
#pragma unroll
        for (int i = 0; i < 4; ++i) { const int row = i * 8 + (lane >> 3), ch = lane & 7; const v4u v = *(const LAS v4u*)(stg + row * 64 + ch * 8); *(v4u*)(op + (size_t)row * D + ch * 8) = v; }
        LDS_WAIT();
        __syncthreads();
    }
    LDS_WAIT(); VM_WAIT();
}

constexpr int SB_NT0 = 6, SB_VA = SB_NT0 * 8192, SB_B = 2 * SB_NT0 * 8192, SB_BV = SB_B + 16384;
__device__ __forceinline__ void attn_sb_phase(const bf16* __restrict__ Q, const bf16* __restrict__ K, const bf16* __restrict__ V, bf16* __restrict__ O, LAS unsigned char* L, int vcu, int G, int wave, int lane, int tid) {
    constexpr int MODE = 0;
    volatile LAS unsigned* act = (volatile LAS unsigned*)(L + XTRA_OFF);
    LAS bf16* stg = (LAS bf16*)(L + SB_B + wave * 4096);
    const LAS float* biasT = nullptr; LAS float* wsf = nullptr; (void)biasT; (void)wsf;
    const int r32 = lane & 31, hi = lane >> 5;
    const unsigned vlane = ((lane >> 4) & 1) * 32 + (lane & 3) * 8 + (4 * hi + ((lane & 15) >> 2)) * 64;
    const unsigned klane = hi * 1024 + r32 * 16;
    __syncthreads();
#define SB_UNIT(idx_, b_, h_, qb_) const int bh_ = (idx_) >> 3; qb_ = (((idx_) & 7) + ((idx_) >> 8)) & 7; b_ = bh_ >> 4; h_ = bh_ & 15
#define SB_DMA1(kt_, koff_, voff_) do { __builtin_amdgcn_global_load_lds((const unsigned*)(ksrc + (size_t)(kt_) * 64 * D), (LAS unsigned*)(L + (koff_) + wave * 1024), 16, 0, 0); \
        __builtin_amdgcn_global_load_lds((const unsigned*)(vsrc + (size_t)(kt_) * 64 * D), (LAS unsigned*)(L + (voff_) + wave * 1024), 16, 0, 0); } while (0)
    int idx = vcu; if (idx >= NB * NHEAD * 8) return;
    int b, h, qb; { SB_UNIT(idx, b, h, qb); }
    pg8::bf16x8 qr[4];
    const bf16* ksrc; const bf16* vsrc;
    { const size_t rowbase = (size_t)b * SEQ; const int r0 = 256 * qb + 32 * wave;
      const bf16* qp = Q + (rowbase + r0 + r32) * D + h * HD + hi * 8;
#pragma unroll
      for (int d0 = 0; d0 < 4; ++d0) qr[d0] = *(const pg8::bf16x8*)(qp + d0 * 16);
      ksrc = K + (rowbase + lane) * D + h * HD + wave * 8; vsrc = V + (rowbase + 16 * (wave & 3) + (lane >> 2)) * D + h * HD + (wave >> 2) * 32 + (lane & 3) * 8;
#pragma unroll
      for (int j = 0; j < SB_NT0; ++j) { const int kt = 4 * qb + 3 - j; if (kt >= 0) SB_DMA1(kt, j * 8192, SB_VA + j * 8192); } }
    for (;;) {
        const size_t rowbase = (size_t)b * SEQ;
        const int cw = 4 * qb + (wave >> 1), r0 = 256 * qb + 32 * wave, t = r0 + r32, kt_top = 4 * qb + 3;
        f32x16 o[2];
#pragma unroll
        for (int r = 0; r < 16; ++r) { o[0][r] = 0.f; o[1][r] = 0.f; }
        float prun = 1.0f, mrun = 0.f, lrun = 0.f; (void)mrun; (void)lrun;
        bool done = false;
        asm volatile("s_waitcnt vmcnt(0)" ::: "memory");
        __syncthreads();
        { const int kt_end = kt_top - (SB_NT0 - 1) > 0 ? kt_top - (SB_NT0 - 1) : 0;
#pragma nounroll
          for (int kt = cw; kt >= kt_end; --kt) {
            if (!done) { const int kslot = (kt_top - kt) * 8192, vslot = SB_VA + (kt_top - kt) * 8192;
                const unsigned kb = (unsigned)(uintptr_t)(L + kslot) + klane;
                f32x16 p0, p1;
                { const float cinit = (MODE == 1 && cw - kt >= 3) ? biasT[256] : 0.f;
#pragma unroll
                  for (int r = 0; r < 16; ++r) { p0[r] = cinit; p1[r] = cinit; } }
                pg8::bf16x8 kfr[8];
#pragma unroll
                for (int d0 = 0; d0 < 4; ++d0) { kfr[2 * d0] = *(const LAS pg8::bf16x8*)(uintptr_t)(kb + d0 * 2048); kfr[2 * d0 + 1] = *(const LAS pg8::bf16x8*)(uintptr_t)(kb + d0 * 2048 + 512); }
                __builtin_amdgcn_sched_barrier(0);
#pragma unroll
                for (int d0 = 0; d0 < 4; ++d0) { p0 = __builtin_amdgcn_mfma_f32_32x32x16_bf16(kfr[2 * d0], qr[d0], p0, 0, 0, 0); p1 = __builtin_amdgcn_mfma_f32_32x32x16_bf16(kfr[2 * d0 + 1], qr[d0], p1, 0, 0, 0); }
                if (MODE == 0) {
                    float F0[16], F1[16];
#pragma unroll
                    for (int r = 0; r < 16; ++r) { F0[r] = pg8::rcp(1.0f + pg8::ex2(p0[r])); F1[r] = pg8::rcp(1.0f + pg8::ex2(p1[r])); }
                    if (kt == cw) { const int kbase = 64 * kt + 4 * hi;
#pragma unroll
                        for (int r = 0; r < 16; ++r) { const int kv = kbase + (r & 3) + 8 * (r >> 2); if (kv >= t) F0[r] = 1.0f; if (kv + 32 >= t) F1[r] = 1.0f; } }
                    float g0[8], g1[8], E[8];
#pragma unroll
                    for (int i = 0; i < 4; ++i) { const float ga = fmul_s(fmul_s(F0[4 * i], F0[4 * i + 1]), fmul_s(F0[4 * i + 2], F0[4 * i + 3])), gb = fmul_s(fmul_s(F1[4 * i], F1[4 * i + 1]), fmul_s(F1[4 * i + 2], F1[4 * i + 3]));
                        auto ra = __builtin_amdgcn_permlane32_swap(__float_as_uint(ga), __float_as_uint(ga), false, false); g0[i] = __uint_as_float(ra[0]); g1[i] = __uint_as_float(ra[1]);
                        auto rb = __builtin_amdgcn_permlane32_swap(__float_as_uint(gb), __float_as_uint(gb), false, false); g0[4 + i] = __uint_as_float(rb[0]); g1[4 + i] = __uint_as_float(rb[1]); }
                    float run = prun;
#pragma unroll
                    for (int x = 1; x >= 0; --x)
#pragma unroll
                        for (int i = 3; i >= 0; --i) {
                            const float E1 = run; run *= g1[4 * x + i]; const float E0 = run; run *= g0[4 * x + i]; E[4 * x + i] = hi ? E1 : E0; }
                    prun = run;
#pragma unroll
                    for (int i = 0; i < 4; ++i) { float w = E[i];
#pragma unroll
                        for (int j = 3; j >= 0; --j) { const float wn = fmul_s(w, F0[4 * i + j]); p0[4 * i + j] = fsub_s(w, wn); w = wn; }
                        w = E[4 + i];
#pragma unroll
                        for (int j = 3; j >= 0; --j) { const float wn = fmul_s(w, F1[4 * i + j]); p1[4 * i + j] = fsub_s(w, wn); w = wn; } }
                    done = !__any(prun > 1.0e-16f);
                } else {
                    if (cw - kt < 3) { const int base = t - 64 * kt - 4 * hi;
#pragma unroll
                        for (int r = 0; r < 16; ++r) { int i0 = base - ((r & 3) + 8 * (r >> 2)); int i1 = i0 - 32;
                            i0 = min(max(i0, -128), 128); i1 = min(max(i1, -128), 128);
                            p0[r] += biasT[i0 + 128]; p1[r] += biasT[i1 + 128]; } }
                    float mx = fmaxf(p0[0], p1[0]);
#pragma unroll
                    for (int r = 1; r < 16; ++r) mx = fmaxf(mx, fmaxf(p0[r], p1[r]));
                    { auto rr = __builtin_amdgcn_permlane32_swap(__float_as_uint(mx), __float_as_uint(mx), false, false); mx = fmaxf(__uint_as_float(rr[0]), __uint_as_float(rr[1])); }
                    const float mnew = fmaxf(mrun, mx), alpha = pg8::ex2(mrun - mnew); mrun = mnew;
                    float ls = 0.f;
#pragma unroll
                    for (int r = 0; r < 16; ++r) { p0[r] = pg8::ex2(p0[r] - mnew); p1[r] = pg8::ex2(p1[r] - mnew); ls += p0[r] + p1[r]; }
                    lrun = lrun * alpha + ls;
                    if (kt != cw) { if (hi == 0) wsf[r32] = alpha; asm volatile("s_waitcnt lgkmcnt(0)" ::: "memory");
#pragma unroll
                        for (int r = 0; r < 16; ++r) { const float f = wsf[crow(r, hi)]; o[0][r] *= f; o[1][r] *= f; }
                        asm volatile("s_waitcnt lgkmcnt(0)" ::: "memory"); }
                }
                pg8::u32x4 pw0, pw1, pw2, pw3;
                pw0 = (pg8::u32x4){cvtpk_s(p0[0], p0[1]), cvtpk_s(p0[2], p0[3]), cvtpk_s(p0[4], p0[5]), cvtpk_s(p0[6], p0[7])};
                pw1 = (pg8::u32x4){cvtpk_s(p0[8], p0[9]), cvtpk_s(p0[10], p0[11]), cvtpk_s(p0[12], p0[13]), cvtpk_s(p0[14], p0[15])};
                pw2 = (pg8::u32x4){cvtpk_s(p1[0], p1[1]), cvtpk_s(p1[2], p1[3]), cvtpk_s(p1[4], p1[5]), cvtpk_s(p1[6], p1[7])};
                pw3 = (pg8::u32x4){cvtpk_s(p1[8], p1[9]), cvtpk_s(p1[10], p1[11]), cvtpk_s(p1[12], p1[13]), cvtpk_s(p1[14], p1[15])};
                pv_tile(o, (unsigned)(uintptr_t)(L + vslot) + vlane, __builtin_bit_cast(pg8::bf16x8, pw0), __builtin_bit_cast(pg8::bf16x8, pw1), __builtin_bit_cast(pg8::bf16x8, pw2), __builtin_bit_cast(pg8::bf16x8, pw3));
            }
          } }
        int ktn = kt_top - SB_NT0; int par = 0;
        for (;;) {
            if (lane == 0) act[par * 8 + wave] = (done || ktn < 0) ? 0u : 1u;
            asm volatile("s_waitcnt lgkmcnt(0)" ::: "memory");
            __syncthreads();
            unsigned any = 0;
#pragma unroll
            for (int w = 0; w < 8; ++w) any |= act[par * 8 + w];
            par ^= 1;
            if (!any) break;
            SB_DMA1(ktn, SB_B, SB_BV); if (ktn >= 1) SB_DMA1(ktn - 1, SB_B + 8192, SB_BV + 8192);
            asm volatile("s_waitcnt vmcnt(0)" ::: "memory");
            __syncthreads();
#pragma nounroll
            for (int j = 0; j < 2; ++j) { const int kt = ktn - j;
                if (kt >= 0 && !done) { const int kslot = SB_B + j * 8192, vslot = SB_BV + j * 8192;
                const unsigned kb = (unsigned)(uintptr_t)(L + kslot) + klane;
                f32x16 p0, p1;
                { const float cinit = (MODE == 1 && cw - kt >= 3) ? biasT[256] : 0.f;
#pragma unroll
                  for (int r = 0; r < 16; ++r) { p0[r] = cinit; p1[r] = cinit; } }
                pg8::bf16x8 kfr[8];
#pragma unroll
                for (int d0 = 0; d0 < 4; ++d0) { kfr[2 * d0] = *(const LAS pg8::bf16x8*)(uintptr_t)(kb + d0 * 2048); kfr[2 * d0 + 1] = *(const LAS pg8::bf16x8*)(uintptr_t)(kb + d0 * 2048 + 512); }
                __builtin_amdgcn_sched_barrier(0);
#pragma unroll
                for (int d0 = 0; d0 < 4; ++d0) { p0 = __builtin_amdgcn_mfma_f32_32x32x16_bf16(kfr[2 * d0], qr[d0], p0, 0, 0, 0); p1 = __builtin_amdgcn_mfma_f32_32x32x16_bf16(kfr[2 * d0 + 1], qr[d0], p1, 0, 0, 0); }
                if (MODE == 0) {
                    float F0[16], F1[16];
#pragma unroll
                    for (int r = 0; r < 16; ++r) { F0[r] = pg8::rcp(1.0f + pg8::ex2(p0[r])); F1[r] = pg8::rcp(1.0f + pg8::ex2(p1[r])); }
                    if (kt == cw) { const int kbase = 64 * kt + 4 * hi;
#pragma unroll
                        for (int r = 0; r < 16; ++r) { const int kv = kbase + (r & 3) + 8 * (r >> 2); if (kv >= t) F0[r] = 1.0f; if (kv + 32 >= t) F1[r] = 1.0f; } }
                    float g0[8], g1[8], E[8];
#pragma unroll
                    for (int i = 0; i < 4; ++i) { const float ga = fmul_s(fmul_s(F0[4 * i], F0[4 * i + 1]), fmul_s(F0[4 * i + 2], F0[4 * i + 3])), gb = fmul_s(fmul_s(F1[4 * i], F1[4 * i + 1]), fmul_s(F1[4 * i + 2], F1[4 * i + 3]));
                        auto ra = __builtin_amdgcn_permlane32_swap(__float_as_uint(ga), __float_as_uint(ga), false, false); g0[i] = __uint_as_float(ra[0]); g1[i] = __uint_as_float(ra[1]);
                        auto rb = __builtin_amdgcn_permlane32_swap(__float_as_uint(gb), __float_as_uint(gb), false, false); g0[4 + i] = __uint_as_float(rb[0]); g1[4 + i] = __uint_as_float(rb[1]); }
                    float run = prun;
#pragma unroll
                    for (int x = 1; x >= 0; --x)
#pragma unroll
                        for (int i = 3; i >= 0; --i) {
                            const float E1 = run; run *= g1[4 * x + i]; const float E0 = run; run *= g0[4 * x + i]; E[4 * x + i] = hi ? E1 : E0; }
                    prun = run;
#pragma unroll
                    for (int i = 0; i < 4; ++i) { float w = E[i];
#pragma unroll
                        for (int j = 3; j >= 0; --j) { const float wn = fmul_s(w, F0[4 * i + j]); p0[4 * i + j] = fsub_s(w, wn); w = wn; }
                        w = E[4 + i];
#pragma unroll
                        for (int j = 3; j >= 0; --j) { const float wn = fmul_s(w, F1[4 * i + j]); p1[4 * i + j] = fsub_s(w, wn); w = wn; } }
                    done = !__any(prun > 1.0e-16f);
                } else {
                    if (cw - kt < 3) { const int base = t - 64 * kt - 4 * hi;
#pragma unroll
                        for (int r = 0; r < 16; ++r) { int i0 = base - ((r & 3) + 8 * (r >> 2)); int i1 = i0 - 32;
                            i0 = min(max(i0, -128), 128); i1 = min(max(i1, -128), 128);
                            p0[r] += biasT[i0 + 128]; p1[r] += biasT[i1 + 128]; } }
                    float mx = fmaxf(p0[0], p1[0]);
#pragma unroll
                    for (int r = 1; r < 16; ++r) mx = fmaxf(mx, fmaxf(p0[r], p1[r]));
                    { auto rr = __builtin_amdgcn_permlane32_swap(__float_as_uint(mx), __float_as_uint(mx), false, false); mx = fmaxf(__uint_as_float(rr[0]), __uint_as_float(rr[1])); }
                    const float mnew = fmaxf(mrun, mx), alpha = pg8::ex2(mrun - mnew); mrun = mnew;
                    float ls = 0.f;
#pragma unroll
                    for (int r = 0; r < 16; ++r) { p0[r] = pg8::ex2(p0[r] - mnew); p1[r] = pg8::ex2(p1[r] - mnew); ls += p0[r] + p1[r]; }
                    lrun = lrun * alpha + ls;
                    if (kt != cw) { if (hi == 0) wsf[r32] = alpha; asm volatile("s_waitcnt lgkmcnt(0)" ::: "memory");
#pragma unroll
                        for (int r = 0; r < 16; ++r) { const float f = wsf[crow(r, hi)]; o[0][r] *= f; o[1][r] *= f; }
                        asm volatile("s_waitcnt lgkmcnt(0)" ::: "memory"); }
                }
                pg8::u32x4 pw0, pw1, pw2, pw3;
                pw0 = (pg8::u32x4){cvtpk_s(p0[0], p0[1]), cvtpk_s(p0[2], p0[3]), cvtpk_s(p0[4], p0[5]), cvtpk_s(p0[6], p0[7])};
                pw1 = (pg8::u32x4){cvtpk_s(p0[8], p0[9]), cvtpk_s(p0[10], p0[11]), cvtpk_s(p0[12], p0[13]), cvtpk_s(p0[14], p0[15])};
                pw2 = (pg8::u32x4){cvtpk_s(p1[0], p1[1]), cvtpk_s(p1[2], p1[3]), cvtpk_s(p1[4], p1[5]), cvtpk_s(p1[6], p1[7])};
                pw3 = (pg8::u32x4){cvtpk_s(p1[8], p1[9]), cvtpk_s(p1[10], p1[11]), cvtpk_s(p1[12], p1[13]), cvtpk_s(p1[14], p1[15])};
                pv_tile(o, (unsigned)(uintptr_t)(L + vslot) + vlane, __builtin_bit_cast(pg8::bf16x8, pw0), __builtin_bit_cast(pg8::bf16x8, pw1), __builtin_bit_cast(pg8::bf16x8, pw2), __builtin_bit_cast(pg8::bf16x8, pw3));
                } }
            ktn -= 2;
        }
        const int idx_n = idx + G; const bool more = idx_n < NB * NHEAD * 8;
        int bn = 0, hn = 0, qbn = 0; pg8::bf16x8 qn[4];
        if (more) { SB_UNIT(idx_n, bn, hn, qbn); const size_t rbn = (size_t)bn * SEQ;
            const bf16* qp = Q + (rbn + 256 * qbn + 32 * wave + r32) * D + hn * HD + hi * 8;
#pragma unroll
            for (int d0 = 0; d0 < 4; ++d0) qn[d0] = *(const pg8::bf16x8*)(qp + d0 * 16);
            ksrc = K + (rbn + lane) * D + hn * HD + wave * 8; vsrc = V + (rbn + 16 * (wave & 3) + (lane >> 2)) * D + hn * HD + (wave >> 2) * 32 + (lane & 3) * 8;
#pragma unroll
            for (int j = 0; j < SB_NT0; ++j) { const int kt = 4 * qbn + 3 - j; if (kt >= 0) SB_DMA1(kt, j * 8192, SB_VA + j * 8192); } }
#pragma unroll
        for (int r = 0; r < 16; ++r) { const int q = crow(r, hi); stg[q * 64 + r32] = bf1(o[0][r]); stg[q * 64 + 32 + r32] = bf1(o[1][r]); }
        LDS_WAIT();
        bf16* op = O + (rowbase + r0) * D + h * HD;
#pragma unroll
        for (int i = 0; i < 4; ++i) { const int row = i * 8 + (lane >> 3), ch = lane & 7; const v4u v = *(const LAS v4u*)(stg + row * 64 + ch * 8); *(v4u*)(op + (size_t)row * D + ch * 8) = v; }
        LDS_WAIT();
        if (!more) break;
        idx = idx_n; b = bn; h = hn; qb = qbn;
#pragma unroll
        for (int d0 = 0; d0 < 4; ++d0) qr[d0] = qn[d0];
    }
#undef SB_UNIT
#undef SB_DMA1
    VM_WAIT(); LDS_WAIT(); __syncthreads();
}

constexpr int SP_VBUF = 32768, SP_GATE = 65536, SP_GPITCH = 136;
__device__ __forceinline__ void spatial_phase(bf16* U, const bf16* Vb, const float* vpart, const float* ws, const float* bs, const float* vg, LAS unsigned char* L, int vcu, int G, int wave, int lane, int tid) {
    LAS float* psum = (LAS float*)(L + XTRA_OFF);
    LAS float* rstdL = psum + 512;
    LAS bf16* gateT = (LAS bf16*)(L + SP_GATE);
    const int r32 = lane & 31, hi = lane >> 5, ib = wave & 3, cbw = wave >> 2;
    const unsigned vlane = ((lane >> 4) & 1) * 32 + (lane & 3) * 8 + (4 * hi + ((lane & 15) >> 2)) * 64;
    const int njt = ib < 2 ? 1 : 2;
    for (int win = vcu; win < NB * 16; win += G) {
        const size_t tok0 = (size_t)win * 128;
        { const int j = tid & 127, part = tid >> 7; const f32x4* p = (const f32x4*)(vpart + (tok0 + j) * 48 + part * 12); const f32x4 a = p[0], c = p[1], d = p[2];
          psum[part * 128 + j] = ((a[0] + a[1]) + (a[2] + a[3])) + ((c[0] + c[1]) + (c[2] + c[3])) + ((d[0] + d[1]) + (d[2] + d[3])); }
        __syncthreads();
        if (tid < 128) rstdL[tid] = __builtin_amdgcn_rsqf(((psum[tid] + psum[128 + tid]) + (psum[256 + tid] + psum[384 + tid])) * (1.0f / SGH) + EPSN);
        __syncthreads();
        const bf16* vsrc0 = Vb + (tok0 + 64 * ((wave >> 1) & 1) + (lane >> 2)) * SGH + (wave >> 2) * 64 + (wave & 1) * 32 + (lane & 3) * 8;
        const int vdst0 = (wave >> 2) * 16384 + ((wave >> 1) & 1) * 8192 + (wave & 1) * 4096;
#define SP_DMA(c0_, buf_) do { _Pragma("unroll") for (int k = 0; k < 4; ++k) \
        __builtin_amdgcn_global_load_lds((const unsigned*)(vsrc0 + (size_t)(16 * k) * SGH + (c0_)), (LAS unsigned*)(L + (buf_) * SP_VBUF + vdst0 + k * 1024), 16, 0, 0); } while (0)
        SP_DMA(0, 0);
        pg8::u32x4 pw[2][4]; float bsv[16];
        for (int u = 0; u < 24; ++u) {
            const int g = u / 3, c0 = g * 384 + (u - 3 * g) * 128, buf = u & 1;
            if (u == 0) asm volatile("s_waitcnt vmcnt(0)" ::: "memory");
            else asm volatile("s_waitcnt vmcnt(8)" ::: "memory");
            __syncthreads();
            if (u + 1 < 24) { const int g1 = (u + 1) / 3; SP_DMA(g1 * 384 + (u + 1 - 3 * g1) * 128, buf ^ 1); }
            asm volatile("" ::: "memory");
            v4u uv[4];
#pragma unroll
            for (int k = 0; k < 4; ++k) { const int q = tid + 512 * k; uv[k] = *(const v4u*)(U + (tok0 + (q >> 4)) * SGH + c0 + (q & 15) * 8); }
            if (u == 3 * g) {
#pragma unroll
                for (int jt = 0; jt < 2; ++jt) if (jt < njt) {
                    const float* wrow = ws + ((size_t)g * 128 + 32 * ib + r32) * 128 + 64 * jt + 4 * hi;
#pragma unroll
                    for (int ks = 0; ks < 4; ++ks) { const f32x4 wa = *(const f32x4*)(wrow + 16 * ks), wb = *(const f32x4*)(wrow + 16 * ks + 8);
                        const f32x4 ra = *(const LAS f32x4*)(rstdL + 64 * jt + 16 * ks + 4 * hi), rb = *(const LAS f32x4*)(rstdL + 64 * jt + 16 * ks + 4 * hi + 8);
                        pw[jt][ks] = pg8::pack8(wa * ra, wb * rb); } }
#pragma unroll
                for (int r = 0; r < 16; ++r) bsv[r] = bs[g * 128 + 32 * ib + crow(r, hi)];
            }
            const float vg0 = vg[c0 + cbw * 64 + r32], vg1 = vg[c0 + cbw * 64 + 32 + r32];
            f32x16 o[2];
#pragma unroll
            for (int r = 0; r < 16; ++r) { o[0][r] = 0.f; o[1][r] = 0.f; }
            const unsigned vb = (unsigned)(uintptr_t)(L + buf * SP_VBUF + cbw * 16384) + vlane;
            pv_tile(o, vb, __builtin_bit_cast(pg8::bf16x8, pw[0][0]), __builtin_bit_cast(pg8::bf16x8, pw[0][1]), __builtin_bit_cast(pg8::bf16x8, pw[0][2]), __builtin_bit_cast(pg8::bf16x8, pw[0][3]));
            if (njt == 2) pv_tile(o, vb + 8192, __builtin_bit_cast(pg8::bf16x8, pw[1][0]), __builtin_bit_cast(pg8::bf16x8, pw[1][1]), __builtin_bit_cast(pg8::bf16x8, pw[1][2]), __builtin_bit_cast(pg8::bf16x8, pw[1][3]));
#pragma unroll
            for (int r = 0; r < 16; ++r) { LAS bf16* gp = gateT + (32 * ib + crow(r, hi)) * SP_GPITCH + cbw * 64 + r32;
                gp[0] = bf1(o[0][r] * vg0 + bsv[r]); gp[32] = bf1(o[1][r] * vg1 + bsv[r]); }
            LDS_WAIT(); __syncthreads();
#pragma unroll
            for (int k = 0; k < 4; ++k) { const int q = tid + 512 * k; const v4u gt = *(const LAS v4u*)(gateT + (q >> 4) * SP_GPITCH + (q & 15) * 8);
                v4u y;
#pragma unroll
                for (int e = 0; e < 4; ++e) y[e] = pg8::cvt_pk_bf16(bf_lo(uv[k][e]) * bf_lo(gt[e]), bf_hi(uv[k][e]) * bf_hi(gt[e]));
                *(v4u*)(U + (tok0 + (q >> 4)) * SGH + c0 + (q & 15) * 8) = y; }
        }
#undef SP_DMA
        VM_WAIT(); LDS_WAIT(); __syncthreads();
    }
}

struct Args { const float* in[26]; float* out; unsigned char* ws; };
enum { I_X = 0, I_C, I_NORMG, I_ADAW, I_ADAB, I_SBWQKV, I_SBQG, I_SBKG, I_SBWO, I_SGWIN, I_SGVG, I_SGWS, I_SGBS, I_SGWOUT, I_CAWQKV, I_CAQG, I_CAKG, I_CARELB, I_CAWO, I_FFW13, I_FFW2, I_MOEWR, I_MOEBR, I_MOEW1, I_MOEW3, I_MOEW2 };

#ifndef PHMASK
#define PHMASK 0xFFFFFFFFu
#endif
#define PH(k) (((PHMASK) >> (k)) & 1u)
__device__ __forceinline__ const void* karg(int byte_off) { const void* p; asm volatile("s_load_dwordx2 %0, %1, %2\n\ts_waitcnt lgkmcnt(0)" : "=s"(p) : "s"(__builtin_amdgcn_kernarg_segment_ptr()), "i"(byte_off) : "memory"); return p; }
#define KIN(i) (a.in[i])
#define KOUT (a.out)
#define KWS (a.ws)
#ifndef PROBEMASK
#define PROBEMASK 0u
#endif
#if PROBEMASK
#define TS_BEGIN() do { ts_b = __builtin_amdgcn_s_memrealtime(); asm volatile("" ::: "memory"); } while (0)
#define TS_END(k) do { asm volatile("" ::: "memory"); if (((PROBEMASK) >> (k)) & 1u) ts_sum += __builtin_amdgcn_s_memrealtime() - ts_b; } while (0)
#define TS_SPIN() do { if (blockIdx.x == 0 && threadIdx.x == 0) { const unsigned long long t0_ = __builtin_amdgcn_s_memrealtime(); while (__builtin_amdgcn_s_memrealtime() - t0_ < ts_sum) __builtin_amdgcn_s_sleep(8); } } while (0)
#else
#define TS_BEGIN() do {} while (0)
#define TS_END(k) do {} while (0)
#define TS_SPIN() do {} while (0)
#endif
__global__ void __launch_bounds__(NWAVES * 64, 2) fwd_kernel(Args a) {
    extern __shared__ __attribute__((aligned(16))) unsigned char lds[];
    LAS unsigned char* L = (LAS unsigned char*)lds;
    const int G = gridDim.x, bx = blockIdx.x, vcu = (G % 8 == 0) ? (bx % 8) * (G / 8) + bx / 8 : bx;
#define PHASE_IDS int tid = threadIdx.x; asm volatile("" : "+v"(tid)); const int lane = tid & 63, wave = __builtin_amdgcn_readfirstlane(tid >> 6); const int gwi = wave * G + vcu, NGW = G * NWAVES; (void)gwi; (void)NGW; (void)lane
    volatile LAS unsigned* MISC = (volatile LAS unsigned*)(L + MISC_OFF);
    if (threadIdx.x < 64) MISC[threadIdx.x] = 0u;
    __syncthreads();
#define mod ((float*)(KWS + WS_MOD))
#define gains ((float*)(KWS + WS_GAINS))
#define WQKV0 ((bf16*)(KWS + WS_WQKV0))
#define WQKV1 ((bf16*)(KWS + WS_WQKV1))
#define WQKVC ((bf16*)(KWS + WS_WQKVC))
#define WO0 ((bf16*)(KWS + WS_WO0))
#define WO1 ((bf16*)(KWS + WS_WO1))
#define WOC ((bf16*)(KWS + WS_WOC))
#define WIN ((bf16*)(KWS + WS_WIN))
#define WOUT ((bf16*)(KWS + WS_WOUT))
#define W13_0 ((bf16*)(KWS + WS_W13_0))
#define W13_1 ((bf16*)(KWS + WS_W13_1))
#define W2_0 ((bf16*)(KWS + WS_W2_0))
#define W2_1 ((bf16*)(KWS + WS_W2_1))
#define MOE13 ((bf16*)(KWS + WS_MOE13))
#define MOE2 ((bf16*)(KWS + WS_MOE2))
#define MOE2B ((bf16*)(KWS + WS_MOE2B))
#define cscale2b ((float*)(KWS + WS_CS + 476 * 1024))
#define H ((bf16*)(KWS + WS_H))
#define AS ((bf16*)(KWS + WS_AS))
#define YB ((bf16*)(KWS + WS_AS))
#define ACT ((bf16*)(KWS + WS_ACT))
#define Qb ACT
#define Kb (ACT + (size_t)MTOK * D)
#define Vb (ACT + (size_t)2 * MTOK * D)
#define Ub ACT
#define Vg (ACT + (size_t)MTOK * SGH)
#define rowinfo ((int*)(KWS + WS_ROWINFO))
#define troute ((int*)(KWS + WS_TROUTE))
#define tw ((float*)(KWS + WS_TW))
#define vpart ((float*)(KWS + WS_VPART))
#define cscale ((float*)(KWS + WS_CS))
#define cscale_d ((float*)(KWS + WS_CS + 256 * 1024))
#define cscale_q ((float*)(KWS + WS_CS + 320 * 1024))
#define cscale_w ((float*)(KWS + WS_CS + 384 * 1024))
#define cscale_o ((float*)(KWS + WS_CS + 448 * 1024))
#define Y8 ((unsigned char*)(KWS + WS_AS))
#define hscale ((float*)(KWS + WS_HSC))
#define rscale ((float*)(KWS + WS_RS))
#define X ((bf16*)(KWS + WS_XB))
#define x_in (KIN(I_X))
#define normg (KIN(I_NORMG))
#define ctl ((unsigned*)(KWS + WS_CTL))
    XcdBarrier bar = xcd_barrier_post(ctl + CW_BAR, MISC + 8);
#define GRID_BAR() xcd_barrier(bar)
#define MOE2_PHASE(cntp_, Bw_, csp_, layer_) { const LAS int* preL_ = (const LAS int*)(L + MISC_OFF + 64); pg8::moe_order_setup((LAS int*)(L + MISC_OFF + 64), cntp_); \
      const int total_ = __builtin_amdgcn_readfirstlane(preL_[8]) * (D / 256), nfull_ = (total_ / G) * G, T_ = total_ - nfull_; \
      const int S_ = T_ == 0 ? 1 : (T_ * 7 <= G ? 7 : (T_ * 2 <= G ? 2 : 1)); \
      pg8::MoeOrderLim S{preL_, D / 256, G, bx, S_ > 1 ? nfull_ : total_}; pg8::Gemm g{ACT, Bw_, 0, 0, DFE / 2, 0}; \
      pg8::EpiMoeOut E{YB, rowinfo, MTOK, csp_}; \
      pg8::gemm_phase<pg8::EpiMoeOut, pg8::MoeOrderLim, true, true, true, false>(L, g, S, E); \
      if (S_ > 1) { pg8::SplitOrder S2{preL_, D / 256, bx, nfull_, T_, S_, DFE / S_}; pg8::Gemm g2{ACT, Bw_, 0, 0, DFE / 2 / S_, DFE / 2}; \
          pg8::EpiMoeSplit E2{E, (float*)H, ctl + CW_SPLIT + (layer_) * 4096, S_}; \
          pg8::gemm_phase<pg8::EpiMoeSplit, pg8::SplitOrder, true, true, true, false>(L, g2, S2, E2); } }
    const float QS = 0.125f * LOG2E;
    unsigned long long ts_b = 0, ts_sum = 0; (void)ts_b; (void)ts_sum;

    TS_BEGIN();
    if (PH(0)) { PHASE_IDS;
        LAS float* cond = (LAS float*)L;
        const float* c = KIN(I_C);
        {   float cv[NB * D / (NWAVES * 64)];
#pragma unroll
            for (int i = 0; i < NB * D / (NWAVES * 64); ++i) cv[i] = c[tid + NWAVES * 64 * i];
#pragma unroll
            for (int i = 0; i < NB * D / (NWAVES * 64); ++i) { const int u = tid + NWAVES * 64 * i, b = u >> 10, k = u & (D - 1); const float v = cv[i]; cond[k * 16 + b] = v / (1.0f + __expf(-v)); } }
        if (bx == 0) for (int gi = tid; gi < 576; gi += NWAVES * 64) { const int set = gi / 192, w = (gi % 192) >> 6, d = gi & 63;
            float v = 1.0f;
            if (w < 2) { const float* src = set == 2 ? (w ? KIN(I_CAKG) : KIN(I_CAQG)) : (w ? KIN(I_SBKG) : KIN(I_SBQG)) + (set == 1 ? HD : 0); v = src[d] * (w ? 1.0f : QS); }
            gains[gi] = v; }
        if (bx == 1) for (int gi = tid; gi < 4 * D; gi += NWAVES * 64) cscale_o[gi] = 1.0f;
        __syncthreads();
        constexpr int C_MOD = 4 * 384, C_QKV = 3 * D / 32, C_WO = 16 * 16, C_WIN = 2 * SGH / 32, C_WOUT = 48 * 16, C_W13 = 2 * DFF / 32, C_W2 = D / 32;
        {
            LAS float* amx = (LAS float*)(L + XTRA_OFF);
            constexpr int WG_TOTAL = 3 * C_QKV + C_WIN + 2 * C_W13 + 2 * NEXP * IT_MOE8;
            int par = 0;
            for (int it = vcu; it < WG_TOTAL; it += G, par ^= 1) {
                int r = it, map = 1, nb = 0, N = 3 * D; const float* W = KIN(I_SBWQKV); unsigned char* dst = (unsigned char*)WQKV0; float* cs = cscale_q;
                if (r < C_QKV) { nb = r; }
                else if ((r -= C_QKV) < C_QKV) { nb = r; W = KIN(I_SBWQKV) + (size_t)D * 3 * D; dst = (unsigned char*)WQKV1; cs = cscale_q + 3 * D; }
                else if ((r -= C_QKV) < C_QKV) { nb = r; W = KIN(I_CAWQKV); dst = (unsigned char*)WQKVC; cs = cscale_q + 6 * D; }
                else if ((r -= C_QKV) < C_WIN) { nb = r; map = 0; N = 2 * SGH; W = KIN(I_SGWIN); dst = (unsigned char*)WIN; cs = cscale_w; }
                else if ((r -= C_WIN) < C_W13) { nb = r; map = 2; N = 2 * DFF; W = KIN(I_FFW13); dst = (unsigned char*)W13_0; cs = cscale_d; }
                else if ((r -= C_W13) < C_W13) { nb = r; map = 2; N = 2 * DFF; W = KIN(I_FFW13) + (size_t)D * 2 * DFF; dst = (unsigned char*)W13_1; cs = cscale_d + 2 * DFF; }
                else if ((r -= C_W13) < NEXP * IT_MOE8) { const int e = r / IT_MOE8; nb = r % IT_MOE8; map = 3; N = DFE; W = KIN(I_MOEW1) + (size_t)e * D * DFE; dst = (unsigned char*)MOE13 + (size_t)e * 2 * DFE * D; cs = cscale + e * 2 * DFE; }
                else { r -= NEXP * IT_MOE8; const int e = r / IT_MOE8; nb = r % IT_MOE8; map = 4; N = DFE; W = KIN(I_MOEW3) + (size_t)e * D * DFE; dst = (unsigned char*)MOE13 + (size_t)e * 2 * DFE * D; cs = cscale + e * 2 * DFE; }
                conv8_wg_item(map, nb, W, N, dst, cs, amx, par, wave, lane);
            }
        }
        __syncthreads();
        {
            LAS float* amx = (LAS float*)(L + XTRA_OFF);
            int par = 0;
            for (int it0 = vcu; it0 < NEXP * IT_MOE2 + ((2 * C_W2 + G - 1) / G) * G; it0 += G, par ^= 1) {
                int it = it0; if (it >= NEXP * IT_MOE2) { const int d = it0 - NEXP * IT_MOE2; it = NEXP * IT_MOE2 + (d % G + G - 64 % G) % G + (d / G) * G; if (it >= NEXP * IT_MOE2 + 2 * C_W2) continue; }
                if (it < NEXP * IT_MOE2) { const int e = it / IT_MOE2; convf8_wg_item<DFE>(it % IT_MOE2, KIN(I_MOEW2) + (size_t)e * DFE * D, D, (unsigned char*)MOE2 + (size_t)e * D * DFE, cscale + NEXP * 2 * DFE + e * D, amx, par, wave, lane); }
                else { const int r = it - NEXP * IT_MOE2, l = r / C_W2; convf8_wg_item<DFF>(r % C_W2, KIN(I_FFW2) + (size_t)l * DFF * D, D, (unsigned char*)W2_0 + (size_t)l * (WS_W2_1 - WS_W2_0), cscale_o + (4 + l) * D, amx, par, wave, lane); }
            }
        }
        constexpr int TOTAL = C_MOD + 3 * C_WO + C_WOUT;
        for (int it = gwi; it < TOTAL; it += NGW) {
            int r = it;
            if (r < C_MOD) { mod_item(r, KIN(I_ADAW), KIN(I_ADAB), mod, cond, lane); continue; } r -= C_MOD;
            if (r < C_WO) { conv_item<0>(r, KIN(I_SBWO), D, D, WO0, lane); continue; } r -= C_WO;
            if (r < C_WO) { conv_item<0>(r, KIN(I_SBWO) + (size_t)D * D, D, D, WO1, lane); continue; } r -= C_WO;
            if (r < C_WO) { conv_item<0>(r, KIN(I_CAWO), D, D, WOC, lane); continue; } r -= C_WO;
            conv_item<0>(r, KIN(I_SGWOUT), SGH, D, WOUT, lane);
        }
    }
    GRID_BAR();
    TS_END(0);

    TS_BEGIN();
    if (PH(1)) { PHASE_IDS; norm_phase<false, true, false, true, false>(x_in, nullptr, H, normg + 0 * D, mod + 0 * MODL, 0, nullptr, nullptr, nullptr, nullptr, nullptr, nullptr, nullptr, nullptr, hscale, L, vcu, G, wave, lane, tid); }
    GRID_BAR();
    TS_END(1);
    TS_BEGIN();
    if (PH(2)) { pg8::Gemm g{H, WQKV0, MTOK, 3 * D, D / 2}; pg8::StaticOrder S; S.init(MTOK, 3 * D, G, bx);
      pg8::EpiQKV E{Qb, gains + 0, hscale, cscale_q};
      pg8::gemm_phase<pg8::EpiQKV, pg8::StaticOrder, true, true, false, true>(L, g, S, E); }
    GRID_BAR();
    TS_END(2);
    TS_BEGIN();
    if (PH(3)) { PHASE_IDS; attn_sb_phase(Qb, Kb, Vb, H, L, vcu, G, wave, lane, tid); }
    GRID_BAR();
    TS_END(3);
    TS_BEGIN();
    if (PH(4)) { pg8::Gemm g{H, WO0, MTOK, D, D}; pg8::StaticOrder S; S.init(MTOK, D, G, bx);
      pg8::EpiResid16<true> E{x_in, X, mod + 0 * MODL + 2 * D, cscale_o};
      pg8::gemm_phase<pg8::EpiResid16<true>, pg8::StaticOrder, true, true>(L, g, S, E); }
    GRID_BAR();
    TS_END(4);
    TS_BEGIN();
    if (PH(1)) { PHASE_IDS; norm_phase<false, true, false, true>(X, nullptr, H, normg + 1 * D, mod + 0 * MODL, 3 * D, nullptr, nullptr, nullptr, nullptr, nullptr, nullptr, nullptr, nullptr, hscale, L, vcu, G, wave, lane, tid); }
    GRID_BAR();
    TS_END(1);
    TS_BEGIN();
    if (PH(5)) { pg8::Gemm g{H, W13_0, MTOK, 2 * DFF, D / 2}; pg8::StaticOrder S; S.init(MTOK, 2 * DFF, G, bx);
      pg8::EpiSwigluQ<true> E{ACT, DFF, 1 << 20, hscale, cscale_d};
      pg8::gemm_phase<pg8::EpiSwigluQ<true>, pg8::StaticOrder, true, true, false, true>(L, g, S, E); }
    GRID_BAR();
    TS_END(5);
    TS_BEGIN();
    if (PH(4)) { pg8::Gemm g{ACT, W2_0, MTOK, D, DFF / 2}; pg8::StaticOrder S; S.init(MTOK, D, G, bx);
      pg8::EpiResid16<false> E{X, X, mod + 0 * MODL + 5 * D, cscale_o + 4 * D};
      pg8::gemm_phase<pg8::EpiResid16<false>, pg8::StaticOrder, true, true, true, false>(L, g, S, E); }
    GRID_BAR();
    TS_END(4);

    TS_BEGIN();
    if (PH(1)) { PHASE_IDS; norm_phase<false, true, false, true>(X, nullptr, H, normg + 2 * D, mod + 1 * MODL, 0, nullptr, nullptr, nullptr, nullptr, nullptr, nullptr, nullptr, nullptr, hscale, L, vcu, G, wave, lane, tid); }
    GRID_BAR();
    TS_END(1);
    TS_BEGIN();
    if (PH(6)) { pg8::Gemm g{H, WIN, MTOK, 2 * SGH, D / 2}; pg8::StaticOrder S; S.init(MTOK, 2 * SGH, G, bx);
      pg8::EpiGeluSG E{Ub, Vg, vpart, hscale, cscale_w};
      pg8::gemm_phase<pg8::EpiGeluSG, pg8::StaticOrder, true, true, false, true>(L, g, S, E); }
    GRID_BAR();
    TS_END(6);
    TS_BEGIN();
    if (PH(7)) { PHASE_IDS; spatial_phase(Ub, Vg, vpart, KIN(I_SGWS), KIN(I_SGBS), KIN(I_SGVG), L, vcu, G, wave, lane, tid); }
    GRID_BAR();
    TS_END(7);
    TS_BEGIN();
    if (PH(4)) { pg8::Gemm g{Ub, WOUT, MTOK, D, SGH}; pg8::StaticOrder S; S.init(MTOK, D, G, bx);
      pg8::EpiResid16<false> E{X, X, mod + 1 * MODL + 2 * D, cscale_o + 3 * D};
      pg8::gemm_phase<pg8::EpiResid16<false>, pg8::StaticOrder, true, true>(L, g, S, E); }
    GRID_BAR();
    TS_END(4);
    TS_BEGIN();
    if (PH(8)) { PHASE_IDS; norm_phase<false, true, true>(X, nullptr, H, normg + 3 * D, mod + 1 * MODL, 3 * D, nullptr, nullptr, nullptr, KIN(I_MOEWR), KIN(I_MOEBR), ctl + CW_CNT, troute, tw, hscale, L, vcu, G, wave, lane, tid); }
    GRID_BAR();
    TS_END(8);
    TS_BEGIN();
    if (PH(9)) { PHASE_IDS; gather_phase((const unsigned char*)H, (unsigned char*)AS, rowinfo, troute, ctl + CW_CNT, hscale, rscale, vcu, G, wave, lane, tid); }
    GRID_BAR();
    TS_END(9);
    TS_BEGIN();
    if (PH(10)) { pg8::moe_order_setup((LAS int*)(L + MISC_OFF + 64), ctl + CW_CNT); pg8::MoeOrder S{(const LAS int*)(L + MISC_OFF + 64), 2 * DFE / 256, G, bx}; pg8::Gemm g{AS, MOE13, 0, 0, D / 2};
      pg8::EpiSwigluQ<true> E{ACT, DFE, 2 * DFE / 256, rscale, cscale};
      pg8::gemm_phase<pg8::EpiSwigluQ<true>, pg8::MoeOrder, true, true, false, true>(L, g, S, E); }
    GRID_BAR();
    TS_END(10);
    TS_BEGIN();
    if (PH(11)) MOE2_PHASE(ctl + CW_CNT, MOE2, cscale + NEXP * 2 * DFE, 0)
    if (PH(0)) { PHASE_IDS;
        LAS float* amx = (LAS float*)(L + XTRA_OFF); volatile LAS int* dealw = (volatile LAS int*)(L + XTRA_OFF + 4096);
        const float* w1 = KIN(I_MOEW1) + (size_t)NEXP * D * DFE; const float* w3 = KIN(I_MOEW3) + (size_t)NEXP * D * DFE; const float* w2 = KIN(I_MOEW2) + (size_t)NEXP * DFE * D;
        int par = 0;
        __syncthreads();
        for (;;) {
            if (tid == 0) dealw[par] = (int)__hip_atomic_fetch_add(ctl + CW_CONV, 1u, __ATOMIC_RELAXED, __HIP_MEMORY_SCOPE_AGENT);
            __syncthreads();
            const int itc = dealw[par];
            if (itc >= IT_MOE) break;
            int r = IT_MOE - 1 - itc;
            if (r < 2 * NEXP * IT_MOE8) { const int hi = r >= NEXP * IT_MOE8; r -= hi ? NEXP * IT_MOE8 : 0; const int e = r / IT_MOE8;
                conv8_wg_item(hi ? 4 : 3, r % IT_MOE8, (hi ? w3 : w1) + (size_t)e * D * DFE, DFE, (unsigned char*)MOE13 + (size_t)e * 2 * DFE * D, cscale + e * 2 * DFE, amx, par, wave, lane); }
            else { r -= 2 * NEXP * IT_MOE8; const int e = r / IT_MOE2; convf8_wg_item<DFE>(r % IT_MOE2, w2 + (size_t)e * DFE * D, D, (unsigned char*)MOE2B + (size_t)e * D * DFE, cscale2b + e * D, amx, par, wave, lane); }
            par ^= 1;
        }
    }
    GRID_BAR();
    TS_END(11);

    TS_BEGIN();
    TS_BEGIN();
    if (PH(12)) { PHASE_IDS; norm_phase<true, true, false, true>(X, X, H, normg + 4 * D, mod + 2 * MODL, 0, mod + 1 * MODL + 5 * D, YB, tw, nullptr, nullptr, nullptr, nullptr, nullptr, hscale, L, vcu, G, wave, lane, tid); }
    GRID_BAR();
    TS_END(12);
    TS_BEGIN();
    if (PH(2)) { pg8::Gemm g{H, WQKVC, MTOK, 3 * D, D / 2}; pg8::StaticOrder S; S.init(MTOK, 3 * D, G, bx);
      pg8::EpiQKV E{Qb, gains + 384, hscale, cscale_q + 6 * D};
      pg8::gemm_phase<pg8::EpiQKV, pg8::StaticOrder, true, true, false, true>(L, g, S, E); }
    GRID_BAR();
    TS_END(2);
    TS_BEGIN();
    if (PH(13)) { PHASE_IDS; attn_phase<1>(Qb, Kb, Vb, H, KIN(I_CARELB), L, vcu, G, wave, lane, tid); }
    GRID_BAR();
    TS_END(13);
    TS_BEGIN();
    if (PH(4)) { pg8::Gemm g{H, WOC, MTOK, D, D}; pg8::StaticOrder S; S.init(MTOK, D, G, bx);
      pg8::EpiResid16<false> E{X, X, mod + 2 * MODL + 2 * D, cscale_o + 2 * D};
      pg8::gemm_phase<pg8::EpiResid16<false>, pg8::StaticOrder, true, true>(L, g, S, E); }
    GRID_BAR();
    TS_END(4);
    TS_BEGIN();
    if (PH(1)) { PHASE_IDS; norm_phase<false, true, false, true>(X, nullptr, H, normg + 5 * D, mod + 2 * MODL, 3 * D, nullptr, nullptr, nullptr, nullptr, nullptr, nullptr, nullptr, nullptr, hscale, L, vcu, G, wave, lane, tid); }
    GRID_BAR();
    TS_END(1);
    TS_BEGIN();
    if (PH(5)) { pg8::Gemm g{H, W13_1, MTOK, 2 * DFF, D / 2}; pg8::StaticOrder S; S.init(MTOK, 2 * DFF, G, bx);
      pg8::EpiSwigluQ<true> E{ACT, DFF, 1 << 20, hscale, cscale_d + 2 * DFF};
      pg8::gemm_phase<pg8::EpiSwigluQ<true>, pg8::StaticOrder, true, true, false, true>(L, g, S, E); }
    GRID_BAR();
    TS_END(5);
    TS_BEGIN();
    if (PH(4)) { pg8::Gemm g{ACT, W2_1, MTOK, D, DFF / 2}; pg8::StaticOrder S; S.init(MTOK, D, G, bx);
      pg8::EpiResid16<false> E{X, X, mod + 2 * MODL + 5 * D, cscale_o + 5 * D};
      pg8::gemm_phase<pg8::EpiResid16<false>, pg8::StaticOrder, true, true, true, false>(L, g, S, E); }
    GRID_BAR();
    TS_END(4);

    TS_BEGIN();
    if (PH(1)) { PHASE_IDS; norm_phase<false, true, false, true>(X, nullptr, H, normg + 6 * D, mod + 3 * MODL, 0, nullptr, nullptr, nullptr, nullptr, nullptr, nullptr, nullptr, nullptr, hscale, L, vcu, G, wave, lane, tid); }
    GRID_BAR();
    TS_END(1);
    TS_BEGIN();
    if (PH(2)) { pg8::Gemm g{H, WQKV1, MTOK, 3 * D, D / 2}; pg8::StaticOrder S; S.init(MTOK, 3 * D, G, bx);
      pg8::EpiQKV E{Qb, gains + 192, hscale, cscale_q + 3 * D};
      pg8::gemm_phase<pg8::EpiQKV, pg8::StaticOrder, true, true, false, true>(L, g, S, E); }
    GRID_BAR();
    TS_END(2);
    TS_BEGIN();
    if (PH(3)) { PHASE_IDS; attn_sb_phase(Qb, Kb, Vb, H, L, vcu, G, wave, lane, tid); }
    GRID_BAR();
    TS_END(3);
    TS_BEGIN();
    if (PH(4)) { pg8::Gemm g{H, WO1, MTOK, D, D}; pg8::StaticOrder S; S.init(MTOK, D, G, bx);
      pg8::EpiResid16<false> E{X, X, mod + 3 * MODL + 2 * D, cscale_o + D};
      pg8::gemm_phase<pg8::EpiResid16<false>, pg8::StaticOrder, true, true>(L, g, S, E); }
    GRID_BAR();
    TS_END(4);
    TS_BEGIN();
    if (PH(8)) { PHASE_IDS; norm_phase<false, true, true>(X, nullptr, H, normg + 7 * D, mod + 3 * MODL, 3 * D, nullptr, nullptr, nullptr, KIN(I_MOEWR) + D * NEXP, KIN(I_MOEBR) + NEXP, ctl + CW_CNT + 8 * 64, troute, tw, hscale, L, vcu, G, wave, lane, tid); }
    GRID_BAR();
    TS_END(8);
    TS_BEGIN();
    if (PH(9)) { PHASE_IDS; gather_phase((const unsigned char*)H, (unsigned char*)AS, rowinfo, troute, ctl + CW_CNT + 8 * 64, hscale, rscale, vcu, G, wave, lane, tid); }
    GRID_BAR();
    TS_END(9);
    TS_BEGIN();
    if (PH(10)) { pg8::moe_order_setup((LAS int*)(L + MISC_OFF + 64), ctl + CW_CNT + 8 * 64); pg8::MoeOrder S{(const LAS int*)(L + MISC_OFF + 64), 2 * DFE / 256, G, bx}; pg8::Gemm g{AS, MOE13, 0, 0, D / 2};
      pg8::EpiSwigluQ<true> E{ACT, DFE, 2 * DFE / 256, rscale, cscale};
      pg8::gemm_phase<pg8::EpiSwigluQ<true>, pg8::MoeOrder, true, true, false, true>(L, g, S, E); }
    GRID_BAR();
    TS_END(10);
    TS_BEGIN();
    if (PH(11)) MOE2_PHASE(ctl + CW_CNT + 8 * 64, MOE2B, cscale2b, 1)
    GRID_BAR();
    TS_END(11);
    TS_BEGIN();
    if (PH(14)) { PHASE_IDS; norm_phase<true, false, false, false, true, false>(X, KOUT, nullptr, nullptr, nullptr, 0, mod + 3 * MODL + 5 * D, YB, tw, nullptr, nullptr, nullptr, nullptr, nullptr, nullptr, L, vcu, G, wave, lane, tid); }
    TS_END(14);
    TS_SPIN();
#undef GRID_BAR
#undef PHASE_IDS
#undef mod
#undef gains
#undef WQKV0
#undef WQKV1
#undef WQKVC
#undef WO0
#undef WO1
#undef WOC
#undef WIN
#undef WOUT
#undef W13_0
#undef W13_1
#undef W2_0
#undef W2_1
#undef MOE13
#undef MOE2
#undef MOE2B
#undef cscale2b
#undef H
#undef AS
#undef YB
#undef ACT
#undef Qb
#undef Kb
#undef Vb
#undef Ub
#undef Vg
#undef rowinfo
#undef troute
#undef tw
#undef vpart
#undef cscale
#undef cscale_d
#undef cscale_q
#undef cscale_w
#undef cscale_o
#undef Y8
#undef hscale
#undef rscale
#undef X
#undef x_in
#undef normg
#undef ctl
}

extern "C" void kernel_launch(void* const* d_in, const int* in_sizes, int n_in, void* d_out, int out_size, void* d_ws, size_t ws_size, hipStream_t stream) {
    static int grid = 0;
    if (grid == 0) {
        if (n_in != 26 || in_sizes[0] != MTOK * D || out_size != MTOK * D || ws_size < WS_END) { fprintf(stderr, "kernel_launch: unexpected shapes (n_in %d, in0 %d, out %d, ws %zu < %zu)\n", n_in, n_in > 0 ? in_sizes[0] : -1, out_size, ws_size, (size_t)WS_END); grid = -1; return; }
        int dev = 0, cus = 0, per_cu = 0;
        if (hipGetDevice(&dev) != hipSuccess || hipDeviceGetAttribute(&cus, hipDeviceAttributeMultiprocessorCount, dev) != hipSuccess) { grid = -1; return; }
        if (hipFuncSetAttribute((const void*)fwd_kernel, hipFuncAttributeMaxDynamicSharedMemorySize, LDS_BYTES) != hipSuccess) { fprintf(stderr, "kernel_launch: hipFuncSetAttribute failed\n"); grid = -1; return; }
        if (hipOccupancyMaxActiveBlocksPerMultiprocessor(&per_cu, (const void*)fwd_kernel, NWAVES * 64, LDS_BYTES) != hipSuccess || per_cu < 1) { fprintf(stderr, "kernel_launch: occupancy query says %d\n", per_cu); }
        (void)hipGetLastError();
        grid = cus;
    }
    if (grid < 0) return;
    if (hipMemsetAsync((char*)d_ws + WS_CTL, 0, CTL_ZERO_BYTES, stream) != hipSuccess) return;
    Args a{};
    for (int i = 0; i < 26; ++i) a.in[i] = (const float*)d_in[i];
    a.out = (float*)d_out; a.ws = (unsigned char*)d_ws;
    hipLaunchKernelGGL(fwd_kernel, dim3(grid), dim3(NWAVES * 64), LDS_BYTES, stream, a);
}
```
